# Optimizing an MI355X kernel written in HIP

```python
import jax, jax.numpy as jnp
from jax import lax
import numpy as np

D_MODEL = 1024
BATCH = 1
SEQ = 16384
DEPTH = 2

HEAD_DIM = 64
ROPE_DIM = HEAD_DIM // 4
ROPE_THETA = 500000.0
RMS_EPS = 1e-6
Q_BLOCK = 128
NEG_INF = -1e30
POS_BIG = 1e30

MOBA_HEADS = 6
MOBA_BLOCK = 256
MOBA_TOPK = 3

NSA_HEADS = 4
NSA_CMP_LEN = 32
NSA_CMP_STRIDE = 16
NSA_CMP_HIDDEN = 4 * HEAD_DIM
NSA_SLC_BLOCK = 64
NSA_SLC_TOPN = 16
NSA_WINDOW = 512

FOX_HEADS = 6
N_BRANCH = 3

MOBA_W = MOBA_HEADS * HEAD_DIM
NSA_W = NSA_HEADS * HEAD_DIM
FOX_W = FOX_HEADS * HEAD_DIM
IN_SPLITS = (MOBA_W,) * 4 + (NSA_W,) + (HEAD_DIM,) * 6 + (3 * NSA_HEADS, NSA_W) + (FOX_W,) * 3 + (FOX_HEADS, FOX_W, N_BRANCH * D_MODEL)
IN_COLS = sum(IN_SPLITS)
ATTN_SCALE = HEAD_DIM ** -0.5

kernel_name = "hybrid_moba_nsa_fox_gated"


def rms_norm(x, g):
    xf = x.astype(jnp.float32)
    y = xf * lax.rsqrt(jnp.mean(xf * xf, axis=-1, keepdims=True) + RMS_EPS)
    return (y * g.astype(jnp.float32)).astype(x.dtype)


def rope_tables(pos):
    inv = ROPE_THETA ** (-jnp.arange(0, ROPE_DIM, 2, dtype=jnp.float32) / ROPE_DIM)
    ang = pos.astype(jnp.float32)[:, None] * inv[None, :]
    return jnp.cos(ang), jnp.sin(ang)


def apply_partial_rope(x, cos, sin):
    half = ROPE_DIM // 2
    xr = x[..., :ROPE_DIM].astype(jnp.float32)
    x1, x2 = xr[..., :half], xr[..., half:]
    rot = jnp.concatenate([x1 * cos - x2 * sin, x2 * cos + x1 * sin], axis=-1)
    return jnp.concatenate([rot.astype(x.dtype), x[..., ROPE_DIM:]], axis=-1)


def masked_softmax(logits, mask):
    p = jax.nn.softmax(jnp.where(mask, logits.astype(jnp.float32), NEG_INF), axis=-1)
    return p * mask


def split_heads(t, n):
    B, S, _ = t.shape
    return t.reshape(B, S, n, HEAD_DIM).transpose(0, 2, 1, 3)


def merge_heads(t):
    B, H, S, dh = t.shape
    return t.transpose(0, 2, 1, 3).reshape(B, S, H * dh)


def sweep(fn, S):
    out = lax.map(fn, jnp.arange(S // Q_BLOCK))
    nq, B, H, Q, dh = out.shape
    return out.transpose(1, 2, 0, 3, 4).reshape(B, H, nq * Q, dh)


def moba_attention(q, k, v):
    B, H, S, dh = q.shape
    nb = -(-S // MOBA_BLOCK)
    pad = nb * MOBA_BLOCK - S
    kp = jnp.pad(k, ((0, 0), (0, 0), (0, pad), (0, 0)))
    vp = jnp.pad(v, ((0, 0), (0, 0), (0, pad), (0, 0)))
    kb = kp.reshape(B, H, nb, MOBA_BLOCK, dh)
    vb = vp.reshape(B, H, nb, MOBA_BLOCK, dh)
    kmean = jnp.mean(kb.astype(jnp.float32), axis=3).astype(k.dtype)
    n_sel = max(1, min(MOBA_TOPK, nb - 1))
    bi = jnp.arange(B)[:, None, None, None]
    hi = jnp.arange(H)[None, :, None, None]
    blk_ids = jnp.arange(nb)
    inner = jnp.arange(MOBA_BLOCK)

    def chunk(c):
        c0 = c * Q_BLOCK
        qc = lax.dynamic_slice_in_dim(q, c0, Q_BLOCK, axis=2)
        t = c0 + jnp.arange(Q_BLOCK)
        cur = t // MOBA_BLOCK
        gate = jnp.einsum('bhqd,bhnd->bhqn', qc, kmean).astype(jnp.float32)
        gate = jnp.where(blk_ids[None, :] < cur[:, None], gate, NEG_INF)
        _, idx = lax.top_k(gate, n_sel)
        sel_ok = jnp.arange(n_sel)[None, :] < cur[:, None]
        ks = kb[bi, hi, idx]
        vs = vb[bi, hi, idx]
        s_sel = jnp.einsum('bhqd,bhqnkd->bhqnk', qc, ks) * ATTN_SCALE
        m_sel = jnp.broadcast_to(sel_ok[:, :, None], (Q_BLOCK, n_sel, MOBA_BLOCK))
        own0 = (c0 // MOBA_BLOCK) * MOBA_BLOCK
        ko = lax.dynamic_slice_in_dim(kp, own0, MOBA_BLOCK, axis=2)
        vo = lax.dynamic_slice_in_dim(vp, own0, MOBA_BLOCK, axis=2)
        s_own = jnp.einsum('bhqd,bhkd->bhqk', qc, ko) * ATTN_SCALE
        m_own = (own0 + inner)[None, :] <= t[:, None]
        n_k = n_sel * MOBA_BLOCK
        logits = jnp.concatenate([s_sel.reshape(B, H, Q_BLOCK, n_k), s_own], axis=-1)
        mask = jnp.concatenate([m_sel.reshape(Q_BLOCK, n_k), m_own], axis=-1)
        p = masked_softmax(logits, mask).astype(v.dtype)
        p_sel = p[..., :n_k].reshape(B, H, Q_BLOCK, n_sel, MOBA_BLOCK)
        return (jnp.einsum('bhqnk,bhqnkd->bhqd', p_sel, vs)
                + jnp.einsum('bhqk,bhkd->bhqd', p[..., n_k:], vo))

    return sweep(chunk, S)


def nsa_compress(t, gidx, pe, w1, w2):
    B = t.shape[0]
    blocks = t[:, gidx] + pe
    flat = blocks.reshape(B, gidx.shape[0], NSA_CMP_LEN * HEAD_DIM)
    return jax.nn.silu(flat @ w1) @ w2


def nsa_attention(q, k_cmp, v_cmp, cmp_end, k_slc, v_slc, k_win, v_win, gates):
    B, H, S, dh = q.shape
    ns = S // NSA_SLC_BLOCK
    n_top = min(NSA_SLC_TOPN, ns)
    cmp_start = cmp_end - (NSA_CMP_LEN - 1)
    slc_start = jnp.arange(ns) * NSA_SLC_BLOCK
    overlap = ((cmp_start[:, None] <= slc_start[None, :] + NSA_SLC_BLOCK - 1)
               & (cmp_end[:, None] >= slc_start[None, :])).astype(jnp.float32)
    ksb = k_slc.reshape(B, ns, NSA_SLC_BLOCK, dh)
    vsb = v_slc.reshape(B, ns, NSA_SLC_BLOCK, dh)
    kwp = jnp.pad(k_win, ((0, 0), (NSA_WINDOW, 0), (0, 0)))
    vwp = jnp.pad(v_win, ((0, 0), (NSA_WINDOW, 0), (0, 0)))
    bi = jnp.arange(B)[:, None, None]
    blk = jnp.arange(ns)
    inner = jnp.arange(NSA_SLC_BLOCK)

    def chunk(c):
        c0 = c * Q_BLOCK
        qc = lax.dynamic_slice_in_dim(q, c0, Q_BLOCK, axis=2)
        t = c0 + jnp.arange(Q_BLOCK)
        s_c = jnp.einsum('bhqd,bnd->bhqn', qc, k_cmp) * ATTN_SCALE
        m_c = cmp_end[None, :] <= t[:, None]
        p_c = masked_softmax(s_c, m_c)
        o_c = jnp.einsum('bhqn,bnd->bhqd', p_c.astype(v_cmp.dtype), v_cmp)
        imp = jnp.einsum('bhqn,nm->bqm', p_c, overlap)
        cur = t // NSA_SLC_BLOCK
        score = jnp.where(blk[None, :] <= cur[:, None], imp, NEG_INF)
        forced = (blk[None, :] == 0) | (blk[None, :] == cur[:, None]) | (blk[None, :] == cur[:, None] - 1)
        score = jnp.where(forced, POS_BIG, score)
        _, idx = lax.top_k(score, n_top)
        ok = jnp.arange(n_top)[None, :] < (cur + 1)[:, None]
        ks = ksb[bi, idx]
        vs = vsb[bi, idx]
        s_s = jnp.einsum('bhqd,bqnkd->bhqnk', qc, ks) * ATTN_SCALE
        kpos = idx[..., None] * NSA_SLC_BLOCK + inner
        m_s = (kpos <= t[None, :, None, None]) & ok[None, :, :, None]
        n_k = n_top * NSA_SLC_BLOCK
        p_s = masked_softmax(s_s.reshape(B, H, Q_BLOCK, n_k), m_s.reshape(B, 1, Q_BLOCK, n_k))
        o_s = jnp.einsum('bhqnk,bqnkd->bhqd', p_s.reshape(B, H, Q_BLOCK, n_top, NSA_SLC_BLOCK).astype(v_slc.dtype), vs)
        kw = lax.dynamic_slice_in_dim(kwp, c0, NSA_WINDOW + Q_BLOCK, axis=1)
        vw = lax.dynamic_slice_in_dim(vwp, c0, NSA_WINDOW + Q_BLOCK, axis=1)
        wpos = c0 - NSA_WINDOW + jnp.arange(NSA_WINDOW + Q_BLOCK)
        diff = t[:, None] - wpos[None, :]
        m_w = (diff >= 0) & (diff < NSA_WINDOW) & (wpos[None, :] >= 0)
        s_w = jnp.einsum('bhqd,bkd->bhqk', qc, kw) * ATTN_SCALE
        o_w = jnp.einsum('bhqk,bkd->bhqd', masked_softmax(s_w, m_w).astype(v_win.dtype), vw)
        gc = lax.dynamic_slice_in_dim(gates, c0, Q_BLOCK, axis=2)
        return gc[..., 0:1] * o_c + gc[..., 1:2] * o_s + gc[..., 2:3] * o_w

    return sweep(chunk, S)


def fox_attention(q, k, v, log_f):
    B, H, S, dh = q.shape
    csum = jnp.cumsum(log_f, axis=-1)
    kpos = jnp.arange(S)

    def chunk(c):
        c0 = c * Q_BLOCK
        qc = lax.dynamic_slice_in_dim(q, c0, Q_BLOCK, axis=2)
        cq = lax.dynamic_slice_in_dim(csum, c0, Q_BLOCK, axis=2)
        t = c0 + jnp.arange(Q_BLOCK)
        s = (jnp.einsum('bhqd,bhkd->bhqk', qc, k).astype(jnp.float32) * ATTN_SCALE
             + cq[..., None] - csum[:, :, None, :])
        p = masked_softmax(s, kpos[None, :] <= t[:, None])
        return jnp.einsum('bhqk,bhkd->bhqd', p.astype(v.dtype), v)

    return sweep(chunk, S)


def hybrid_layer(x, norm_g, w_in, b_f, b_gate, moba_qk_g, nsa_q_g, nsa_k_g, fox_qk_g,
                 cmp_pe, cmp_w1, cmp_w2, w_up_moba, w_up_nsa, w_up_fox, w_out):
    B, S, _ = x.shape
    h = rms_norm(x, norm_g)
    proj = h @ w_in
    offsets = np.cumsum(IN_SPLITS)[:-1].tolist()
    (mq, mk, mv, mz, nq, kc, vc, ksl, vsl, kw, vw, ng, nz,
     fq, fk, fv, ff, fz, gl) = jnp.split(proj, offsets, axis=-1)
    pos = jnp.arange(S)
    cos, sin = rope_tables(pos)

    q = apply_partial_rope(rms_norm(split_heads(mq, MOBA_HEADS), moba_qk_g[0]), cos, sin)
    k = apply_partial_rope(rms_norm(split_heads(mk, MOBA_HEADS), moba_qk_g[1]), cos, sin)
    o_moba = merge_heads(moba_attention(q, k, split_heads(mv, MOBA_HEADS)))
    y_moba = (o_moba * jax.nn.silu(mz)) @ w_up_moba

    q = apply_partial_rope(rms_norm(split_heads(nq, NSA_HEADS), nsa_q_g), cos, sin)
    nc = (S - NSA_CMP_LEN) // NSA_CMP_STRIDE + 1
    starts = jnp.arange(nc) * NSA_CMP_STRIDE
    gidx = starts[:, None] + jnp.arange(NSA_CMP_LEN)[None, :]
    cmp_end = starts + NSA_CMP_LEN - 1
    k_cmp = nsa_compress(kc, gidx, cmp_pe[0], cmp_w1[0], cmp_w2[0])
    v_cmp = nsa_compress(vc, gidx, cmp_pe[1], cmp_w1[1], cmp_w2[1])
    cos_c, sin_c = rope_tables(cmp_end)
    k_cmp = apply_partial_rope(rms_norm(k_cmp, nsa_k_g[0]), cos_c, sin_c)
    ksl = apply_partial_rope(rms_norm(ksl, nsa_k_g[1]), cos, sin)
    kw = apply_partial_rope(rms_norm(kw, nsa_k_g[2]), cos, sin)
    gates = jax.nn.sigmoid(ng.reshape(B, S, NSA_HEADS, 3).transpose(0, 2, 1, 3))
    o_nsa = merge_heads(nsa_attention(q, k_cmp, v_cmp, cmp_end, ksl, vsl, kw, vw, gates))
    y_nsa = (o_nsa * jax.nn.silu(nz)) @ w_up_nsa

    q = rms_norm(split_heads(fq, FOX_HEADS), fox_qk_g[0])
    k = rms_norm(split_heads(fk, FOX_HEADS), fox_qk_g[1])
    log_f = jax.nn.log_sigmoid((ff + b_f).astype(jnp.float32)).transpose(0, 2, 1)
    o_fox = merge_heads(fox_attention(q, k, split_heads(fv, FOX_HEADS), log_f))
    y_fox = (o_fox * jax.nn.silu(fz)) @ w_up_fox

    g = jax.nn.sigmoid(gl + b_gate).reshape(B, S, N_BRANCH, D_MODEL)
    merged = g[:, :, 0] * y_moba + g[:, :, 1] * y_nsa + g[:, :, 2] * y_fox
    return x + merged @ w_out


def setup_inputs(seed: int = 0) -> dict:
    key = jax.random.key(seed)
    ks = jax.random.split(key, 16)
    f32 = jnp.float32

    def nrm(k, shape, scale):
        return jax.random.normal(k, shape, f32) * scale

    cmp_in = NSA_CMP_LEN * HEAD_DIM
    return {
        'x': nrm(ks[0], (BATCH, SEQ, D_MODEL), 1.0),
        'norm_g': 1.0 + nrm(ks[1], (DEPTH, D_MODEL), 0.02),
        'w_in': nrm(ks[2], (DEPTH, D_MODEL, IN_COLS), D_MODEL ** -0.5),
        'b_f': 3.0 + nrm(ks[3], (DEPTH, FOX_HEADS), 0.5),
        'b_gate': nrm(ks[4], (DEPTH, N_BRANCH * D_MODEL), 0.01),
        'moba_qk_g': 1.0 + nrm(ks[5], (DEPTH, 2, HEAD_DIM), 0.02),
        'nsa_q_g': 1.0 + nrm(ks[6], (DEPTH, HEAD_DIM), 0.02),
        'nsa_k_g': 1.0 + nrm(ks[7], (DEPTH, 3, HEAD_DIM), 0.02),
        'fox_qk_g': 1.0 + nrm(ks[8], (DEPTH, 2, HEAD_DIM), 0.02),
        'cmp_pe': nrm(ks[9], (DEPTH, 2, NSA_CMP_LEN, HEAD_DIM), 0.1),
        'cmp_w1': nrm(ks[10], (DEPTH, 2, cmp_in, NSA_CMP_HIDDEN), cmp_in ** -0.5),
        'cmp_w2': nrm(ks[11], (DEPTH, 2, NSA_CMP_HIDDEN, HEAD_DIM), NSA_CMP_HIDDEN ** -0.5),
        'w_up_moba': nrm(ks[12], (DEPTH, MOBA_W, D_MODEL), MOBA_W ** -0.5),
        'w_up_nsa': nrm(ks[13], (DEPTH, NSA_W, D_MODEL), NSA_W ** -0.5),
        'w_up_fox': nrm(ks[14], (DEPTH, FOX_W, D_MODEL), FOX_W ** -0.5),
        'w_out': nrm(ks[15], (DEPTH, D_MODEL, D_MODEL), D_MODEL ** -0.5),
    }


def reference(x, norm_g, w_in, b_f, b_gate, moba_qk_g, nsa_q_g, nsa_k_g, fox_qk_g,
              cmp_pe, cmp_w1, cmp_w2, w_up_moba, w_up_nsa, w_up_fox, w_out):
    for l in range(DEPTH):
        x = hybrid_layer(x, norm_g[l], w_in[l], b_f[l], b_gate[l], moba_qk_g[l], nsa_q_g[l],
                         nsa_k_g[l], fox_qk_g[l], cmp_pe[l], cmp_w1[l], cmp_w2[l],
                         w_up_moba[l], w_up_nsa[l], w_up_fox[l], w_out[l])
    return x
```

```cpp
#include <hip/hip_runtime.h>
#include <hip/hip_cooperative_groups.h>
#include <cstdio>
#include <cstdint>
namespace cg = cooperative_groups;

#ifndef N_LAUNCH_MODE
#define N_LAUNCH_MODE 1
#endif

typedef unsigned short bf16;
typedef short bf16x8 __attribute__((ext_vector_type(8)));
typedef float f32x4 __attribute__((ext_vector_type(4)));
typedef float f32x16 __attribute__((ext_vector_type(16)));
typedef unsigned u32x4 __attribute__((ext_vector_type(4)));
typedef unsigned u32x2 __attribute__((ext_vector_type(2)));
#define LAS __attribute__((address_space(3)))

constexpr int SEQ = 16384, DM = 1024, INC = 7058, PAC = 4096, NGL = 3072;
constexpr float LOG2E = 1.4426950408889634f;
constexpr float C2 = 0.125f * LOG2E;
constexpr float RMS_EPS = 1e-6f;
constexpr int LDS_BYTES = 131072;

constexpr int C_MK = 0, C_MV = 384, C_KC = 768, C_VC = 832, C_KSL = 896, C_VSL = 960, C_MQ = 1024, C_MZ = 1408, C_NQ = 1792, C_KW = 2048, C_VW = 2112,
              C_NZ = 2176, C_FQ = 2432, C_FK = 2816, C_FV = 3200, C_FZ = 3584, C_NG = 3968, C_FF = 3980, C_GL = 1024;
constexpr int C_OM = 0, C_OF = 384, C_ON = 768;

constexpr size_t MiB = 1u << 20;
constexpr size_t WS_CTL = 0, WS_WA = 1 * MiB, WS_WG = 9 * MiB, WS_WUPM = 15 * MiB, WS_WUPN = 15 * MiB + 768 * 1024, WS_WUPF = 15 * MiB + 1280 * 1024,
                 WS_WO = 17 * MiB, WS_W1T = 19 * MiB, WS_W2T = 21 * MiB, WS_PW = 21 * MiB + 64 * 1024, WS_KMEAN = 21 * MiB + 128 * 1024,
                 WS_CS = 21 * MiB + 256 * 1024, WS_CSTOT = 21 * MiB + 768 * 1024, WS_KCMP = 22 * MiB, WS_VCMP = 22 * MiB + 128 * 1024,
                 WS_KF = 23 * MiB, WS_VF = 51 * MiB, WS_H = 80 * MiB, WS_PA = 112 * MiB, WS_END = 240 * MiB;
constexpr size_t STREAM_ELEMS = (size_t)SEQ * 64;

struct Params {
    const float* x; const float* norm_g; const float* w_in; const float* b_f; const float* b_gate;
    const float* moba_qk_g; const float* nsa_q_g; const float* nsa_k_g; const float* fox_qk_g;
    const float* cmp_pe; const float* cmp_w1; const float* cmp_w2; const float* w_up_moba; const float* w_up_nsa; const float* w_up_fox; const float* w_out;
    float* out; unsigned char* ws; int ph_lo, ph_hi;
};

__device__ __forceinline__ unsigned cvt_pk_bf16(float lo, float hi) { unsigned r; asm volatile("v_cvt_pk_bf16_f32 %0, %1, %2" : "=v"(r) : "v"(lo), "v"(hi)); return r; }
__device__ __forceinline__ float bf2f(unsigned short b) { return __builtin_bit_cast(float, (unsigned)b << 16); }
__device__ __forceinline__ float bflo(unsigned w) { return __builtin_bit_cast(float, w << 16); }
__device__ __forceinline__ float bfhi(unsigned w) { return __builtin_bit_cast(float, w & 0xffff0000u); }
__device__ __forceinline__ unsigned short f2bf(float f) { return (unsigned short)(cvt_pk_bf16(f, 0.f) & 0xffffu); }
__device__ __forceinline__ float shx(float v, int m, int lane) { return __builtin_bit_cast(float, __builtin_amdgcn_ds_bpermute((lane ^ m) << 2, __builtin_bit_cast(int, v))); }
__device__ __forceinline__ int shxi(int v, int m, int lane) { return __builtin_amdgcn_ds_bpermute((lane ^ m) << 2, v); }
__device__ __forceinline__ float shfrom(float v, int src) { return __builtin_bit_cast(float, __builtin_amdgcn_ds_bpermute(src << 2, __builtin_bit_cast(int, v))); }
__device__ __forceinline__ int shfromi(int v, int src) { return __builtin_amdgcn_ds_bpermute(src << 2, v); }
__device__ __forceinline__ float wave_sum(float v, int lane) {
#pragma unroll
    for (int o = 1; o < 64; o <<= 1) v += shx(v, o, lane);
    return v;
}
__device__ __forceinline__ float wave_max(float v, int lane) {
#pragma unroll
    for (int o = 1; o < 64; o <<= 1) v = fmaxf(v, shx(v, o, lane));
    return v;
}
__device__ __forceinline__ int crow(int r, int hi) { return (r & 3) + 8 * (r >> 2) + 4 * hi; }
__device__ __forceinline__ float sigmoidf_(float z) { return 1.f / (1.f + __expf(-z)); }
__device__ __forceinline__ float siluf_(float z) { return z / (1.f + __expf(-z)); }
#define MFMA32(a, b, c) __builtin_amdgcn_mfma_f32_32x32x16_bf16((a), (b), (c), 0, 0, 0)
#define LDS_FENCE() asm volatile("s_waitcnt lgkmcnt(0)" ::: "memory")

namespace pg8 {
typedef unsigned short bf16_t;
constexpr int BM = 256, BK = 64, HALF = 128, HTB = HALF * BK * 2, NXCD = 8, WGM = 8;
__host__ __device__ __forceinline__ int lds_byte(int r, int c) { const int st = (r >> 4) * 2 + (c >> 5), rr = r & 15, cc = c & 31, ob = rr * 64 + cc * 2; return st * 1024 + (ob ^ (((ob >> 9) & 1) << 5)); }
__host__ __device__ __forceinline__ void stage_rc(int b, int& R, int& C) { const int st = b / 1024, sb = b % 1024, swz = sb ^ (((sb >> 9) & 1) << 5); R = (st >> 1) * 16 + swz / 64; C = (st & 1) * 32 + (swz % 64) / 2; }
__host__ __device__ __forceinline__ int perm32(int rho) { const int n = rho >> 4, i = rho & 15; return 8 * (i >> 2) + 4 * n + (i & 3); }
struct Unit { int pm, pn; };
struct Gemm { const bf16_t* A; const bf16_t* Bt; int M, N, K, lda; };
struct StaticOrder {
    int nM, nN, nwg, G, c;
    __device__ void init(int M, int N, int G_, int c_) { nM = M / BM; nN = N / BM; nwg = nM * nN; G = G_; c = c_; }
    __device__ bool next(int i, Unit& u) const {
        const long L = (long)i * G + c; if (L >= nwg) return false;
        int wgid = (int)L; { const int q = nwg / NXCD, r = nwg % NXCD, xcd = wgid % NXCD, off = wgid / NXCD; wgid = (xcd < r ? xcd * (q + 1) : r * (q + 1) + (xcd - r) * q) + off; }
        const int nig = WGM * nN, gid = wgid / nig, fm = gid * WGM, gsz = (nM - fm) < WGM ? (nM - fm) : WGM;
        u.pm = fm + ((wgid % nig) % gsz); u.pn = (wgid % nig) / gsz; return true;
    }
};
struct EpiBf16 {
    bf16_t* O; int ldc;
    __device__ __forceinline__ void operator()(const f32x4 (&acc)[2][2][4][2], const Unit& u, int wr, int wc, int fr, int fq) const {
        const int row0 = u.pm * BM + wr * 64 + fr, col0 = u.pn * BM + wc * 32 + 8 * fq;
#pragma unroll
        for (int ai = 0; ai < 2; ++ai)
#pragma unroll
            for (int m = 0; m < 4; ++m) { bf16_t* rowp = O + (size_t)(row0 + ai * HALF + m * 16) * ldc + col0;
#pragma unroll
                for (int bj = 0; bj < 2; ++bj) { const f32x4 v0 = acc[ai][bj][m][0], v1 = acc[ai][bj][m][1];
                    u32x4 w; w.x = cvt_pk_bf16(v0[0], v0[1]); w.y = cvt_pk_bf16(v0[2], v0[3]); w.z = cvt_pk_bf16(v1[0], v1[1]); w.w = cvt_pk_bf16(v1[2], v1[3]);
                    *(u32x4*)(rowp + bj * HALF) = w; } }
    }
};
struct EpiMerge {
    bf16_t* Mg; const bf16_t* gl; const float* bg; int first;
    __device__ __forceinline__ void operator()(const f32x4 (&acc)[2][2][4][2], const Unit& u, int wr, int wc, int fr, int fq) const {
        const int row0 = u.pm * BM + wr * 64 + fr, col0 = u.pn * BM + wc * 32 + 8 * fq;
#pragma unroll
        for (int bj = 0; bj < 2; ++bj) {
            const int col = col0 + bj * HALF;
            const f32x4 b0 = *(const f32x4*)(bg + col), b1 = *(const f32x4*)(bg + col + 4);
#pragma unroll
            for (int ai = 0; ai < 2; ++ai)
#pragma unroll
                for (int m = 0; m < 4; ++m) {
                    const size_t row = (size_t)(row0 + ai * HALF + m * 16);
                    const u32x4 g = *(const u32x4*)(gl + row * PAC + col);
                    const f32x4 a0 = acc[ai][bj][m][0], a1 = acc[ai][bj][m][1];
                    float v[8];
                    v[0] = a0[0] * sigmoidf_(bflo(g.x) + b0[0]); v[1] = a0[1] * sigmoidf_(bfhi(g.x) + b0[1]);
                    v[2] = a0[2] * sigmoidf_(bflo(g.y) + b0[2]); v[3] = a0[3] * sigmoidf_(bfhi(g.y) + b0[3]);
                    v[4] = a1[0] * sigmoidf_(bflo(g.z) + b1[0]); v[5] = a1[1] * sigmoidf_(bfhi(g.z) + b1[1]);
                    v[6] = a1[2] * sigmoidf_(bflo(g.w) + b1[2]); v[7] = a1[3] * sigmoidf_(bfhi(g.w) + b1[3]);
                    bf16_t* mp = Mg + row * DM + col;
                    if (!first) { const u32x4 p = *(const u32x4*)mp;
                        v[0] += bflo(p.x); v[1] += bfhi(p.x); v[2] += bflo(p.y); v[3] += bfhi(p.y); v[4] += bflo(p.z); v[5] += bfhi(p.z); v[6] += bflo(p.w); v[7] += bfhi(p.w); }
                    u32x4 w; w.x = cvt_pk_bf16(v[0], v[1]); w.y = cvt_pk_bf16(v[2], v[3]); w.z = cvt_pk_bf16(v[4], v[5]); w.w = cvt_pk_bf16(v[6], v[7]);
                    *(u32x4*)mp = w;
                }
        }
    }
};
struct EpiOut {
    const float* xin; float* out;
    __device__ __forceinline__ void operator()(const f32x4 (&acc)[2][2][4][2], const Unit& u, int wr, int wc, int fr, int fq) const {
        const int row0 = u.pm * BM + wr * 64 + fr, col0 = u.pn * BM + wc * 32 + 8 * fq;
#pragma unroll
        for (int ai = 0; ai < 2; ++ai)
#pragma unroll
            for (int m = 0; m < 4; ++m)
#pragma unroll
                for (int bj = 0; bj < 2; ++bj) {
                    const size_t off = (size_t)(row0 + ai * HALF + m * 16) * DM + col0 + bj * HALF;
                    const f32x4 x0 = *(const f32x4*)(xin + off), x1 = *(const f32x4*)(xin + off + 4);
                    *(f32x4*)(out + off) = x0 + acc[ai][bj][m][0]; *(f32x4*)(out + off + 4) = x1 + acc[ai][bj][m][1];
                }
    }
};

template <class Epi, class Sched>
__device__ __forceinline__ void gemm_phase(LAS unsigned char* lds, const Gemm g, const Sched& S, const Epi& E, const int tid) {
    const int wid = __builtin_amdgcn_readfirstlane(tid >> 6), lane = tid & 63, wr = wid >> 2, wc = wid & 3, fr = lane & 15, fq = lane >> 4;
    const int K = g.K, nt = K / BK, lda = g.lda;
    unsigned voffA[2], voffB[2];
#pragma unroll
    for (int i = 0; i < 2; ++i) { int R, C; stage_rc(tid * 16 + i * 8192, R, C); const int Rb = (R & ~31) + perm32(R & 31);
        voffA[i] = (unsigned)(R * lda + C) * 2u; voffB[i] = (unsigned)(Rb * K + C) * 2u; }
    const size_t kstep = (size_t)(BK * 2);
    const size_t hstepA = (size_t)HALF * lda * 2, hstepB = (size_t)HALF * K * 2;
    const size_t tstepA = 2 * hstepA, tstepB = 2 * hstepB;
    const unsigned ldsw = (unsigned)wid * 1024u;
    const int aoff = lds_byte(wr * 64 + fr, fq * 8), boff = lds_byte(wc * 32 + fr, fq * 8);
#define PG8_SA(b, h) (((b) * 2 + (h)) * HTB)
#define PG8_SB(b, h) ((4 + (b) * 2 + (h)) * HTB)
#define PG8_STAGE(bufoff, gbase, voff) do { _Pragma("unroll") for (int _i = 0; _i < 2; ++_i) \
        __builtin_amdgcn_global_load_lds((const unsigned*)((const char*)(gbase) + (voff)[_i]), (LAS unsigned*)(lds + (bufoff) + ldsw + _i * 8192), 16, 0, 0); } while (0)
#define PG8_LDA(dst, b, h) do { _Pragma("unroll") for (int m = 0; m < 4; ++m) _Pragma("unroll") for (int k = 0; k < 2; ++k) dst[m][k] = *(const LAS bf16x8*)(lds + PG8_SA(b, h) + aoff + m * 2048 + k * 1024); } while (0)
#define PG8_LDB(dst, b, h) do { _Pragma("unroll") for (int n = 0; n < 2; ++n) _Pragma("unroll") for (int k = 0; k < 2; ++k) dst[n][k] = *(const LAS bf16x8*)(lds + PG8_SB(b, h) + boff + n * 2048 + k * 1024); } while (0)
#define PG8_MMA(ai, bj, At, Bt) do { __builtin_amdgcn_s_setprio(1); _Pragma("unroll") for (int m = 0; m < 4; ++m) _Pragma("unroll") for (int n = 0; n < 2; ++n) _Pragma("unroll") for (int k = 0; k < 2; ++k) \
        acc[ai][bj][m][n] = __builtin_amdgcn_mfma_f32_16x16x32_bf16(Bt[n][k], At[m][k], acc[ai][bj][m][n], 0, 0, 0); __builtin_amdgcn_s_setprio(0); } while (0)
#define PG8_WAIT_V(n) asm volatile("s_waitcnt vmcnt(" #n ")" ::: "memory")
#define PG8_WAIT_L(n) asm volatile("s_waitcnt lgkmcnt(" #n ")" ::: "memory")
#define PG8_BAR __builtin_amdgcn_s_barrier()
#define PG8_SCHED __builtin_amdgcn_sched_barrier(0)
    Unit cur, nxt; int ui = 0;
    if (!S.next(0, cur)) return;
    f32x4 acc[2][2][4][2];
#pragma unroll
    for (int a = 0; a < 2; ++a)
#pragma unroll
        for (int b = 0; b < 2; ++b)
#pragma unroll
            for (int m = 0; m < 4; ++m)
#pragma unroll
                for (int n = 0; n < 2; ++n) acc[a][b][m][n] = (f32x4){0.f, 0.f, 0.f, 0.f};
    bf16x8 At[4][2], B0[2][2], B1[2][2];
    const char* cA = (const char*)g.A + (size_t)cur.pm * tstepA; const char* cB = (const char*)g.Bt + (size_t)cur.pn * tstepB;
    PG8_STAGE(PG8_SB(0, 0), cB, voffB); PG8_STAGE(PG8_SB(0, 1), cB + hstepB, voffB); PG8_STAGE(PG8_SA(0, 0), cA, voffA); PG8_STAGE(PG8_SA(0, 1), cA + hstepA, voffA);
    if (wr == 1) PG8_BAR;
    PG8_WAIT_V(2); PG8_BAR;
    PG8_STAGE(PG8_SB(1, 0), cB + kstep, voffB); PG8_STAGE(PG8_SA(1, 0), cA + kstep, voffA); PG8_STAGE(PG8_SB(1, 1), cB + hstepB + kstep, voffB);
    PG8_WAIT_V(6); PG8_BAR;
    for (;;) {
        const bool has_next = S.next(ui + 1, nxt);
        const char* nA = has_next ? (const char*)g.A + (size_t)nxt.pm * tstepA : cA; const char* nB = has_next ? (const char*)g.Bt + (size_t)nxt.pn * tstepB : cB;
        for (int t = 0; t < nt; t += 2) {
            const bool last = (t == nt - 2);
            const char* a1 = cA + (size_t)(t + 1) * kstep;
            const char* a2 = last ? nA : cA + (size_t)(t + 2) * kstep; const char* b2 = last ? nB : cB + (size_t)(t + 2) * kstep;
            const char* a3 = a2 + kstep; const char* b3 = b2 + kstep;
            PG8_LDB(B0, 0, 0); PG8_LDB(B1, 0, 1); PG8_SCHED; PG8_LDA(At, 0, 0); PG8_STAGE(PG8_SA(1, 1), a1 + hstepA, voffA);
            PG8_WAIT_V(8); PG8_WAIT_L(0); PG8_BAR; PG8_MMA(0, 0, At, B0); PG8_MMA(0, 1, At, B1); PG8_BAR; PG8_SCHED;
            PG8_LDA(At, 0, 1); PG8_STAGE(PG8_SB(0, 0), b2, voffB); PG8_STAGE(PG8_SB(0, 1), b2 + hstepB, voffB); PG8_STAGE(PG8_SA(0, 0), a2, voffA);
            PG8_WAIT_V(8); PG8_WAIT_L(0); PG8_BAR; PG8_MMA(1, 0, At, B0); PG8_MMA(1, 1, At, B1); PG8_BAR; PG8_SCHED;
            PG8_LDB(B0, 1, 0); PG8_LDB(B1, 1, 1); PG8_SCHED; PG8_LDA(At, 1, 0); PG8_STAGE(PG8_SA(0, 1), a2 + hstepA, voffA);
            PG8_WAIT_V(8); PG8_WAIT_L(0); PG8_BAR; PG8_MMA(0, 0, At, B0); PG8_MMA(0, 1, At, B1); PG8_BAR; PG8_SCHED;
            PG8_LDA(At, 1, 1); PG8_STAGE(PG8_SB(1, 0), b3, voffB); PG8_STAGE(PG8_SB(1, 1), b3 + hstepB, voffB); PG8_STAGE(PG8_SA(1, 0), a3, voffA);
            PG8_WAIT_V(8); PG8_WAIT_L(0); PG8_BAR; PG8_MMA(1, 0, At, B0); PG8_MMA(1, 1, At, B1); PG8_BAR; PG8_SCHED;
        }
        if (wr == 0) PG8_BAR;
        E(acc, cur, wr, wc, fr, fq);
        if (!has_next) break;
#pragma unroll
        for (int a = 0; a < 2; ++a)
#pragma unroll
            for (int b = 0; b < 2; ++b)
#pragma unroll
                for (int m = 0; m < 4; ++m)
#pragma unroll
                    for (int n = 0; n < 2; ++n) acc[a][b][m][n] = (f32x4){0.f, 0.f, 0.f, 0.f};
        cur = nxt; cA = nA; cB = nB; ++ui;
        if (wr == 1) PG8_BAR;
    }
    PG8_WAIT_V(0);
    PG8_BAR;
#undef PG8_SA
#undef PG8_SB
#undef PG8_STAGE
#undef PG8_LDA
#undef PG8_LDB
#undef PG8_MMA
#undef PG8_WAIT_V
#undef PG8_WAIT_L
#undef PG8_BAR
#undef PG8_SCHED
}
}

struct Frame { LAS unsigned char* lds; int tid, lane, wave, gw, NGW; unsigned char* ws; bf16* PA; };

__device__ __forceinline__ int srcA(int n) {
    if (n < 384) return 384 + n;
    if (n < 768) return 768 + (n - 384);
    if (n < 1024) return 1792 + (n - 768);
    if (n < 1408) return n - 1024;
    if (n < 1792) return 1152 + (n - 1408);
    if (n < 2048) return 1536 + (n - 1792);
    if (n < 2176) return 2048 + (n - 2048);
    if (n < 2432) return 2188 + (n - 2176);
    if (n < 3584) return 2444 + (n - 2432);
    if (n < 3968) return 3602 + (n - 3584);
    if (n < 3980) return 2176 + (n - 3968);
    if (n < 3986) return 3596 + (n - 3980);
    return -1;
}
__device__ __forceinline__ void tr_item(const float* W, int ldw, bf16* WT, int Kd, int k0, int n0, int mode, int off, LAS float* scr, int lane) {
    const int nn = n0 + (lane & 31);
    const int sc = mode == 0 ? srcA(nn) : nn + off;
#pragma unroll 8
    for (int i = 0; i < 32; ++i) { const int kk = 2 * i + (lane >> 5); scr[kk * 33 + (lane & 31)] = sc >= 0 ? W[(size_t)(k0 + kk) * ldw + sc] : 0.f; }
    LDS_FENCE();
    const int c = lane & 7;
#pragma unroll
    for (int j = 0; j < 4; ++j) { const int n = (lane >> 3) + 8 * j; const LAS float* s = scr + (8 * c) * 33 + n;
        u32x4 o; o.x = cvt_pk_bf16(s[0 * 33], s[1 * 33]); o.y = cvt_pk_bf16(s[2 * 33], s[3 * 33]); o.z = cvt_pk_bf16(s[4 * 33], s[5 * 33]); o.w = cvt_pk_bf16(s[6 * 33], s[7 * 33]);
        *(u32x4*)(WT + (size_t)(n0 + n) * Kd + k0 + 8 * c) = o; }
    LDS_FENCE();
}
__device__ __forceinline__ void phase0(const Params& P, const Frame& F, int layer, const float* xin) {
    LAS float* scr = (LAS float*)(F.lds + F.wave * 16384);
    unsigned char* ws = F.ws;
    if (F.gw == 0 && F.lane == 0) ((unsigned*)(ws + WS_CTL))[16 * layer] = 0u;
    constexpr int I_A = 16 * 128, I_G = 16 * 96, I_UM = 6 * 32, I_UN = 4 * 32, I_UF = 6 * 32, I_O = 16 * 32, I_1 = 32 * 8, I_2 = 4 * 2;
    constexpr int NIT = I_A + I_G + I_UM + I_UN + I_UF + I_O + 2 * I_1 + 2 * I_2;
    const float* w_in = P.w_in + (size_t)layer * DM * INC;
    for (int it = F.gw; it < NIT; it += F.NGW) {
        int r = it;
        if (r < I_A) { tr_item(w_in, INC, (bf16*)(ws + WS_WA), 1024, 64 * (r / 128), 32 * (r % 128), 0, 0, scr, F.lane); continue; } r -= I_A;
        if (r < I_G) { tr_item(w_in, INC, (bf16*)(ws + WS_WG), 1024, 64 * (r / 96), 32 * (r % 96), 1, 3986, scr, F.lane); continue; } r -= I_G;
        if (r < I_UM) { tr_item(P.w_up_moba + (size_t)layer * 384 * 1024, 1024, (bf16*)(ws + WS_WUPM), 384, 64 * (r / 32), 32 * (r % 32), 1, 0, scr, F.lane); continue; } r -= I_UM;
        if (r < I_UN) { tr_item(P.w_up_nsa + (size_t)layer * 256 * 1024, 1024, (bf16*)(ws + WS_WUPN), 256, 64 * (r / 32), 32 * (r % 32), 1, 0, scr, F.lane); continue; } r -= I_UN;
        if (r < I_UF) { tr_item(P.w_up_fox + (size_t)layer * 384 * 1024, 1024, (bf16*)(ws + WS_WUPF), 384, 64 * (r / 32), 32 * (r % 32), 1, 0, scr, F.lane); continue; } r -= I_UF;
        if (r < I_O) { tr_item(P.w_out + (size_t)layer * 1024 * 1024, 1024, (bf16*)(ws + WS_WO), 1024, 64 * (r / 32), 32 * (r % 32), 1, 0, scr, F.lane); continue; } r -= I_O;
        if (r < 2 * I_1) { const int kv = r / I_1; r %= I_1;
            tr_item(P.cmp_w1 + (size_t)(layer * 2 + kv) * 2048 * 256, 256, (bf16*)(ws + WS_W1T) + (size_t)kv * 256 * 2048, 2048, 64 * (r / 8), 32 * (r % 8), 1, 0, scr, F.lane); continue; } r -= 2 * I_1;
        { const int kv = r / I_2; r %= I_2;
            tr_item(P.cmp_w2 + (size_t)(layer * 2 + kv) * 256 * 64, 64, (bf16*)(ws + WS_W2T) + (size_t)kv * 64 * 256, 256, 64 * (r / 2), 32 * (r % 2), 1, 0, scr, F.lane); }
    }
    for (int it = F.gw; it < 8; it += F.NGW) {
        const int kv = it >> 2, n = (it & 3) * 64 + F.lane;
        const float* pe = P.cmp_pe + (size_t)(layer * 2 + kv) * 2048; const float* w1 = P.cmp_w1 + (size_t)(layer * 2 + kv) * 2048 * 256 + n;
        float s0 = 0.f, s1 = 0.f, s2 = 0.f, s3 = 0.f;
        for (int k = 0; k < 2048; k += 4) { s0 += pe[k] * w1[(size_t)k * 256]; s1 += pe[k + 1] * w1[(size_t)(k + 1) * 256]; s2 += pe[k + 2] * w1[(size_t)(k + 2) * 256]; s3 += pe[k + 3] * w1[(size_t)(k + 3) * 256]; }
        ((float*)(ws + WS_PW))[kv * 256 + n] = (s0 + s1) + (s2 + s3);
    }
    const float* g = P.norm_g + layer * DM; bf16* H = (bf16*)(ws + WS_H);
    for (int m = F.gw; m < SEQ; m += F.NGW) {
        const f32x4* xr = (const f32x4*)(xin + (size_t)m * DM) + F.lane;
        f32x4 v[4]; float s = 0.f;
#pragma unroll
        for (int j = 0; j < 4; ++j) { v[j] = xr[64 * j]; s += (v[j].x * v[j].x + v[j].y * v[j].y) + (v[j].z * v[j].z + v[j].w * v[j].w); }
        const float rs = rsqrtf(wave_sum(s, F.lane) * (1.f / DM) + RMS_EPS);
        unsigned long long* o8 = (unsigned long long*)(H + (size_t)m * DM) + F.lane;
#pragma unroll
        for (int j = 0; j < 4; ++j) { const f32x4 gg = ((const f32x4*)g)[F.lane + 64 * j];
            o8[64 * j] = (unsigned long long)cvt_pk_bf16(v[j].x * rs * gg.x, v[j].y * rs * gg.y) | ((unsigned long long)cvt_pk_bf16(v[j].z * rs * gg.z, v[j].w * rs * gg.w) << 32); }
    }
}

__device__ __forceinline__ void rope_sincos(float pos, int i, float& cs, float& sn) {
    constexpr float INV[8] = {1.0f, 0.1939227432012558f, 0.03760603070259094f, 0.007292664609849453f, 0.0014142135623842478f, 0.00027424818836152554f, 5.3182957344688475e-05f, 1.0313385246263351e-05f};
    const float ang = pos * INV[i];
    double rev = (double)ang * 0.15915494309189535; rev -= floor(rev);
    const float fr = (float)rev;
    sn = __builtin_amdgcn_sinf(fr); cs = __builtin_amdgcn_cosf(fr);
}
__device__ __forceinline__ void p2_normrow(const Params& P, const Frame& F, int layer, int idx) {
    const int t = idx / 30, slot = idx - t * 30;
    int col, kstream = -1; const float* g; bool rope = true; float osc = 1.f;
    if (slot < 6) { col = C_MQ + slot * 64; g = P.moba_qk_g + layer * 128; osc = C2; }
    else if (slot < 12) { col = C_MK + (slot - 6) * 64; g = P.moba_qk_g + layer * 128 + 64; kstream = slot - 6; }
    else if (slot < 16) { col = C_NQ + (slot - 12) * 64; g = P.nsa_q_g + layer * 64; osc = C2; }
    else if (slot == 16) { col = C_KSL; g = P.nsa_k_g + layer * 192 + 64; kstream = 6; }
    else if (slot == 17) { col = C_KW; g = P.nsa_k_g + layer * 192 + 128; kstream = 7; }
    else if (slot < 24) { col = C_FQ + (slot - 18) * 64; g = P.fox_qk_g + layer * 128; rope = false; osc = C2; }
    else { col = C_FK + (slot - 24) * 64; g = P.fox_qk_g + layer * 128 + 64; rope = false; kstream = 8 + (slot - 24); }
    bf16* rowp = F.PA + (size_t)t * PAC + col;
    float v[64];
    float ss = 0.f;
#pragma unroll
    for (int j = 0; j < 8; ++j) { const u32x4 w = ((const u32x4*)rowp)[j];
        v[8 * j + 0] = bflo(w.x); v[8 * j + 1] = bfhi(w.x); v[8 * j + 2] = bflo(w.y); v[8 * j + 3] = bfhi(w.y);
        v[8 * j + 4] = bflo(w.z); v[8 * j + 5] = bfhi(w.z); v[8 * j + 6] = bflo(w.w); v[8 * j + 7] = bfhi(w.w); }
#pragma unroll
    for (int d = 0; d < 64; ++d) ss += v[d] * v[d];
    const float rs = rsqrtf(ss * (1.f / 64.f) + RMS_EPS);
#pragma unroll
    for (int d = 0; d < 64; ++d) v[d] = v[d] * rs * g[d];
    if (rope) {
#pragma unroll
        for (int i = 0; i < 8; ++i) { float cs, sn; rope_sincos((float)t, i, cs, sn); const float a = v[i], b = v[i + 8]; v[i] = a * cs - b * sn; v[i + 8] = b * cs + a * sn; }
    }
    bf16* dst; int dstep;
    if (kstream < 0) { dst = rowp; dstep = 8; }
    else { dst = (bf16*)(F.ws + WS_KF) + (size_t)kstream * STREAM_ELEMS + ((size_t)(t >> 5) * 256 + (t & 31)) * 8; dstep = 0; }
#pragma unroll
    for (int j = 0; j < 8; ++j) {
        u32x4 w; w.x = cvt_pk_bf16(v[8 * j] * osc, v[8 * j + 1] * osc); w.y = cvt_pk_bf16(v[8 * j + 2] * osc, v[8 * j + 3] * osc);
        w.z = cvt_pk_bf16(v[8 * j + 4] * osc, v[8 * j + 5] * osc); w.w = cvt_pk_bf16(v[8 * j + 6] * osc, v[8 * j + 7] * osc);
        bf16* p = kstream < 0 ? dst + 8 * j : dst + ((j >> 1) * 64 + (j & 1) * 32) * 8;
        *(u32x4*)p = w;
    }
    (void)dstep;
}
__device__ __forceinline__ void p2_vfrag(const Frame& F, size_t f) {
    const int st = (int)(f >> 17); const int r = (int)(f & 131071);
    const int T = r >> 8, dt = (r >> 7) & 1, s = (r >> 6) & 1, ln = r & 63, c = ln & 31, hg = ln >> 5;
    const int col0 = st < 6 ? C_MV + st * 64 : (st == 6 ? C_VSL : (st == 7 ? C_VW : C_FV + (st - 8) * 64));
    const bf16* src = F.PA + (size_t)(32 * T + 16 * s + 4 * hg) * PAC + col0 + dt * 32 + c;
    unsigned short e[8];
#pragma unroll
    for (int j = 0; j < 8; ++j) e[j] = src[(size_t)((j & 3) + 8 * (j >> 2)) * PAC];
    u32x4 w; w.x = e[0] | ((unsigned)e[1] << 16); w.y = e[2] | ((unsigned)e[3] << 16); w.z = e[4] | ((unsigned)e[5] << 16); w.w = e[6] | ((unsigned)e[7] << 16);
    *(u32x4*)((bf16*)(F.ws + WS_VF) + (size_t)st * STREAM_ELEMS + (size_t)r * 8) = w;
}
__device__ __forceinline__ void p2_compress(const Params& P, const Frame& F, int layer, int item) {
    const int kv = item >> 5, T = item & 31, lane = F.lane, c = lane & 31, hg = lane >> 5;
    const int col0 = C_KC + kv * 64;
    const bf16* W1T = (const bf16*)(F.ws + WS_W1T) + (size_t)kv * 256 * 2048;
    const bf16* W2T = (const bf16*)(F.ws + WS_W2T) + (size_t)kv * 64 * 256;
    const float* pw = (const float*)(F.ws + WS_PW) + kv * 256;
    f32x16 acc[8];
#pragma unroll
    for (int nt = 0; nt < 8; ++nt)
#pragma unroll
        for (int r = 0; r < 16; ++r) acc[nt][r] = 0.f;
    const int blk = 32 * T + c;
    for (int ks = 0; ks < 128; ++ks) {
        const int pos = ks >> 2, dsub = (ks & 3) * 16;
        int row = 16 * blk + pos; row = row > SEQ - 1 ? SEQ - 1 : row;
        const bf16x8 b = *(const bf16x8*)(F.PA + (size_t)row * PAC + col0 + dsub + hg * 8);
#pragma unroll
        for (int nt = 0; nt < 8; ++nt) {
            const bf16x8 a = *(const bf16x8*)(W1T + (size_t)(nt * 32 + c) * 2048 + ks * 16 + hg * 8);
            acc[nt] = MFMA32(a, b, acc[nt]);
        }
    }
    f32x16 o[2];
#pragma unroll
    for (int r = 0; r < 16; ++r) { o[0][r] = 0.f; o[1][r] = 0.f; }
#pragma unroll
    for (int nt = 0; nt < 8; ++nt) {
        float hv[16];
#pragma unroll
        for (int r = 0; r < 16; ++r) hv[r] = siluf_(acc[nt][r] + pw[nt * 32 + crow(r, hg)]);
#pragma unroll
        for (int s = 0; s < 2; ++s) {
            u32x4 pw4; pw4.x = cvt_pk_bf16(hv[8 * s], hv[8 * s + 1]); pw4.y = cvt_pk_bf16(hv[8 * s + 2], hv[8 * s + 3]); pw4.z = cvt_pk_bf16(hv[8 * s + 4], hv[8 * s + 5]); pw4.w = cvt_pk_bf16(hv[8 * s + 6], hv[8 * s + 7]);
            const bf16x8 pb = __builtin_bit_cast(bf16x8, pw4);
#pragma unroll
            for (int dt = 0; dt < 2; ++dt) {
                const bf16* wp = W2T + (size_t)(dt * 32 + c) * 256 + nt * 32 + 16 * s + 4 * hg;
                const u32x2 lo = *(const u32x2*)wp, hi = *(const u32x2*)(wp + 8);
                u32x4 aw; aw.x = lo.x; aw.y = lo.y; aw.z = hi.x; aw.w = hi.y;
                o[dt] = MFMA32(__builtin_bit_cast(bf16x8, aw), pb, o[dt]);
            }
        }
    }
    if (kv == 0) {
        const float* g = P.nsa_k_g + layer * 192;
        float ss = 0.f;
#pragma unroll
        for (int dt = 0; dt < 2; ++dt)
#pragma unroll
            for (int r = 0; r < 16; ++r) ss += o[dt][r] * o[dt][r];
        ss += shx(ss, 32, lane);
        const float rs = rsqrtf(ss * (1.f / 64.f) + RMS_EPS);
#pragma unroll
        for (int dt = 0; dt < 2; ++dt)
#pragma unroll
            for (int r = 0; r < 16; ++r) o[dt][r] = o[dt][r] * rs * g[dt * 32 + crow(r, hg)];
        const float pos = (float)(16 * blk + 31);
#pragma unroll
        for (int r = 0; r < 4; ++r) {
            float c0, s0, c1, s1; rope_sincos(pos, r, c0, s0); rope_sincos(pos, r + 4, c1, s1);
            const float cs = hg ? c1 : c0, sn = hg ? s1 : s0;
            const float a = o[0][r], b = o[0][r + 4]; o[0][r] = a * cs - b * sn; o[0][r + 4] = b * cs + a * sn;
        }
        bf16* KC = (bf16*)(F.ws + WS_KCMP);
#pragma unroll
        for (int dt = 0; dt < 2; ++dt)
#pragma unroll
            for (int gq = 0; gq < 4; ++gq) {
                const int ks = dt * 2 + (gq >> 1), hgp = gq & 1;
                u32x2 w; w.x = cvt_pk_bf16(o[dt][4 * gq], o[dt][4 * gq + 1]); w.y = cvt_pk_bf16(o[dt][4 * gq + 2], o[dt][4 * gq + 3]);
                *(u32x2*)(KC + ((size_t)(T * 4 + ks) * 64 + hgp * 32 + c) * 8 + 4 * hg) = w;
            }
    } else {
        bf16* VC = (bf16*)(F.ws + WS_VCMP);
        const int s = c >> 4, hgp = (c >> 2) & 1, j = ((c >> 3) & 1) * 4 + (c & 3);
#pragma unroll
        for (int dt = 0; dt < 2; ++dt)
#pragma unroll
            for (int r = 0; r < 16; ++r)
                VC[((size_t)((T * 2 + dt) * 2 + s) * 64 + hgp * 32 + crow(r, hg)) * 8 + j] = f2bf(o[dt][r]);
    }
}
__device__ __forceinline__ void phase2(const Params& P, const Frame& F, int layer) {
#ifndef NO_CMP
    if (F.gw < 64) p2_compress(P, F, layer, F.gw);
#endif
    for (int it = F.gw; it < 6 * 256; it += F.NGW) {
        const int h = it >> 8, ch = it & 255, t = ch * 64 + F.lane;
        const float z = bf2f(F.PA[(size_t)t * PAC + C_FF + h]) + P.b_f[layer * 6 + h];
        float v = (fminf(z, 0.f) - log1pf(__expf(-fabsf(z)))) * LOG2E;
#pragma unroll
        for (int o = 1; o < 64; o <<= 1) { const float y = shfrom(v, (F.lane - o) & 63); if (F.lane >= o) v += y; }
        ((float*)(F.ws + WS_CS))[h * SEQ + t] = v;
        if (F.lane == 63) ((float*)(F.ws + WS_CSTOT))[h * 256 + ch] = v;
    }
#ifndef NO_NORMROW
    for (int it = F.gw; it < SEQ * 30 / 64; it += F.NGW) p2_normrow(P, F, layer, it * 64 + F.lane);
#endif
    for (int it = F.gw; it < 14 * 131072 / 64; it += F.NGW) p2_vfrag(F, (size_t)it * 64 + F.lane);
}

__device__ __forceinline__ void phase3(const Frame& F) {
    for (int it = F.gw; it < 384; it += F.NGW) {
        const int h = it >> 6, blk = it & 63, d = F.lane, ks = d >> 4, hg = (d >> 3) & 1, j = d & 7;
        const bf16* kf = (const bf16*)(F.ws + WS_KF) + (size_t)h * STREAM_ELEMS;
        float s = 0.f;
        for (int T = blk * 8; T < blk * 8 + 8; ++T)
#pragma unroll 8
            for (int c = 0; c < 32; ++c) s += bf2f(kf[((size_t)(T * 4 + ks) * 64 + hg * 32 + c) * 8 + j]);
        ((float*)(F.ws + WS_KMEAN))[(h * 64 + blk) * 64 + d] = s * (1.f / 256.f);
    }
    for (int it = F.gw; it < 6 * 256; it += F.NGW) {
        const int h = it >> 8, ch = it & 255;
        const float* tot = (const float*)(F.ws + WS_CSTOT) + h * 256;
        float s = 0.f;
        for (int cc = F.lane; cc < ch; cc += 64) s += tot[cc];
        s = wave_sum(s, F.lane);
        float* cs = (float*)(F.ws + WS_CS) + h * SEQ + ch * 64 + F.lane;
        *cs = *cs + s;
    }
}

__device__ __forceinline__ f32x16 qk_tile(const bf16* Kt, const bf16x8 (&qf)[4], int lane) {
    const bf16x8* p = (const bf16x8*)Kt + lane;
    f32x16 s;
#pragma unroll
    for (int r = 0; r < 16; ++r) s[r] = 0.f;
#pragma unroll
    for (int ks = 0; ks < 4; ++ks) s = MFMA32(p[ks * 64], qf[ks], s);
    return s;
}
__device__ __forceinline__ void pv_tile(const bf16* Vt, const float (&e)[16], f32x16 (&o)[2], int lane) {
    const bf16x8* p = (const bf16x8*)Vt + lane;
    u32x4 w0, w1;
    w0.x = cvt_pk_bf16(e[0], e[1]); w0.y = cvt_pk_bf16(e[2], e[3]); w0.z = cvt_pk_bf16(e[4], e[5]); w0.w = cvt_pk_bf16(e[6], e[7]);
    w1.x = cvt_pk_bf16(e[8], e[9]); w1.y = cvt_pk_bf16(e[10], e[11]); w1.z = cvt_pk_bf16(e[12], e[13]); w1.w = cvt_pk_bf16(e[14], e[15]);
    const bf16x8 pb0 = __builtin_bit_cast(bf16x8, w0), pb1 = __builtin_bit_cast(bf16x8, w1);
    o[0] = MFMA32(p[0], pb0, o[0]); o[0] = MFMA32(p[64], pb1, o[0]);
    o[1] = MFMA32(p[128], pb0, o[1]); o[1] = MFMA32(p[192], pb1, o[1]);
}
__device__ __forceinline__ float gain_bound(const float* gq, const float* gk, int lane) {
    const float a = wave_max(fabsf(gq[lane]), lane), b = wave_max(fabsf(gk[lane]), lane);
    return (8.f * a * b * 1.02f + 0.05f) * LOG2E;
}
__device__ __forceinline__ void write_gated(const Frame& F, const f32x16 (&o)[2], float scale, int t, int ocol, int zcol, int hg) {
    bf16* rowp = F.PA + (size_t)t * PAC;
#pragma unroll
    for (int dt = 0; dt < 2; ++dt)
#pragma unroll
        for (int g = 0; g < 4; ++g) {
            const int d0 = dt * 32 + 8 * g + 4 * hg;
            const u32x2 z = *(const u32x2*)(rowp + zcol + d0);
            u32x2 w;
            w.x = cvt_pk_bf16(o[dt][4 * g] * scale * siluf_(bflo(z.x)), o[dt][4 * g + 1] * scale * siluf_(bfhi(z.x)));
            w.y = cvt_pk_bf16(o[dt][4 * g + 2] * scale * siluf_(bflo(z.y)), o[dt][4 * g + 3] * scale * siluf_(bfhi(z.y)));
            *(u32x2*)(rowp + ocol + d0) = w;
        }
}
#define ZERO_O(o) do { _Pragma("unroll") for (int _r = 0; _r < 16; ++_r) { o[0][_r] = 0.f; o[1][_r] = 0.f; } } while (0)

__device__ __forceinline__ void unit_moba(const Params& P, const Frame& F, int layer, int h, int qg) {
    const int lane = F.lane, c = lane & 31, hg = lane >> 5, t0 = qg * 32, t = t0 + c, cur = t0 >> 8;
    const float SH = gain_bound(P.moba_qk_g + layer * 128, P.moba_qk_g + layer * 128 + 64, lane);
    const bf16* qrow = F.PA + (size_t)t * PAC + C_MQ + h * 64;
    bf16x8 qf[4];
#pragma unroll
    for (int ks = 0; ks < 4; ++ks) qf[ks] = *(const bf16x8*)(qrow + ks * 16 + hg * 8);
    int i1 = -1, i2 = -1, i3 = -1;
    if (cur > 0) {
        float qv[64];
#pragma unroll
        for (int j = 0; j < 8; ++j) { const u32x4 w = ((const u32x4*)qrow)[j];
            qv[8 * j + 0] = bflo(w.x); qv[8 * j + 1] = bfhi(w.x); qv[8 * j + 2] = bflo(w.y); qv[8 * j + 3] = bfhi(w.y);
            qv[8 * j + 4] = bflo(w.z); qv[8 * j + 5] = bfhi(w.z); qv[8 * j + 6] = bflo(w.w); qv[8 * j + 7] = bfhi(w.w); }
        float v1 = -3e38f, v2 = -3e38f, v3 = -3e38f;
        const float* km = (const float*)(F.ws + WS_KMEAN) + (size_t)h * 64 * 64;
        for (int j = 0; j < cur; ++j) {
            float g0 = 0.f, g1 = 0.f;
#pragma unroll
            for (int d = 0; d < 64; d += 2) { g0 += qv[d] * km[j * 64 + d]; g1 += qv[d + 1] * km[j * 64 + d + 1]; }
            const float g = g0 + g1;
            if (g > v3) { if (g > v2) { v3 = v2; i3 = i2; if (g > v1) { v2 = v1; i2 = i1; v1 = g; i1 = j; } else { v2 = g; i2 = j; } } else { v3 = g; i3 = j; } }
        }
    }
    const bf16* KF = (const bf16*)(F.ws + WS_KF) + (size_t)h * STREAM_ELEMS;
    const bf16* VF = (const bf16*)(F.ws + WS_VF) + (size_t)h * STREAM_ELEMS;
    f32x16 o[2]; ZERO_O(o); float l = 0.f;
    for (int j = 0; j < cur; ++j) {
        const bool flag = (j == i1) || (j == i2) || (j == i3);
        if (__ballot(flag) == 0ull) continue;
        for (int tt = 0; tt < 8; ++tt) {
            const int T = j * 8 + tt;
            const f32x16 s = qk_tile(KF + (size_t)T * 2048, qf, lane);
            float e[16];
#pragma unroll
            for (int r = 0; r < 16; ++r) { e[r] = flag ? __builtin_amdgcn_exp2f(s[r] - SH) : 0.f; l += e[r]; }
            pv_tile(VF + (size_t)T * 2048, e, o, lane);
        }
    }
    for (int T = cur * 8; T <= (t0 >> 5); ++T) {
        const f32x16 s = qk_tile(KF + (size_t)T * 2048, qf, lane);
        float e[16];
#pragma unroll
        for (int r = 0; r < 16; ++r) { const int key = 32 * T + crow(r, hg); e[r] = key <= t ? __builtin_amdgcn_exp2f(s[r] - SH) : 0.f; l += e[r]; }
        pv_tile(VF + (size_t)T * 2048, e, o, lane);
    }
    l += shx(l, 32, lane);
    write_gated(F, o, l > 0.f ? 1.f / l : 0.f, t, C_OM + h * 64, C_MZ + h * 64, hg);
}

__device__ __forceinline__ void unit_fox(const Params& P, const Frame& F, int layer, int h, int qg) {
    const int lane = F.lane, c = lane & 31, hg = lane >> 5, t0 = qg * 32, t = t0 + c;
    const float SH = gain_bound(P.fox_qk_g + layer * 128, P.fox_qk_g + layer * 128 + 64, lane);
    const float* cs = (const float*)(F.ws + WS_CS) + (size_t)h * SEQ;
    const bf16* qrow = F.PA + (size_t)t * PAC + C_FQ + h * 64;
    bf16x8 qf[4];
#pragma unroll
    for (int ks = 0; ks < 4; ++ks) qf[ks] = *(const bf16x8*)(qrow + ks * 16 + hg * 8);
    const float cq = cs[t];
    const int Thi = t0 >> 5;
    const float cs0 = cs[t0], lim = -(2.f * SH + 40.f);
    int lo = 0, hi = Thi;
    while (lo < hi) { const int mid = (lo + hi) >> 1; if (cs0 - cs[32 * mid + 31] >= lim) hi = mid; else lo = mid + 1; }
    const bf16* KF = (const bf16*)(F.ws + WS_KF) + (size_t)(8 + h) * STREAM_ELEMS;
    const bf16* VF = (const bf16*)(F.ws + WS_VF) + (size_t)(8 + h) * STREAM_ELEMS;
    f32x16 o[2]; ZERO_O(o); float l = 0.f;
    for (int T = Thi; T >= lo; --T) {
        const f32x16 s = qk_tile(KF + (size_t)T * 2048, qf, lane);
        f32x4 ck[4];
#pragma unroll
        for (int g = 0; g < 4; ++g) ck[g] = *(const f32x4*)(cs + 32 * T + 8 * g + 4 * hg);
        float e[16];
#pragma unroll
        for (int r = 0; r < 16; ++r) { const int key = 32 * T + crow(r, hg);
            e[r] = key <= t ? __builtin_amdgcn_exp2f(s[r] - SH + (cq - ck[r >> 2][r & 3])) : 0.f; l += e[r]; }
        pv_tile(VF + (size_t)T * 2048, e, o, lane);
    }
    l += shx(l, 32, lane);
    write_gated(F, o, l > 0.f ? 1.f / l : 0.f, t, C_OF + h * 64, C_FZ + h * 64, hg);
}

__device__ __forceinline__ void unit_nsa(const Params& P, const Frame& F, int layer, int u) {
    const int lane = F.lane, c = lane & 31, hg = lane >> 5, qi = c >> 2, h = c & 3, t0 = u * 8, t = t0 + qi, cur = t0 >> 6;
    const float* kg = P.nsa_k_g + layer * 192; const float* qg = P.nsa_q_g + layer * 64;
    const float SHc = gain_bound(qg, kg, lane), SHs = gain_bound(qg, kg + 64, lane), SHw = gain_bound(qg, kg + 128, lane);
    const bf16* prow = F.PA + (size_t)t * PAC;
    bf16x8 qf[4];
#pragma unroll
    for (int ks = 0; ks < 4; ++ks) qf[ks] = *(const bf16x8*)(prow + C_NQ + h * 64 + ks * 16 + hg * 8);
    const float g0 = sigmoidf_(bf2f(prow[C_NG + h * 3 + 0])), g1 = sigmoidf_(bf2f(prow[C_NG + h * 3 + 1])), g2 = sigmoidf_(bf2f(prow[C_NG + h * 3 + 2]));
    LAS float* impS = (LAS float*)(F.lds + F.wave * 16384); LAS float* impE = impS + 2048;
    f32x16 accF[2]; ZERO_O(accF);
    f32x16 o[2]; float l;
    const int nmax = (t0 + 7 - 31) >> 4, ntile = (t0 + 7 >= 31) ? (nmax >> 5) + 1 : 0;
    const bf16* KC = (const bf16*)(F.ws + WS_KCMP); const bf16* VC = (const bf16*)(F.ws + WS_VCMP);
    ZERO_O(o); l = 0.f;
    for (int T = 0; T < ntile; ++T) {
        const f32x16 s = qk_tile(KC + (size_t)T * 2048, qf, lane);
        float e[16];
#pragma unroll
        for (int r = 0; r < 16; ++r) { const int n = 32 * T + crow(r, hg); e[r] = (16 * n + 31 <= t) ? __builtin_amdgcn_exp2f(s[r] - SHc) : 0.f; l += e[r]; }
        pv_tile(VC + (size_t)T * 2048, e, o, lane);
    }
    l += shx(l, 32, lane);
    const float invc = l > 0.f ? 1.f / l : 0.f;
    {
        const float sc = g0 * invc;
#pragma unroll
        for (int r = 0; r < 16; ++r) { accF[0][r] += sc * o[0][r]; accF[1][r] += sc * o[1][r]; }
    }
    for (int T = 0; T < ntile; ++T) {
        const f32x16 s = qk_tile(KC + (size_t)T * 2048, qf, lane);
#pragma unroll
        for (int g = 0; g < 4; ++g) {
            float s4 = 0.f, ed = 0.f;
#pragma unroll
            for (int k = 0; k < 4; ++k) { const int r = 4 * g + k; const int n = 32 * T + crow(r, hg);
                const float p = (16 * n + 31 <= t) ? __builtin_amdgcn_exp2f(s[r] - SHc) * invc : 0.f; s4 += p; if (k == 3) ed = p; }
            s4 += shx(s4, 1, lane); s4 += shx(s4, 2, lane); ed += shx(ed, 1, lane); ed += shx(ed, 2, lane);
            const int m = 8 * T + 2 * g + hg;
            if (h == 0) { impS[qi * 256 + m] = s4; if (m + 1 < 256) impE[qi * 256 + m + 1] = ed; }
        }
    }
    LDS_FENCE();
    unsigned long long my0 = 0ull, my1 = 0ull, my2 = 0ull, my3 = 0ull, un0 = 0ull, un1 = 0ull, un2 = 0ull, un3 = 0ull;
    {
        const int qs = lane >> 3, sub = lane & 7;
        float val[32];
#pragma unroll
        for (int k = 0; k < 32; ++k) { const int m = sub + 8 * k;
            const float iv = impS[qs * 256 + m] + impE[qs * 256 + m];
            val[k] = (m > cur) ? -3e38f : ((m == 0 || m == cur || m == cur - 1) ? 3e38f : iv); }
        const int nsel = cur + 1 < 16 ? cur + 1 : 16;
        for (int rd = 0; rd < nsel; ++rd) {
            float bv = val[0]; int bk = 0;
#pragma unroll
            for (int k = 1; k < 32; ++k) if (val[k] > bv) { bv = val[k]; bk = k; }
            int bm = sub + 8 * bk;
#pragma unroll
            for (int of = 1; of < 8; of <<= 1) { const float ov = shx(bv, of, lane); const int om = shxi(bm, of, lane);
                if (ov > bv || (ov == bv && om < bm)) { bv = ov; bm = om; } }
#pragma unroll
            for (int k = 0; k < 32; ++k) if (sub + 8 * k == bm) val[k] = -3e38f;
            const int wa = shfromi(bm, (c >> 2) * 8);
            { const unsigned long long bit = 1ull << (wa & 63); const int kk = wa >> 6;
              my0 |= kk == 0 ? bit : 0ull; my1 |= kk == 1 ? bit : 0ull; my2 |= kk == 2 ? bit : 0ull; my3 |= kk == 3 ? bit : 0ull; }
#pragma unroll
            for (int q = 0; q < 8; ++q) { const int wq = __builtin_amdgcn_readlane(bm, q * 8); const unsigned long long bit = 1ull << (wq & 63); const int kk = wq >> 6;
                un0 |= kk == 0 ? bit : 0ull; un1 |= kk == 1 ? bit : 0ull; un2 |= kk == 2 ? bit : 0ull; un3 |= kk == 3 ? bit : 0ull; }
        }
    }
    LDS_FENCE();
    const bf16* KS = (const bf16*)(F.ws + WS_KF) + (size_t)6 * STREAM_ELEMS; const bf16* VS = (const bf16*)(F.ws + WS_VF) + (size_t)6 * STREAM_ELEMS;
    ZERO_O(o); l = 0.f;
#pragma unroll
    for (int kk = 0; kk < 4; ++kk) {
        unsigned long long uw = kk == 0 ? un0 : (kk == 1 ? un1 : (kk == 2 ? un2 : un3));
        const unsigned long long mw = kk == 0 ? my0 : (kk == 1 ? my1 : (kk == 2 ? my2 : my3));
        while (uw) {
            const int b = __builtin_ctzll(uw); uw &= uw - 1ull;
            const int m = 64 * kk + b; const bool flag = (mw >> b) & 1ull;
            for (int tt = 0; tt < 2; ++tt) {
                const int T = 2 * m + tt;
                const f32x16 s = qk_tile(KS + (size_t)T * 2048, qf, lane);
                float e[16];
#pragma unroll
                for (int r = 0; r < 16; ++r) { const int key = 32 * T + crow(r, hg); e[r] = (flag && key <= t) ? __builtin_amdgcn_exp2f(s[r] - SHs) : 0.f; l += e[r]; }
                pv_tile(VS + (size_t)T * 2048, e, o, lane);
            }
        }
    }
    l += shx(l, 32, lane);
    {
        const float sc = l > 0.f ? g1 / l : 0.f;
#pragma unroll
        for (int r = 0; r < 16; ++r) { accF[0][r] += sc * o[0][r]; accF[1][r] += sc * o[1][r]; }
    }
    const bf16* KW = (const bf16*)(F.ws + WS_KF) + (size_t)7 * STREAM_ELEMS; const bf16* VW = (const bf16*)(F.ws + WS_VF) + (size_t)7 * STREAM_ELEMS;
    ZERO_O(o); l = 0.f;
    const int Tlo = (t0 - 511 > 0 ? t0 - 511 : 0) >> 5, Thi = (t0 + 7) >> 5;
    for (int T = Tlo; T <= Thi; ++T) {
        const f32x16 s = qk_tile(KW + (size_t)T * 2048, qf, lane);
        float e[16];
#pragma unroll
        for (int r = 0; r < 16; ++r) { const int key = 32 * T + crow(r, hg); e[r] = (key <= t && key >= t - 511) ? __builtin_amdgcn_exp2f(s[r] - SHw) : 0.f; l += e[r]; }
        pv_tile(VW + (size_t)T * 2048, e, o, lane);
    }
    l += shx(l, 32, lane);
    {
        const float sc = l > 0.f ? g2 / l : 0.f;
#pragma unroll
        for (int r = 0; r < 16; ++r) { accF[0][r] += sc * o[0][r]; accF[1][r] += sc * o[1][r]; }
    }
    write_gated(F, accF, 1.f, t, C_ON + h * 64, C_NZ + h * 64, hg);
}

__device__ __forceinline__ void phase4(const Params& P, const Frame& F0, int layer) {
    unsigned* ctr = (unsigned*)(F0.ws + WS_CTL) + 16 * layer;
    constexpr int N_MOBA = 6 * 512, N_NSA = 2048, N_FOX = 6 * 512, N_ALL = N_MOBA + N_NSA + N_FOX;
    for (;;) {
        Frame F = F0;
        { unsigned char* w = F0.ws; asm volatile("" : "+s"(w)); int tv = F0.tid; asm volatile("" : "+v"(tv)); F.ws = w; F.PA = (bf16*)(w + WS_PA); F.tid = tv; F.lane = tv & 63; }
        unsigned u = 0;
        if (F.lane == 0) u = __hip_atomic_fetch_add(ctr, 1u, __ATOMIC_RELAXED, __HIP_MEMORY_SCOPE_AGENT);
        u = __builtin_amdgcn_readfirstlane(u);
        if (u >= (unsigned)N_ALL) break;
#ifndef NO_MOBA
        if (u < (unsigned)N_MOBA) { unit_moba(P, F, layer, (int)(u % 6), 511 - (int)(u / 6)); } else
#endif
#ifndef NO_NSA
        if (u < (unsigned)(N_MOBA + N_NSA)) { unit_nsa(P, F, layer, 2047 - (int)(u - N_MOBA)); } else
#endif
#ifndef NO_FOX
        { const unsigned v = u - (N_MOBA + N_NSA); unit_fox(P, F, layer, (int)(v % 6), 511 - (int)(v / 6)); }
#else
        {}
#endif
    }
}

__global__ void __launch_bounds__(512, 2) fwd_kernel(Params P) {
    extern __shared__ __attribute__((aligned(16))) unsigned char lds_raw[];
    cg::grid_group grid = cg::this_grid();
    const int G = gridDim.x, bx = blockIdx.x;
    for (int ph = P.ph_lo; ph < P.ph_hi; ++ph) {
        unsigned char* wsb = P.ws; asm volatile("" : "+s"(wsb));
        int tidv = threadIdx.x; asm volatile("" : "+v"(tidv));
        Frame F;
        F.lds = (LAS unsigned char*)lds_raw;
        F.tid = tidv; F.lane = F.tid & 63; F.wave = __builtin_amdgcn_readfirstlane(F.tid >> 6);
        F.gw = bx * 8 + F.wave; F.NGW = G * 8;
        F.ws = wsb; F.PA = (bf16*)(wsb + WS_PA);
        const int layer = ph >> 3, k = ph & 7;
        const float* xin = layer == 0 ? P.x : P.out;
        if (k == 0) phase0(P, F, layer, xin);
        else if (k == 1 || k == 5) {
            pg8::Gemm g; pg8::StaticOrder S; pg8::EpiBf16 E;
            if (k == 1) { g = pg8::Gemm{(const bf16*)(wsb + WS_H), (const bf16*)(wsb + WS_WA), SEQ, PAC, DM, DM}; S.init(SEQ, PAC, G, bx); E = pg8::EpiBf16{F.PA, PAC}; }
            else { g = pg8::Gemm{(const bf16*)(wsb + WS_H), (const bf16*)(wsb + WS_WG), SEQ, NGL, DM, DM}; S.init(SEQ, NGL, G, bx); E = pg8::EpiBf16{F.PA + C_GL, PAC}; }
#ifndef NO_G15
            pg8::gemm_phase<pg8::EpiBf16, pg8::StaticOrder>(F.lds, g, S, E, F.tid);
#endif
        }
        else if (k == 2) phase2(P, F, layer);
        else if (k == 3) phase3(F);
        else if (k == 4) phase4(P, F, layer);
        else if (k == 6) {
            for (int b = 0; b < 3; ++b) {
                const int Kb = b == 1 ? 256 : 384;
                const bf16* A = F.PA + (b == 0 ? C_OM : (b == 1 ? C_ON : C_OF));
                const bf16* Bt = (const bf16*)(wsb + (b == 0 ? WS_WUPM : (b == 1 ? WS_WUPN : WS_WUPF)));
                pg8::Gemm g{A, Bt, SEQ, DM, Kb, PAC}; pg8::StaticOrder S; S.init(SEQ, DM, G, bx);
                pg8::EpiMerge E{(bf16*)(wsb + WS_H), F.PA + C_GL + b * 1024, P.b_gate + layer * 3072 + b * 1024, b == 0 ? 1 : 0};
#ifndef NO_G6
                pg8::gemm_phase<pg8::EpiMerge, pg8::StaticOrder>(F.lds, g, S, E, F.tid);
#endif
            }
        }
        else {
            pg8::Gemm g{(const bf16*)(wsb + WS_H), (const bf16*)(wsb + WS_WO), SEQ, DM, DM, DM}; pg8::StaticOrder S; S.init(SEQ, DM, G, bx);
            pg8::EpiOut E{xin, P.out};
#ifndef NO_G7
            pg8::gemm_phase<pg8::EpiOut, pg8::StaticOrder>(F.lds, g, S, E, F.tid);
#endif
        }
        if (ph + 1 < P.ph_hi) grid.sync();
    }
}

extern "C" void kernel_launch(void* const* d_in, const int* in_sizes, int n_in, void* d_out, int out_size, void* d_ws, size_t ws_size, hipStream_t stream) {
    static int grid = 0;
    if (grid == 0) {
        if (n_in != 16 || out_size != SEQ * DM || ws_size < WS_END) { fprintf(stderr, "kernel_launch: unexpected problem shape (n_in %d out %d ws %zu)\n", n_in, out_size, ws_size); grid = -1; return; }
        int dev = 0, cus = 0, per_cu = 0;
        hipGetDevice(&dev);
        hipDeviceGetAttribute(&cus, hipDeviceAttributeMultiprocessorCount, dev);
        hipFuncSetAttribute((const void*)fwd_kernel, hipFuncAttributeMaxDynamicSharedMemorySize, LDS_BYTES);
        hipOccupancyMaxActiveBlocksPerMultiprocessor(&per_cu, (const void*)fwd_kernel, 512, LDS_BYTES);
        if (per_cu < 1) { fprintf(stderr, "kernel_launch: occupancy query says %d blocks per CU\n", per_cu); per_cu = 1; }
        (void)hipGetLastError();
        grid = cus * per_cu;
    }
    if (grid < 0) return;
    Params p{};
    p.x = (const float*)d_in[0]; p.norm_g = (const float*)d_in[1]; p.w_in = (const float*)d_in[2]; p.b_f = (const float*)d_in[3]; p.b_gate = (const float*)d_in[4];
    p.moba_qk_g = (const float*)d_in[5]; p.nsa_q_g = (const float*)d_in[6]; p.nsa_k_g = (const float*)d_in[7]; p.fox_qk_g = (const float*)d_in[8];
    p.cmp_pe = (const float*)d_in[9]; p.cmp_w1 = (const float*)d_in[10]; p.cmp_w2 = (const float*)d_in[11];
    p.w_up_moba = (const float*)d_in[12]; p.w_up_nsa = (const float*)d_in[13]; p.w_up_fox = (const float*)d_in[14]; p.w_out = (const float*)d_in[15];
    p.out = (float*)d_out; p.ws = (unsigned char*)d_ws;
#if N_LAUNCH_MODE == 1
    for (int ph = 0; ph < 16; ++ph) { p.ph_lo = ph; p.ph_hi = ph + 1; hipLaunchKernelGGL(fwd_kernel, dim3(grid), dim3(512), LDS_BYTES, stream, p); }
#else
    p.ph_lo = 0; p.ph_hi = 16;
    void* args[] = {&p};
    hipError_t e = hipLaunchCooperativeKernel((const void*)fwd_kernel, dim3(grid), dim3(512), args, LDS_BYTES, stream);
    if (e != hipSuccess) fprintf(stderr, "kernel_launch: cooperative launch failed: %s (grid %d)\n", hipGetErrorString(e), grid);
#endif
}
```

```cpp
#include <hip/hip_runtime.h>
#include <hip/hip_cooperative_groups.h>
#include <cstdio>
#include <cstdint>
namespace cg = cooperative_groups;

#ifndef N_LAUNCH_MODE
#define N_LAUNCH_MODE 0
#endif

typedef unsigned short bf16;
typedef short bf16x8 __attribute__((ext_vector_type(8)));
typedef float f32x4 __attribute__((ext_vector_type(4)));
typedef float f32x16 __attribute__((ext_vector_type(16)));
typedef unsigned u32x4 __attribute__((ext_vector_type(4)));
typedef unsigned u32x2 __attribute__((ext_vector_type(2)));
#define LAS __attribute__((address_space(3)))

constexpr int SEQ = 16384, DM = 1024, INC = 7058, PAC = 4096, NGL = 3072;
constexpr float LOG2E = 1.4426950408889634f;
constexpr float C2 = 0.125f * LOG2E;
constexpr float RMS_EPS = 1e-6f;
constexpr int LDS_BYTES = 131072;

constexpr int C_MK = 0, C_MV = 384, C_KC = 768, C_VC = 832, C_KSL = 896, C_VSL = 960, C_MQ = 1024, C_MZ = 1408, C_NQ = 1792, C_KW = 2048, C_VW = 2112,
              C_NZ = 2176, C_FQ = 2432, C_FK = 2816, C_FV = 3200, C_FZ = 3584, C_NG = 3968, C_FF = 3980, C_GL = 1024;
constexpr int C_OM = 0, C_OF = 384, C_ON = 768;

constexpr size_t MiB = 1u << 20;
constexpr size_t WS_CTL = 0, WS_WA = 1 * MiB, WS_WG = 9 * MiB, WS_WUPM = 15 * MiB, WS_WUPN = 15 * MiB + 768 * 1024, WS_WUPF = 15 * MiB + 1280 * 1024,
                 WS_WO = 17 * MiB, WS_W1T = 19 * MiB, WS_W2T = 21 * MiB, WS_PW = 21 * MiB + 64 * 1024, WS_KMEAN = 21 * MiB + 128 * 1024,
                 WS_CS = 21 * MiB + 256 * 1024, WS_CSTOT = 21 * MiB + 768 * 1024, WS_KCMP = 22 * MiB, WS_VCMP = 22 * MiB + 128 * 1024,
                 WS_KF = 23 * MiB, WS_VF = 51 * MiB, WS_H = 80 * MiB, WS_PA = 112 * MiB, WS_END = 240 * MiB;
constexpr size_t STREAM_ELEMS = (size_t)SEQ * 64;

struct Params {
    const float* x; const float* norm_g; const float* w_in; const float* b_f; const float* b_gate;
    const float* moba_qk_g; const float* nsa_q_g; const float* nsa_k_g; const float* fox_qk_g;
    const float* cmp_pe; const float* cmp_w1; const float* cmp_w2; const float* w_up_moba; const float* w_up_nsa; const float* w_up_fox; const float* w_out;
    float* out; unsigned char* ws; int ph_lo, ph_hi;
};

__device__ __forceinline__ unsigned cvt_pk_bf16(float lo, float hi) { unsigned r; asm volatile("v_cvt_pk_bf16_f32 %0, %1, %2" : "=v"(r) : "v"(lo), "v"(hi)); return r; }
__device__ __forceinline__ float bf2f(unsigned short b) { return __builtin_bit_cast(float, (unsigned)b << 16); }
__device__ __forceinline__ float bflo(unsigned w) { return __builtin_bit_cast(float, w << 16); }
__device__ __forceinline__ float bfhi(unsigned w) { return __builtin_bit_cast(float, w & 0xffff0000u); }
__device__ __forceinline__ unsigned short f2bf(float f) { return (unsigned short)(cvt_pk_bf16(f, 0.f) & 0xffffu); }
__device__ __forceinline__ float shx(float v, int m, int lane) { return __builtin_bit_cast(float, __builtin_amdgcn_ds_bpermute((lane ^ m) << 2, __builtin_bit_cast(int, v))); }
__device__ __forceinline__ int shxi(int v, int m, int lane) { return __builtin_amdgcn_ds_bpermute((lane ^ m) << 2, v); }
__device__ __forceinline__ float shfrom(float v, int src) { return __builtin_bit_cast(float, __builtin_amdgcn_ds_bpermute(src << 2, __builtin_bit_cast(int, v))); }
__device__ __forceinline__ int shfromi(int v, int src) { return __builtin_amdgcn_ds_bpermute(src << 2, v); }
__device__ __forceinline__ float wave_sum(float v, int lane) {
#pragma unroll
    for (int o = 1; o < 64; o <<= 1) v += shx(v, o, lane);
    return v;
}
__device__ __forceinline__ float wave_max(float v, int lane) {
#pragma unroll
    for (int o = 1; o < 64; o <<= 1) v = fmaxf(v, shx(v, o, lane));
    return v;
}
__device__ __forceinline__ int crow(int r, int hi) { return (r & 3) + 8 * (r >> 2) + 4 * hi; }
__device__ __forceinline__ float sigmoidf_(float z) { return 1.f / (1.f + __expf(-z)); }
__device__ __forceinline__ float siluf_(float z) { return z / (1.f + __expf(-z)); }
#define MFMA32(a, b, c) __builtin_amdgcn_mfma_f32_32x32x16_bf16((a), (b), (c), 0, 0, 0)
#define LDS_FENCE() asm volatile("s_waitcnt lgkmcnt(0)" ::: "memory")

namespace pg8 {
typedef unsigned short bf16_t;
constexpr int BM = 256, BK = 64, HALF = 128, HTB = HALF * BK * 2, NXCD = 8, WGM = 8;
__host__ __device__ __forceinline__ int lds_byte(int r, int c) { const int st = (r >> 4) * 2 + (c >> 5), rr = r & 15, cc = c & 31, ob = rr * 64 + cc * 2; return st * 1024 + (ob ^ (((ob >> 9) & 1) << 5)); }
__host__ __device__ __forceinline__ void stage_rc(int b, int& R, int& C) { const int st = b / 1024, sb = b % 1024, swz = sb ^ (((sb >> 9) & 1) << 5); R = (st >> 1) * 16 + swz / 64; C = (st & 1) * 32 + (swz % 64) / 2; }
__host__ __device__ __forceinline__ int perm32(int rho) { const int n = rho >> 4, i = rho & 15; return 8 * (i >> 2) + 4 * n + (i & 3); }
struct Unit { int pm, pn; };
struct Gemm { const bf16_t* A; const bf16_t* Bt; int M, N, K, lda; };
struct StaticOrder {
    int nM, nN, nwg, G, c;
    __device__ void init(int M, int N, int G_, int c_) { nM = M / BM; nN = N / BM; nwg = nM * nN; G = G_; c = c_; }
    __device__ bool next(int i, Unit& u) const {
        const long L = (long)i * G + c; if (L >= nwg) return false;
        int wgid = (int)L; { const int q = nwg / NXCD, r = nwg % NXCD, xcd = wgid % NXCD, off = wgid / NXCD; wgid = (xcd < r ? xcd * (q + 1) : r * (q + 1) + (xcd - r) * q) + off; }
        const int nig = WGM * nN, gid = wgid / nig, fm = gid * WGM, gsz = (nM - fm) < WGM ? (nM - fm) : WGM;
        u.pm = fm + ((wgid % nig) % gsz); u.pn = (wgid % nig) / gsz; return true;
    }
};
struct EpiBf16 {
    bf16_t* O; int ldc;
    __device__ __forceinline__ void operator()(const f32x4 (&acc)[2][2][4][2], const Unit& u, int wr, int wc, int fr, int fq) const {
        const int row0 = u.pm * BM + wr * 64 + fr, col0 = u.pn * BM + wc * 32 + 8 * fq;
#pragma unroll
        for (int ai = 0; ai < 2; ++ai)
#pragma unroll
            for (int m = 0; m < 4; ++m) { bf16_t* rowp = O + (size_t)(row0 + ai * HALF + m * 16) * ldc + col0;
#pragma unroll
                for (int bj = 0; bj < 2; ++bj) { const f32x4 v0 = acc[ai][bj][m][0], v1 = acc[ai][bj][m][1];
                    u32x4 w; w.x = cvt_pk_bf16(v0[0], v0[1]); w.y = cvt_pk_bf16(v0[2], v0[3]); w.z = cvt_pk_bf16(v1[0], v1[1]); w.w = cvt_pk_bf16(v1[2], v1[3]);
                    *(u32x4*)(rowp + bj * HALF) = w; } }
    }
};
struct EpiMerge {
    bf16_t* Mg; const bf16_t* gl; const float* bg; int first;
    __device__ __forceinline__ void operator()(const f32x4 (&acc)[2][2][4][2], const Unit& u, int wr, int wc, int fr, int fq) const {
        const int row0 = u.pm * BM + wr * 64 + fr, col0 = u.pn * BM + wc * 32 + 8 * fq;
#pragma unroll
        for (int bj = 0; bj < 2; ++bj) {
            const int col = col0 + bj * HALF;
            const f32x4 b0 = *(const f32x4*)(bg + col), b1 = *(const f32x4*)(bg + col + 4);
#pragma unroll
            for (int ai = 0; ai < 2; ++ai)
#pragma unroll
                for (int m = 0; m < 4; ++m) {
                    const size_t row = (size_t)(row0 + ai * HALF + m * 16);
                    const u32x4 g = *(const u32x4*)(gl + row * PAC + col);
                    const f32x4 a0 = acc[ai][bj][m][0], a1 = acc[ai][bj][m][1];
                    float v[8];
                    v[0] = a0[0] * sigmoidf_(bflo(g.x) + b0[0]); v[1] = a0[1] * sigmoidf_(bfhi(g.x) + b0[1]);
                    v[2] = a0[2] * sigmoidf_(bflo(g.y) + b0[2]); v[3] = a0[3] * sigmoidf_(bfhi(g.y) + b0[3]);
                    v[4] = a1[0] * sigmoidf_(bflo(g.z) + b1[0]); v[5] = a1[1] * sigmoidf_(bfhi(g.z) + b1[1]);
                    v[6] = a1[2] * sigmoidf_(bflo(g.w) + b1[2]); v[7] = a1[3] * sigmoidf_(bfhi(g.w) + b1[3]);
                    bf16_t* mp = Mg + row * DM + col;
                    if (!first) { const u32x4 p = *(const u32x4*)mp;
                        v[0] += bflo(p.x); v[1] += bfhi(p.x); v[2] += bflo(p.y); v[3] += bfhi(p.y); v[4] += bflo(p.z); v[5] += bfhi(p.z); v[6] += bflo(p.w); v[7] += bfhi(p.w); }
                    u32x4 w; w.x = cvt_pk_bf16(v[0], v[1]); w.y = cvt_pk_bf16(v[2], v[3]); w.z = cvt_pk_bf16(v[4], v[5]); w.w = cvt_pk_bf16(v[6], v[7]);
                    *(u32x4*)mp = w;
                }
        }
    }
};
struct EpiOut {
    const float* xin; float* out;
    __device__ __forceinline__ void operator()(const f32x4 (&acc)[2][2][4][2], const Unit& u, int wr, int wc, int fr, int fq) const {
        const int row0 = u.pm * BM + wr * 64 + fr, col0 = u.pn * BM + wc * 32 + 8 * fq;
#pragma unroll
        for (int ai = 0; ai < 2; ++ai)
#pragma unroll
            for (int m = 0; m < 4; ++m)
#pragma unroll
                for (int bj = 0; bj < 2; ++bj) {
                    const size_t off = (size_t)(row0 + ai * HALF + m * 16) * DM + col0 + bj * HALF;
                    const f32x4 x0 = *(const f32x4*)(xin + off), x1 = *(const f32x4*)(xin + off + 4);
                    *(f32x4*)(out + off) = x0 + acc[ai][bj][m][0]; *(f32x4*)(out + off + 4) = x1 + acc[ai][bj][m][1];
                }
    }
};

template <class Epi, class Sched>
__device__ __forceinline__ void gemm_phase(LAS unsigned char* lds, const Gemm g, const Sched& S, const Epi& E, const int tid) {
    const int wid = __builtin_amdgcn_readfirstlane(tid >> 6), lane = tid & 63, wr = wid >> 2, wc = wid & 3, fr = lane & 15, fq = lane >> 4;
    const int K = g.K, nt = K / BK, lda = g.lda;
    unsigned voffA[2], voffB[2];
#pragma unroll
    for (int i = 0; i < 2; ++i) { int R, C; stage_rc(tid * 16 + i * 8192, R, C); const int Rb = (R & ~31) + perm32(R & 31);
        voffA[i] = (unsigned)(R * lda + C) * 2u; voffB[i] = (unsigned)(Rb * K + C) * 2u; }
    const size_t kstep = (size_t)(BK * 2);
    const size_t hstepA = (size_t)HALF * lda * 2, hstepB = (size_t)HALF * K * 2;
    const size_t tstepA = 2 * hstepA, tstepB = 2 * hstepB;
    const unsigned ldsw = (unsigned)wid * 1024u;
    const int aoff = lds_byte(wr * 64 + fr, fq * 8), boff = lds_byte(wc * 32 + fr, fq * 8);
#define PG8_SA(b, h) (((b) * 2 + (h)) * HTB)
#define PG8_SB(b, h) ((4 + (b) * 2 + (h)) * HTB)
#define PG8_STAGE(bufoff, gbase, voff) do { _Pragma("unroll") for (int _i = 0; _i < 2; ++_i) \
        __builtin_amdgcn_global_load_lds((const unsigned*)((const char*)(gbase) + (voff)[_i]), (LAS unsigned*)(lds + (bufoff) + ldsw + _i * 8192), 16, 0, 0); } while (0)
#define PG8_LDA(dst, b, h) do { _Pragma("unroll") for (int m = 0; m < 4; ++m) _Pragma("unroll") for (int k = 0; k < 2; ++k) dst[m][k] = *(const LAS bf16x8*)(lds + PG8_SA(b, h) + aoff + m * 2048 + k * 1024); } while (0)
#define PG8_LDB(dst, b, h) do { _Pragma("unroll") for (int n = 0; n < 2; ++n) _Pragma("unroll") for (int k = 0; k < 2; ++k) dst[n][k] = *(const LAS bf16x8*)(lds + PG8_SB(b, h) + boff + n * 2048 + k * 1024); } while (0)
#define PG8_MMA(ai, bj, At, Bt) do { __builtin_amdgcn_s_setprio(1); _Pragma("unroll") for (int m = 0; m < 4; ++m) _Pragma("unroll") for (int n = 0; n < 2; ++n) _Pragma("unroll") for (int k = 0; k < 2; ++k) \
        acc[ai][bj][m][n] = __builtin_amdgcn_mfma_f32_16x16x32_bf16(Bt[n][k], At[m][k], acc[ai][bj][m][n], 0, 0, 0); __builtin_amdgcn_s_setprio(0); } while (0)
#define PG8_WAIT_V(n) asm volatile("s_waitcnt vmcnt(" #n ")" ::: "memory")
#define PG8_WAIT_L(n) asm volatile("s_waitcnt lgkmcnt(" #n ")" ::: "memory")
#define PG8_BAR __builtin_amdgcn_s_barrier()
#define PG8_SCHED __builtin_amdgcn_sched_barrier(0)
    Unit cur, nxt; int ui = 0;
    if (!S.next(0, cur)) return;
    f32x4 acc[2][2][4][2];
#pragma unroll
    for (int a = 0; a < 2; ++a)
#pragma unroll
        for (int b = 0; b < 2; ++b)
#pragma unroll
            for (int m = 0; m < 4; ++m)
#pragma unroll
                for (int n = 0; n < 2; ++n) acc[a][b][m][n] = (f32x4){0.f, 0.f, 0.f, 0.f};
    bf16x8 At[4][2], B0[2][2], B1[2][2];
    const char* cA = (const char*)g.A + (size_t)cur.pm * tstepA; const char* cB = (const char*)g.Bt + (size_t)cur.pn * tstepB;
    PG8_STAGE(PG8_SB(0, 0), cB, voffB); PG8_STAGE(PG8_SB(0, 1), cB + hstepB, voffB); PG8_STAGE(PG8_SA(0, 0), cA, voffA); PG8_STAGE(PG8_SA(0, 1), cA + hstepA, voffA);
    if (wr == 1) PG8_BAR;
    PG8_WAIT_V(2); PG8_BAR;
    PG8_STAGE(PG8_SB(1, 0), cB + kstep, voffB); PG8_STAGE(PG8_SA(1, 0), cA + kstep, voffA); PG8_STAGE(PG8_SB(1, 1), cB + hstepB + kstep, voffB);
    PG8_WAIT_V(6); PG8_BAR;
    for (;;) {
        const bool has_next = S.next(ui + 1, nxt);
        const char* nA = has_next ? (const char*)g.A + (size_t)nxt.pm * tstepA : cA; const char* nB = has_next ? (const char*)g.Bt + (size_t)nxt.pn * tstepB : cB;
        for (int t = 0; t < nt; t += 2) {
            const bool last = (t == nt - 2);
            const char* a1 = cA + (size_t)(t + 1) * kstep;
            const char* a2 = last ? nA : cA + (size_t)(t + 2) * kstep; const char* b2 = last ? nB : cB + (size_t)(t + 2) * kstep;
            const char* a3 = a2 + kstep; const char* b3 = b2 + kstep;
            PG8_LDB(B0, 0, 0); PG8_LDB(B1, 0, 1); PG8_SCHED; PG8_LDA(At, 0, 0); PG8_STAGE(PG8_SA(1, 1), a1 + hstepA, voffA);
            PG8_WAIT_V(8); PG8_WAIT_L(0); PG8_BAR; PG8_MMA(0, 0, At, B0); PG8_MMA(0, 1, At, B1); PG8_BAR; PG8_SCHED;
            PG8_LDA(At, 0, 1); PG8_STAGE(PG8_SB(0, 0), b2, voffB); PG8_STAGE(PG8_SB(0, 1), b2 + hstepB, voffB); PG8_STAGE(PG8_SA(0, 0), a2, voffA);
            PG8_WAIT_V(8); PG8_WAIT_L(0); PG8_BAR; PG8_MMA(1, 0, At, B0); PG8_MMA(1, 1, At, B1); PG8_BAR; PG8_SCHED;
            PG8_LDB(B0, 1, 0); PG8_LDB(B1, 1, 1); PG8_SCHED; PG8_LDA(At, 1, 0); PG8_STAGE(PG8_SA(0, 1), a2 + hstepA, voffA);
            PG8_WAIT_V(8); PG8_WAIT_L(0); PG8_BAR; PG8_MMA(0, 0, At, B0); PG8_MMA(0, 1, At, B1); PG8_BAR; PG8_SCHED;
            PG8_LDA(At, 1, 1); PG8_STAGE(PG8_SB(1, 0), b3, voffB); PG8_STAGE(PG8_SB(1, 1), b3 + hstepB, voffB); PG8_STAGE(PG8_SA(1, 0), a3, voffA);
            PG8_WAIT_V(8); PG8_WAIT_L(0); PG8_BAR; PG8_MMA(1, 0, At, B0); PG8_MMA(1, 1, At, B1); PG8_BAR; PG8_SCHED;
        }
        if (wr == 0) PG8_BAR;
        E(acc, cur, wr, wc, fr, fq);
        if (!has_next) break;
#pragma unroll
        for (int a = 0; a < 2; ++a)
#pragma unroll
            for (int b = 0; b < 2; ++b)
#pragma unroll
                for (int m = 0; m < 4; ++m)
#pragma unroll
                    for (int n = 0; n < 2; ++n) acc[a][b][m][n] = (f32x4){0.f, 0.f, 0.f, 0.f};
        cur = nxt; cA = nA; cB = nB; ++ui;
        if (wr == 1) PG8_BAR;
    }
    PG8_WAIT_V(0);
    PG8_BAR;
#undef PG8_SA
#undef PG8_SB
#undef PG8_STAGE
#undef PG8_LDA
#undef PG8_LDB
#undef PG8_MMA
#undef PG8_WAIT_V
#undef PG8_WAIT_L
#undef PG8_BAR
#undef PG8_SCHED
}
}

struct Frame { LAS unsigned char* lds; int tid, lane, wave, gw, NGW; unsigned char* ws; bf16* PA; };

__device__ __forceinline__ int srcA(int n) {
    if (n < 384) return 384 + n;
    if (n < 768) return 768 + (n - 384);
    if (n < 1024) return 1792 + (n - 768);
    if (n < 1408) return n - 1024;
    if (n < 1792) return 1152 + (n - 1408);
    if (n < 2048) return 1536 + (n - 1792);
    if (n < 2176) return 2048 + (n - 2048);
    if (n < 2432) return 2188 + (n - 2176);
    if (n < 3584) return 2444 + (n - 2432);
    if (n < 3968) return 3602 + (n - 3584);
    if (n < 3980) return 2176 + (n - 3968);
    if (n < 3986) return 3596 + (n - 3980);
    return -1;
}
__device__ __forceinline__ void tr_item(const float* W, int ldw, bf16* WT, int Kd, int k0, int n0, int mode, int off, LAS float* scr, int lane) {
    const int nn = n0 + (lane & 31);
    const int sc = mode == 0 ? srcA(nn) : nn + off;
#pragma unroll 8
    for (int i = 0; i < 32; ++i) { const int kk = 2 * i + (lane >> 5); scr[kk * 33 + (lane & 31)] = sc >= 0 ? W[(size_t)(k0 + kk) * ldw + sc] : 0.f; }
    LDS_FENCE();
    const int c = lane & 7;
#pragma unroll
    for (int j = 0; j < 4; ++j) { const int n = (lane >> 3) + 8 * j; const LAS float* s = scr + (8 * c) * 33 + n;
        u32x4 o; o.x = cvt_pk_bf16(s[0 * 33], s[1 * 33]); o.y = cvt_pk_bf16(s[2 * 33], s[3 * 33]); o.z = cvt_pk_bf16(s[4 * 33], s[5 * 33]); o.w = cvt_pk_bf16(s[6 * 33], s[7 * 33]);
        *(u32x4*)(WT + (size_t)(n0 + n) * Kd + k0 + 8 * c) = o; }
    LDS_FENCE();
}
__device__ __forceinline__ void phase0(const Params& P, const Frame& F, int layer, const float* xin) {
    LAS float* scr = (LAS float*)(F.lds + F.wave * 16384);
    unsigned char* ws = F.ws;
    if (F.gw == 0 && F.lane == 0) ((unsigned*)(ws + WS_CTL))[16 * layer] = 0u;
    constexpr int I_A = 16 * 128, I_G = 16 * 96, I_UM = 6 * 32, I_UN = 4 * 32, I_UF = 6 * 32, I_O = 16 * 32, I_1 = 32 * 8, I_2 = 4 * 2;
    constexpr int NIT = I_A + I_G + I_UM + I_UN + I_UF + I_O + 2 * I_1 + 2 * I_2;
    const float* w_in = P.w_in + (size_t)layer * DM * INC;
    for (int it = F.gw; it < NIT; it += F.NGW) {
        int r = it;
        if (r < I_A) { tr_item(w_in, INC, (bf16*)(ws + WS_WA), 1024, 64 * (r / 128), 32 * (r % 128), 0, 0, scr, F.lane); continue; } r -= I_A;
        if (r < I_G) { tr_item(w_in, INC, (bf16*)(ws + WS_WG), 1024, 64 * (r / 96), 32 * (r % 96), 1, 3986, scr, F.lane); continue; } r -= I_G;
        if (r < I_UM) { tr_item(P.w_up_moba + (size_t)layer * 384 * 1024, 1024, (bf16*)(ws + WS_WUPM), 384, 64 * (r / 32), 32 * (r % 32), 1, 0, scr, F.lane); continue; } r -= I_UM;
        if (r < I_UN) { tr_item(P.w_up_nsa + (size_t)layer * 256 * 1024, 1024, (bf16*)(ws + WS_WUPN), 256, 64 * (r / 32), 32 * (r % 32), 1, 0, scr, F.lane); continue; } r -= I_UN;
        if (r < I_UF) { tr_item(P.w_up_fox + (size_t)layer * 384 * 1024, 1024, (bf16*)(ws + WS_WUPF), 384, 64 * (r / 32), 32 * (r % 32), 1, 0, scr, F.lane); continue; } r -= I_UF;
        if (r < I_O) { tr_item(P.w_out + (size_t)layer * 1024 * 1024, 1024, (bf16*)(ws + WS_WO), 1024, 64 * (r / 32), 32 * (r % 32), 1, 0, scr, F.lane); continue; } r -= I_O;
        if (r < 2 * I_1) { const int kv = r / I_1; r %= I_1;
            tr_item(P.cmp_w1 + (size_t)(layer * 2 + kv) * 2048 * 256, 256, (bf16*)(ws + WS_W1T) + (size_t)kv * 256 * 2048, 2048, 64 * (r / 8), 32 * (r % 8), 1, 0, scr, F.lane); continue; } r -= 2 * I_1;
        { const int kv = r / I_2; r %= I_2;
            tr_item(P.cmp_w2 + (size_t)(layer * 2 + kv) * 256 * 64, 64, (bf16*)(ws + WS_W2T) + (size_t)kv * 64 * 256, 256, 64 * (r / 2), 32 * (r % 2), 1, 0, scr, F.lane); }
    }
    for (int it = F.gw; it < 8; it += F.NGW) {
        const int kv = it >> 2, n = (it & 3) * 64 + F.lane;
        const float* pe = P.cmp_pe + (size_t)(layer * 2 + kv) * 2048; const float* w1 = P.cmp_w1 + (size_t)(layer * 2 + kv) * 2048 * 256 + n;
        float s0 = 0.f, s1 = 0.f, s2 = 0.f, s3 = 0.f;
        for (int k = 0; k < 2048; k += 4) { s0 += pe[k] * w1[(size_t)k * 256]; s1 += pe[k + 1] * w1[(size_t)(k + 1) * 256]; s2 += pe[k + 2] * w1[(size_t)(k + 2) * 256]; s3 += pe[k + 3] * w1[(size_t)(k + 3) * 256]; }
        ((float*)(ws + WS_PW))[kv * 256 + n] = (s0 + s1) + (s2 + s3);
    }
    const float* g = P.norm_g + layer * DM; bf16* H = (bf16*)(ws + WS_H);
    for (int m = F.gw; m < SEQ; m += F.NGW) {
        const f32x4* xr = (const f32x4*)(xin + (size_t)m * DM) + F.lane;
        f32x4 v[4]; float s = 0.f;
#pragma unroll
        for (int j = 0; j < 4; ++j) { v[j] = xr[64 * j]; s += (v[j].x * v[j].x + v[j].y * v[j].y) + (v[j].z * v[j].z + v[j].w * v[j].w); }
        const float rs = rsqrtf(wave_sum(s, F.lane) * (1.f / DM) + RMS_EPS);
        unsigned long long* o8 = (unsigned long long*)(H + (size_t)m * DM) + F.lane;
#pragma unroll
        for (int j = 0; j < 4; ++j) { const f32x4 gg = ((const f32x4*)g)[F.lane + 64 * j];
            o8[64 * j] = (unsigned long long)cvt_pk_bf16(v[j].x * rs * gg.x, v[j].y * rs * gg.y) | ((unsigned long long)cvt_pk_bf16(v[j].z * rs * gg.z, v[j].w * rs * gg.w) << 32); }
    }
}

__device__ __forceinline__ void rope_sincos(float pos, int i, float& cs, float& sn) {
    constexpr float INV[8] = {1.0f, 0.1939227432012558f, 0.03760603070259094f, 0.007292664609849453f, 0.0014142135623842478f, 0.00027424818836152554f, 5.3182957344688475e-05f, 1.0313385246263351e-05f};
    const float ang = pos * INV[i];
    double rev = (double)ang * 0.15915494309189535; rev -= floor(rev);
    const float fr = (float)rev;
    sn = __builtin_amdgcn_sinf(fr); cs = __builtin_amdgcn_cosf(fr);
}
__device__ __forceinline__ void p2_normrow(const Params& P, const Frame& F, int layer, int idx) {
    const int t = idx / 30, slot = idx - t * 30;
    int col, kstream = -1; const float* g; bool rope = true; float osc = 1.f;
    if (slot < 6) { col = C_MQ + slot * 64; g = P.moba_qk_g + layer * 128; osc = C2; }
    else if (slot < 12) { col = C_MK + (slot - 6) * 64; g = P.moba_qk_g + layer * 128 + 64; kstream = slot - 6; }
    else if (slot < 16) { col = C_NQ + (slot - 12) * 64; g = P.nsa_q_g + layer * 64; osc = C2; }
    else if (slot == 16) { col = C_KSL; g = P.nsa_k_g + layer * 192 + 64; kstream = 6; }
    else if (slot == 17) { col = C_KW; g = P.nsa_k_g + layer * 192 + 128; kstream = 7; }
    else if (slot < 24) { col = C_FQ + (slot - 18) * 64; g = P.fox_qk_g + layer * 128; rope = false; osc = C2; }
    else { col = C_FK + (slot - 24) * 64; g = P.fox_qk_g + layer * 128 + 64; rope = false; kstream = 8 + (slot - 24); }
    bf16* rowp = F.PA + (size_t)t * PAC + col;
    float v[64];
    float ss = 0.f;
#pragma unroll
    for (int j = 0; j < 8; ++j) { const u32x4 w = ((const u32x4*)rowp)[j];
        v[8 * j + 0] = bflo(w.x); v[8 * j + 1] = bfhi(w.x); v[8 * j + 2] = bflo(w.y); v[8 * j + 3] = bfhi(w.y);
        v[8 * j + 4] = bflo(w.z); v[8 * j + 5] = bfhi(w.z); v[8 * j + 6] = bflo(w.w); v[8 * j + 7] = bfhi(w.w); }
#pragma unroll
    for (int d = 0; d < 64; ++d) ss += v[d] * v[d];
    const float rs = rsqrtf(ss * (1.f / 64.f) + RMS_EPS);
#pragma unroll
    for (int d = 0; d < 64; ++d) v[d] = v[d] * rs * g[d];
    if (rope) {
#pragma unroll
        for (int i = 0; i < 8; ++i) { float cs, sn; rope_sincos((float)t, i, cs, sn); const float a = v[i], b = v[i + 8]; v[i] = a * cs - b * sn; v[i + 8] = b * cs + a * sn; }
    }
    bf16* dst; int dstep;
    if (kstream < 0) { dst = rowp; dstep = 8; }
    else { dst = (bf16*)(F.ws + WS_KF) + (size_t)kstream * STREAM_ELEMS + ((size_t)(t >> 5) * 256 + (t & 31)) * 8; dstep = 0; }
#pragma unroll
    for (int j = 0; j < 8; ++j) {
        u32x4 w; w.x = cvt_pk_bf16(v[8 * j] * osc, v[8 * j + 1] * osc); w.y = cvt_pk_bf16(v[8 * j + 2] * osc, v[8 * j + 3] * osc);
        w.z = cvt_pk_bf16(v[8 * j + 4] * osc, v[8 * j + 5] * osc); w.w = cvt_pk_bf16(v[8 * j + 6] * osc, v[8 * j + 7] * osc);
        bf16* p = kstream < 0 ? dst + 8 * j : dst + ((j >> 1) * 64 + (j & 1) * 32) * 8;
        *(u32x4*)p = w;
    }
    (void)dstep;
}
__device__ __forceinline__ void p2_vfrag(const Frame& F, size_t f) {
    const int st = (int)(f >> 17); const int r = (int)(f & 131071);
    const int T = r >> 8, dt = (r >> 7) & 1, s = (r >> 6) & 1, ln = r & 63, c = ln & 31, hg = ln >> 5;
    const int col0 = st < 6 ? C_MV + st * 64 : (st == 6 ? C_VSL : (st == 7 ? C_VW : C_FV + (st - 8) * 64));
    const bf16* src = F.PA + (size_t)(32 * T + 16 * s + 4 * hg) * PAC + col0 + dt * 32 + c;
    unsigned short e[8];
#pragma unroll
    for (int j = 0; j < 8; ++j) e[j] = src[(size_t)((j & 3) + 8 * (j >> 2)) * PAC];
    u32x4 w; w.x = e[0] | ((unsigned)e[1] << 16); w.y = e[2] | ((unsigned)e[3] << 16); w.z = e[4] | ((unsigned)e[5] << 16); w.w = e[6] | ((unsigned)e[7] << 16);
    *(u32x4*)((bf16*)(F.ws + WS_VF) + (size_t)st * STREAM_ELEMS + (size_t)r * 8) = w;
}
__device__ __forceinline__ void p2_compress(const Params& P, const Frame& F, int layer, int item) {
    const int kv = item >> 5, T = item & 31, lane = F.lane, c = lane & 31, hg = lane >> 5;
    const int col0 = C_KC + kv * 64;
    const bf16* W1T = (const bf16*)(F.ws + WS_W1T) + (size_t)kv * 256 * 2048;
    const bf16* W2T = (const bf16*)(F.ws + WS_W2T) + (size_t)kv * 64 * 256;
    const float* pw = (const float*)(F.ws + WS_PW) + kv * 256;
    f32x16 acc[8];
#pragma unroll
    for (int nt = 0; nt < 8; ++nt)
#pragma unroll
        for (int r = 0; r < 16; ++r) acc[nt][r] = 0.f;
    const int blk = 32 * T + c;
    for (int ks = 0; ks < 128; ++ks) {
        const int pos = ks >> 2, dsub = (ks & 3) * 16;
        int row = 16 * blk + pos; row = row > SEQ - 1 ? SEQ - 1 : row;
        const bf16x8 b = *(const bf16x8*)(F.PA + (size_t)row * PAC + col0 + dsub + hg * 8);
#pragma unroll
        for (int nt = 0; nt < 8; ++nt) {
            const bf16x8 a = *(const bf16x8*)(W1T + (size_t)(nt * 32 + c) * 2048 + ks * 16 + hg * 8);
            acc[nt] = MFMA32(a, b, acc[nt]);
        }
    }
    f32x16 o[2];
#pragma unroll
    for (int r = 0; r < 16; ++r) { o[0][r] = 0.f; o[1][r] = 0.f; }
#pragma unroll
    for (int nt = 0; nt < 8; ++nt) {
        float hv[16];
#pragma unroll
        for (int r = 0; r < 16; ++r) hv[r] = siluf_(acc[nt][r] + pw[nt * 32 + crow(r, hg)]);
#pragma unroll
        for (int s = 0; s < 2; ++s) {
            u32x4 pw4; pw4.x = cvt_pk_bf16(hv[8 * s], hv[8 * s + 1]); pw4.y = cvt_pk_bf16(hv[8 * s + 2], hv[8 * s + 3]); pw4.z = cvt_pk_bf16(hv[8 * s + 4], hv[8 * s + 5]); pw4.w = cvt_pk_bf16(hv[8 * s + 6], hv[8 * s + 7]);
            const bf16x8 pb = __builtin_bit_cast(bf16x8, pw4);
#pragma unroll
            for (int dt = 0; dt < 2; ++dt) {
                const bf16* wp = W2T + (size_t)(dt * 32 + c) * 256 + nt * 32 + 16 * s + 4 * hg;
                const u32x2 lo = *(const u32x2*)wp, hi = *(const u32x2*)(wp + 8);
                u32x4 aw; aw.x = lo.x; aw.y = lo.y; aw.z = hi.x; aw.w = hi.y;
                o[dt] = MFMA32(__builtin_bit_cast(bf16x8, aw), pb, o[dt]);
            }
        }
    }
    if (kv == 0) {
        const float* g = P.nsa_k_g + layer * 192;
        float ss = 0.f;
#pragma unroll
        for (int dt = 0; dt < 2; ++dt)
#pragma unroll
            for (int r = 0; r < 16; ++r) ss += o[dt][r] * o[dt][r];
        ss += shx(ss, 32, lane);
        const float rs = rsqrtf(ss * (1.f / 64.f) + RMS_EPS);
#pragma unroll
        for (int dt = 0; dt < 2; ++dt)
#pragma unroll
            for (int r = 0; r < 16; ++r) o[dt][r] = o[dt][r] * rs * g[dt * 32 + crow(r, hg)];
        const float pos = (float)(16 * blk + 31);
#pragma unroll
        for (int r = 0; r < 4; ++r) {
            float c0, s0, c1, s1; rope_sincos(pos, r, c0, s0); rope_sincos(pos, r + 4, c1, s1);
            const float cs = hg ? c1 : c0, sn = hg ? s1 : s0;
            const float a = o[0][r], b = o[0][r + 4]; o[0][r] = a * cs - b * sn; o[0][r + 4] = b * cs + a * sn;
        }
        bf16* KC = (bf16*)(F.ws + WS_KCMP);
#pragma unroll
        for (int dt = 0; dt < 2; ++dt)
#pragma unroll
            for (int gq = 0; gq < 4; ++gq) {
                const int ks = dt * 2 + (gq >> 1), hgp = gq & 1;
                u32x2 w; w.x = cvt_pk_bf16(o[dt][4 * gq], o[dt][4 * gq + 1]); w.y = cvt_pk_bf16(o[dt][4 * gq + 2], o[dt][4 * gq + 3]);
                *(u32x2*)(KC + ((size_t)(T * 4 + ks) * 64 + hgp * 32 + c) * 8 + 4 * hg) = w;
            }
    } else {
        bf16* VC = (bf16*)(F.ws + WS_VCMP);
        const int s = c >> 4, hgp = (c >> 2) & 1, j = ((c >> 3) & 1) * 4 + (c & 3);
#pragma unroll
        for (int dt = 0; dt < 2; ++dt)
#pragma unroll
            for (int r = 0; r < 16; ++r)
                VC[((size_t)((T * 2 + dt) * 2 + s) * 64 + hgp * 32 + crow(r, hg)) * 8 + j] = f2bf(o[dt][r]);
    }
}
__device__ __forceinline__ void phase2(const Params& P, const Frame& F, int layer) {
#ifndef NO_CMP
    if (F.gw < 64) p2_compress(P, F, layer, F.gw);
#endif
    for (int it = F.gw; it < 6 * 256; it += F.NGW) {
        const int h = it >> 8, ch = it & 255, t = ch * 64 + F.lane;
        const float z = bf2f(F.PA[(size_t)t * PAC + C_FF + h]) + P.b_f[layer * 6 + h];
        float v = (fminf(z, 0.f) - log1pf(__expf(-fabsf(z)))) * LOG2E;
#pragma unroll
        for (int o = 1; o < 64; o <<= 1) { const float y = shfrom(v, (F.lane - o) & 63); if (F.lane >= o) v += y; }
        ((float*)(F.ws + WS_CS))[h * SEQ + t] = v;
        if (F.lane == 63) ((float*)(F.ws + WS_CSTOT))[h * 256 + ch] = v;
    }
#ifndef NO_NORMROW
    for (int it = F.gw; it < SEQ * 30 / 64; it += F.NGW) p2_normrow(P, F, layer, it * 64 + F.lane);
#endif
    for (int it = F.gw; it < 14 * 131072 / 64; it += F.NGW) p2_vfrag(F, (size_t)it * 64 + F.lane);
}

__device__ __forceinline__ void phase3(const Frame& F) {
    for (int it = F.gw; it < 384; it += F.NGW) {
        const int h = it >> 6, blk = it & 63, d = F.lane, ks = d >> 4, hg = (d >> 3) & 1, j = d & 7;
        const bf16* kf = (const bf16*)(F.ws + WS_KF) + (size_t)h * STREAM_ELEMS;
        float s = 0.f;
        for (int T = blk * 8; T < blk * 8 + 8; ++T)
#pragma unroll 8
            for (int c = 0; c < 32; ++c) s += bf2f(kf[((size_t)(T * 4 + ks) * 64 + hg * 32 + c) * 8 + j]);
        ((float*)(F.ws + WS_KMEAN))[(h * 64 + blk) * 64 + d] = s * (1.f / 256.f);
    }
    for (int it = F.gw; it < 6 * 256; it += F.NGW) {
        const int h = it >> 8, ch = it & 255;
        const float* tot = (const float*)(F.ws + WS_CSTOT) + h * 256;
        float s = 0.f;
        for (int cc = F.lane; cc < ch; cc += 64) s += tot[cc];
        s = wave_sum(s, F.lane);
        float* cs = (float*)(F.ws + WS_CS) + h * SEQ + ch * 64 + F.lane;
        *cs = *cs + s;
    }
}

__device__ __forceinline__ f32x16 qk_tile(const bf16* Kt, const bf16x8 (&qf)[4], int lane) {
    const bf16x8* p = (const bf16x8*)Kt + lane;
    f32x16 s;
#pragma unroll
    for (int r = 0; r < 16; ++r) s[r] = 0.f;
#pragma unroll
    for (int ks = 0; ks < 4; ++ks) s = MFMA32(p[ks * 64], qf[ks], s);
    return s;
}
__device__ __forceinline__ void pv_tile(const bf16* Vt, const float (&e)[16], f32x16 (&o)[2], int lane) {
    const bf16x8* p = (const bf16x8*)Vt + lane;
    u32x4 w0, w1;
    w0.x = cvt_pk_bf16(e[0], e[1]); w0.y = cvt_pk_bf16(e[2], e[3]); w0.z = cvt_pk_bf16(e[4], e[5]); w0.w = cvt_pk_bf16(e[6], e[7]);
    w1.x = cvt_pk_bf16(e[8], e[9]); w1.y = cvt_pk_bf16(e[10], e[11]); w1.z = cvt_pk_bf16(e[12], e[13]); w1.w = cvt_pk_bf16(e[14], e[15]);
    const bf16x8 pb0 = __builtin_bit_cast(bf16x8, w0), pb1 = __builtin_bit_cast(bf16x8, w1);
    o[0] = MFMA32(p[0], pb0, o[0]); o[0] = MFMA32(p[64], pb1, o[0]);
    o[1] = MFMA32(p[128], pb0, o[1]); o[1] = MFMA32(p[192], pb1, o[1]);
}
__device__ __forceinline__ float gain_bound(const float* gq, const float* gk, int lane) {
    const float a = wave_max(fabsf(gq[lane]), lane), b = wave_max(fabsf(gk[lane]), lane);
    return (8.f * a * b * 1.02f + 0.05f) * LOG2E;
}
__device__ __forceinline__ void write_gated(const Frame& F, const f32x16 (&o)[2], float scale, int t, int ocol, int zcol, int hg) {
    bf16* rowp = F.PA + (size_t)t * PAC;
#pragma unroll
    for (int dt = 0; dt < 2; ++dt)
#pragma unroll
        for (int g = 0; g < 4; ++g) {
            const int d0 = dt * 32 + 8 * g + 4 * hg;
            const u32x2 z = *(const u32x2*)(rowp + zcol + d0);
            u32x2 w;
            w.x = cvt_pk_bf16(o[dt][4 * g] * scale * siluf_(bflo(z.x)), o[dt][4 * g + 1] * scale * siluf_(bfhi(z.x)));
            w.y = cvt_pk_bf16(o[dt][4 * g + 2] * scale * siluf_(bflo(z.y)), o[dt][4 * g + 3] * scale * siluf_(bfhi(z.y)));
            *(u32x2*)(rowp + ocol + d0) = w;
        }
}
#define ZERO_O(o) do { _Pragma("unroll") for (int _r = 0; _r < 16; ++_r) { o[0][_r] = 0.f; o[1][_r] = 0.f; } } while (0)

__device__ __forceinline__ void unit_moba(const Params& P, const Frame& F, int layer, int h, int qg) {
    const int lane = F.lane, c = lane & 31, hg = lane >> 5, t0 = qg * 32, t = t0 + c, cur = t0 >> 8;
    const float SH = gain_bound(P.moba_qk_g + layer * 128, P.moba_qk_g + layer * 128 + 64, lane);
    const bf16* qrow = F.PA + (size_t)t * PAC + C_MQ + h * 64;
    bf16x8 qf[4];
#pragma unroll
    for (int ks = 0; ks < 4; ++ks) qf[ks] = *(const bf16x8*)(qrow + ks * 16 + hg * 8);
    int i1 = -1, i2 = -1, i3 = -1;
    if (cur > 0) {
        float qv[64];
#pragma unroll
        for (int j = 0; j < 8; ++j) { const u32x4 w = ((const u32x4*)qrow)[j];
            qv[8 * j + 0] = bflo(w.x); qv[8 * j + 1] = bfhi(w.x); qv[8 * j + 2] = bflo(w.y); qv[8 * j + 3] = bfhi(w.y);
            qv[8 * j + 4] = bflo(w.z); qv[8 * j + 5] = bfhi(w.z); qv[8 * j + 6] = bflo(w.w); qv[8 * j + 7] = bfhi(w.w); }
        float v1 = -3e38f, v2 = -3e38f, v3 = -3e38f;
        const float* km = (const float*)(F.ws + WS_KMEAN) + (size_t)h * 64 * 64;
        for (int j = 0; j < cur; ++j) {
            float g0 = 0.f, g1 = 0.f;
#pragma unroll
            for (int d = 0; d < 64; d += 2) { g0 += qv[d] * km[j * 64 + d]; g1 += qv[d + 1] * km[j * 64 + d + 1]; }
            const float g = g0 + g1;
            if (g > v3) { if (g > v2) { v3 = v2; i3 = i2; if (g > v1) { v2 = v1; i2 = i1; v1 = g; i1 = j; } else { v2 = g; i2 = j; } } else { v3 = g; i3 = j; } }
        }
    }
    const bf16* KF = (const bf16*)(F.ws + WS_KF) + (size_t)h * STREAM_ELEMS;
    const bf16* VF = (const bf16*)(F.ws + WS_VF) + (size_t)h * STREAM_ELEMS;
    f32x16 o[2]; ZERO_O(o); float l = 0.f;
    for (int j = 0; j < cur; ++j) {
        const bool flag = (j == i1) || (j == i2) || (j == i3);
        if (__ballot(flag) == 0ull) continue;
        for (int tt = 0; tt < 8; ++tt) {
            const int T = j * 8 + tt;
            const f32x16 s = qk_tile(KF + (size_t)T * 2048, qf, lane);
            float e[16];
#pragma unroll
            for (int r = 0; r < 16; ++r) { e[r] = flag ? __builtin_amdgcn_exp2f(s[r] - SH) : 0.f; l += e[r]; }
            pv_tile(VF + (size_t)T * 2048, e, o, lane);
        }
    }
    for (int T = cur * 8; T <= (t0 >> 5); ++T) {
        const f32x16 s = qk_tile(KF + (size_t)T * 2048, qf, lane);
        float e[16];
#pragma unroll
        for (int r = 0; r < 16; ++r) { const int key = 32 * T + crow(r, hg); e[r] = key <= t ? __builtin_amdgcn_exp2f(s[r] - SH) : 0.f; l += e[r]; }
        pv_tile(VF + (size_t)T * 2048, e, o, lane);
    }
    l += shx(l, 32, lane);
    write_gated(F, o, l > 0.f ? 1.f / l : 0.f, t, C_OM + h * 64, C_MZ + h * 64, hg);
}

__device__ __forceinline__ void unit_fox(const Params& P, const Frame& F, int layer, int h, int qg) {
    const int lane = F.lane, c = lane & 31, hg = lane >> 5, t0 = qg * 32, t = t0 + c;
    const float SH = gain_bound(P.fox_qk_g + layer * 128, P.fox_qk_g + layer * 128 + 64, lane);
    const float* cs = (const float*)(F.ws + WS_CS) + (size_t)h * SEQ;
    const bf16* qrow = F.PA + (size_t)t * PAC + C_FQ + h * 64;
    bf16x8 qf[4];
#pragma unroll
    for (int ks = 0; ks < 4; ++ks) qf[ks] = *(const bf16x8*)(qrow + ks * 16 + hg * 8);
    const float cq = cs[t];
    const int Thi = t0 >> 5;
    const float cs0 = cs[t0], lim = -(2.f * SH + 40.f);
    int lo = 0, hi = Thi;
    while (lo < hi) { const int mid = (lo + hi) >> 1; if (cs0 - cs[32 * mid + 31] >= lim) hi = mid; else lo = mid + 1; }
    const bf16* KF = (const bf16*)(F.ws + WS_KF) + (size_t)(8 + h) * STREAM_ELEMS;
    const bf16* VF = (const bf16*)(F.ws + WS_VF) + (size_t)(8 + h) * STREAM_ELEMS;
    f32x16 o[2]; ZERO_O(o); float l = 0.f;
    for (int T = Thi; T >= lo; --T) {
        const f32x16 s = qk_tile(KF + (size_t)T * 2048, qf, lane);
        f32x4 ck[4];
#pragma unroll
        for (int g = 0; g < 4; ++g) ck[g] = *(const f32x4*)(cs + 32 * T + 8 * g + 4 * hg);
        float e[16];
#pragma unroll
        for (int r = 0; r < 16; ++r) { const int key = 32 * T + crow(r, hg);
            e[r] = key <= t ? __builtin_amdgcn_exp2f(s[r] - SH + (cq - ck[r >> 2][r & 3])) : 0.f; l += e[r]; }
        pv_tile(VF + (size_t)T * 2048, e, o, lane);
    }
    l += shx(l, 32, lane);
    write_gated(F, o, l > 0.f ? 1.f / l : 0.f, t, C_OF + h * 64, C_FZ + h * 64, hg);
}

__device__ __forceinline__ void unit_nsa(const Params& P, const Frame& F, int layer, int u) {
    const int lane = F.lane, c = lane & 31, hg = lane >> 5, qi = c >> 2, h = c & 3, t0 = u * 8, t = t0 + qi, cur = t0 >> 6;
    const float* kg = P.nsa_k_g + layer * 192; const float* qg = P.nsa_q_g + layer * 64;
    const float SHc = gain_bound(qg, kg, lane), SHs = gain_bound(qg, kg + 64, lane), SHw = gain_bound(qg, kg + 128, lane);
    const bf16* prow = F.PA + (size_t)t * PAC;
    bf16x8 qf[4];
#pragma unroll
    for (int ks = 0; ks < 4; ++ks) qf[ks] = *(const bf16x8*)(prow + C_NQ + h * 64 + ks * 16 + hg * 8);
    const float g0 = sigmoidf_(bf2f(prow[C_NG + h * 3 + 0])), g1 = sigmoidf_(bf2f(prow[C_NG + h * 3 + 1])), g2 = sigmoidf_(bf2f(prow[C_NG + h * 3 + 2]));
    LAS float* impS = (LAS float*)(F.lds + F.wave * 16384); LAS float* impE = impS + 2048;
    f32x16 accF[2]; ZERO_O(accF);
    f32x16 o[2]; float l;
    const int nmax = (t0 + 7 - 31) >> 4, ntile = (t0 + 7 >= 31) ? (nmax >> 5) + 1 : 0;
    const bf16* KC = (const bf16*)(F.ws + WS_KCMP); const bf16* VC = (const bf16*)(F.ws + WS_VCMP);
    ZERO_O(o); l = 0.f;
    for (int T = 0; T < ntile; ++T) {
        const f32x16 s = qk_tile(KC + (size_t)T * 2048, qf, lane);
        float e[16];
#pragma unroll
        for (int r = 0; r < 16; ++r) { const int n = 32 * T + crow(r, hg); e[r] = (16 * n + 31 <= t) ? __builtin_amdgcn_exp2f(s[r] - SHc) : 0.f; l += e[r]; }
        pv_tile(VC + (size_t)T * 2048, e, o, lane);
    }
    l += shx(l, 32, lane);
    const float invc = l > 0.f ? 1.f / l : 0.f;
    {
        const float sc = g0 * invc;
#pragma unroll
        for (int r = 0; r < 16; ++r) { accF[0][r] += sc * o[0][r]; accF[1][r] += sc * o[1][r]; }
    }
    for (int T = 0; T < ntile; ++T) {
        const f32x16 s = qk_tile(KC + (size_t)T * 2048, qf, lane);
#pragma unroll
        for (int g = 0; g < 4; ++g) {
            float s4 = 0.f, ed = 0.f;
#pragma unroll
            for (int k = 0; k < 4; ++k) { const int r = 4 * g + k; const int n = 32 * T + crow(r, hg);
                const float p = (16 * n + 31 <= t) ? __builtin_amdgcn_exp2f(s[r] - SHc) * invc : 0.f; s4 += p; if (k == 3) ed = p; }
            s4 += shx(s4, 1, lane); s4 += shx(s4, 2, lane); ed += shx(ed, 1, lane); ed += shx(ed, 2, lane);
            const int m = 8 * T + 2 * g + hg;
            if (h == 0) { impS[qi * 256 + m] = s4; if (m + 1 < 256) impE[qi * 256 + m + 1] = ed; }
        }
    }
    LDS_FENCE();
    unsigned long long my0 = 0ull, my1 = 0ull, my2 = 0ull, my3 = 0ull, un0 = 0ull, un1 = 0ull, un2 = 0ull, un3 = 0ull;
    {
        const int qs = lane >> 3, sub = lane & 7;
        float val[32];
#pragma unroll
        for (int k = 0; k < 32; ++k) { const int m = sub + 8 * k;
            const float iv = impS[qs * 256 + m] + impE[qs * 256 + m];
            val[k] = (m > cur) ? -3e38f : ((m == 0 || m == cur || m == cur - 1) ? 3e38f : iv); }
        const int nsel = cur + 1 < 16 ? cur + 1 : 16;
        for (int rd = 0; rd < nsel; ++rd) {
            float bv = val[0]; int bk = 0;
#pragma unroll
            for (int k = 1; k < 32; ++k) if (val[k] > bv) { bv = val[k]; bk = k; }
            int bm = sub + 8 * bk;
#pragma unroll
            for (int of = 1; of < 8; of <<= 1) { const float ov = shx(bv, of, lane); const int om = shxi(bm, of, lane);
                if (ov > bv || (ov == bv && om < bm)) { bv = ov; bm = om; } }
#pragma unroll
            for (int k = 0; k < 32; ++k) if (sub + 8 * k == bm) val[k] = -3e38f;
            const int wa = shfromi(bm, (c >> 2) * 8);
            { const unsigned long long bit = 1ull << (wa & 63); const int kk = wa >> 6;
              my0 |= kk == 0 ? bit : 0ull; my1 |= kk == 1 ? bit : 0ull; my2 |= kk == 2 ? bit : 0ull; my3 |= kk == 3 ? bit : 0ull; }
#pragma unroll
            for (int q = 0; q < 8; ++q) { const int wq = __builtin_amdgcn_readlane(bm, q * 8); const unsigned long long bit = 1ull << (wq & 63); const int kk = wq >> 6;
                un0 |= kk == 0 ? bit : 0ull; un1 |= kk == 1 ? bit : 0ull; un2 |= kk == 2 ? bit : 0ull; un3 |= kk == 3 ? bit : 0ull; }
        }
    }
    LDS_FENCE();
    const bf16* KS = (const bf16*)(F.ws + WS_KF) + (size_t)6 * STREAM_ELEMS; const bf16* VS = (const bf16*)(F.ws + WS_VF) + (size_t)6 * STREAM_ELEMS;
    ZERO_O(o); l = 0.f;
#pragma unroll
    for (int kk = 0; kk < 4; ++kk) {
        unsigned long long uw = kk == 0 ? un0 : (kk == 1 ? un1 : (kk == 2 ? un2 : un3));
        const unsigned long long mw = kk == 0 ? my0 : (kk == 1 ? my1 : (kk == 2 ? my2 : my3));
        while (uw) {
            const int b = __builtin_ctzll(uw); uw &= uw - 1ull;
            const int m = 64 * kk + b; const bool flag = (mw >> b) & 1ull;
            for (int tt = 0; tt < 2; ++tt) {
                const int T = 2 * m + tt;
                const f32x16 s = qk_tile(KS + (size_t)T * 2048, qf, lane);
                float e[16];
#pragma unroll
                for (int r = 0; r < 16; ++r) { const int key = 32 * T + crow(r, hg); e[r] = (flag && key <= t) ? __builtin_amdgcn_exp2f(s[r] - SHs) : 0.f; l += e[r]; }
                pv_tile(VS + (size_t)T * 2048, e, o, lane);
            }
        }
    }
    l += shx(l, 32, lane);
    {
        const float sc = l > 0.f ? g1 / l : 0.f;
#pragma unroll
        for (int r = 0; r < 16; ++r) { accF[0][r] += sc * o[0][r]; accF[1][r] += sc * o[1][r]; }
    }
    const bf16* KW = (const bf16*)(F.ws + WS_KF) + (size_t)7 * STREAM_ELEMS; const bf16* VW = (const bf16*)(F.ws + WS_VF) + (size_t)7 * STREAM_ELEMS;
    ZERO_O(o); l = 0.f;
    const int Tlo = (t0 - 511 > 0 ? t0 - 511 : 0) >> 5, Thi = (t0 + 7) >> 5;
    for (int T = Tlo; T <= Thi; ++T) {
        const f32x16 s = qk_tile(KW + (size_t)T * 2048, qf, lane);
        float e[16];
#pragma unroll
        for (int r = 0; r < 16; ++r) { const int key = 32 * T + crow(r, hg); e[r] = (key <= t && key >= t - 511) ? __builtin_amdgcn_exp2f(s[r] - SHw) : 0.f; l += e[r]; }
        pv_tile(VW + (size_t)T * 2048, e, o, lane);
    }
    l += shx(l, 32, lane);
    {
        const float sc = l > 0.f ? g2 / l : 0.f;
#pragma unroll
        for (int r = 0; r < 16; ++r) { accF[0][r] += sc * o[0][r]; accF[1][r] += sc * o[1][r]; }
    }
    write_gated(F, accF, 1.f, t, C_ON + h * 64, C_NZ + h * 64, hg);
}

__device__ __forceinline__ void phase4(const Params& P, const Frame& F0, int layer) {
    unsigned* ctr = (unsigned*)(F0.ws + WS_CTL) + 16 * layer;
    constexpr int N_MOBA = 6 * 512, N_NSA = 2048, N_FOX = 6 * 512, N_ALL = N_MOBA + N_NSA + N_FOX;
    for (;;) {
        Frame F = F0;
        { unsigned char* w = F0.ws; asm volatile("" : "+s"(w)); int tv = F0.tid; asm volatile("" : "+v"(tv)); F.ws = w; F.PA = (bf16*)(w + WS_PA); F.tid = tv; F.lane = tv & 63; }
        unsigned u = 0;
        if (F.lane == 0) u = __hip_atomic_fetch_add(ctr, 1u, __ATOMIC_RELAXED, __HIP_MEMORY_SCOPE_AGENT);
        u = __builtin_amdgcn_readfirstlane(u);
        if (u >= (unsigned)N_ALL) break;
#ifndef NO_MOBA
        if (u < (unsigned)N_MOBA) { unit_moba(P, F, layer, (int)(u % 6), 511 - (int)(u / 6)); } else
#endif
#ifndef NO_NSA
        if (u < (unsigned)(N_MOBA + N_NSA)) { unit_nsa(P, F, layer, 2047 - (int)(u - N_MOBA)); } else
#endif
#ifndef NO_FOX
        { const unsigned v = u - (N_MOBA + N_NSA); unit_fox(P, F, layer, (int)(v % 6), 511 - (int)(v / 6)); }
#else
        {}
#endif
    }
}

__global__ void __launch_bounds__(512, 2) fwd_kernel(Params P) {
    extern __shared__ __attribute__((aligned(16))) unsigned char lds_raw[];
    cg::grid_group grid = cg::this_grid();
    const int G = gridDim.x, bx = blockIdx.x;
    for (int ph = P.ph_lo; ph < P.ph_hi; ++ph) {
        unsigned char* wsb = P.ws; asm volatile("" : "+s"(wsb));
        int tidv = threadIdx.x; asm volatile("" : "+v"(tidv));
        Frame F;
        F.lds = (LAS unsigned char*)lds_raw;
        F.tid = tidv; F.lane = F.tid & 63; F.wave = __builtin_amdgcn_readfirstlane(F.tid >> 6);
        F.gw = bx * 8 + F.wave; F.NGW = G * 8;
        F.ws = wsb; F.PA = (bf16*)(wsb + WS_PA);
        const int layer = ph >> 3, k = ph & 7;
        const float* xin = layer == 0 ? P.x : P.out;
        if (k == 0) phase0(P, F, layer, xin);
        else if (k == 1 || k == 5) {
            pg8::Gemm g; pg8::StaticOrder S; pg8::EpiBf16 E;
            if (k == 1) { g = pg8::Gemm{(const bf16*)(wsb + WS_H), (const bf16*)(wsb + WS_WA), SEQ, PAC, DM, DM}; S.init(SEQ, PAC, G, bx); E = pg8::EpiBf16{F.PA, PAC}; }
            else { g = pg8::Gemm{(const bf16*)(wsb + WS_H), (const bf16*)(wsb + WS_WG), SEQ, NGL, DM, DM}; S.init(SEQ, NGL, G, bx); E = pg8::EpiBf16{F.PA + C_GL, PAC}; }
#ifndef NO_G15
            pg8::gemm_phase<pg8::EpiBf16, pg8::StaticOrder>(F.lds, g, S, E, F.tid);
#endif
        }
        else if (k == 2) phase2(P, F, layer);
        else if (k == 3) phase3(F);
        else if (k == 4) phase4(P, F, layer);
        else if (k == 6) {
            for (int b = 0; b < 3; ++b) {
                const int Kb = b == 1 ? 256 : 384;
                const bf16* A = F.PA + (b == 0 ? C_OM : (b == 1 ? C_ON : C_OF));
                const bf16* Bt = (const bf16*)(wsb + (b == 0 ? WS_WUPM : (b == 1 ? WS_WUPN : WS_WUPF)));
                pg8::Gemm g{A, Bt, SEQ, DM, Kb, PAC}; pg8::StaticOrder S; S.init(SEQ, DM, G, bx);
                pg8::EpiMerge E{(bf16*)(wsb + WS_H), F.PA + C_GL + b * 1024, P.b_gate + layer * 3072 + b * 1024, b == 0 ? 1 : 0};
#ifndef NO_G6
                pg8::gemm_phase<pg8::EpiMerge, pg8::StaticOrder>(F.lds, g, S, E, F.tid);
#endif
            }
        }
        else {
            pg8::Gemm g{(const bf16*)(wsb + WS_H), (const bf16*)(wsb + WS_WO), SEQ, DM, DM, DM}; pg8::StaticOrder S; S.init(SEQ, DM, G, bx);
            pg8::EpiOut E{xin, P.out};
#ifndef NO_G7
            pg8::gemm_phase<pg8::EpiOut, pg8::StaticOrder>(F.lds, g, S, E, F.tid);
#endif
        }
        if (ph + 1 < P.ph_hi) grid.sync();
    }
}

extern "C" void kernel_launch(void* const* d_in, const int* in_sizes, int n_in, void* d_out, int out_size, void* d_ws, size_t ws_size, hipStream_t stream) {
    static int grid = 0;
    if (grid == 0) {
        if (n_in != 16 || out_size != SEQ * DM || ws_size < WS_END) { fprintf(stderr, "kernel_launch: unexpected problem shape (n_in %d out %d ws %zu)\n", n_in, out_size, ws_size); grid = -1; return; }
        int dev = 0, cus = 0, per_cu = 0;
        hipGetDevice(&dev);
        hipDeviceGetAttribute(&cus, hipDeviceAttributeMultiprocessorCount, dev);
        hipFuncSetAttribute((const void*)fwd_kernel, hipFuncAttributeMaxDynamicSharedMemorySize, LDS_BYTES);
        hipOccupancyMaxActiveBlocksPerMultiprocessor(&per_cu, (const void*)fwd_kernel, 512, LDS_BYTES);
        if (per_cu < 1) { fprintf(stderr, "kernel_launch: occupancy query says %d blocks per CU\n", per_cu); per_cu = 1; }
        (void)hipGetLastError();
        grid = cus * per_cu;
    }
    if (grid < 0) return;
    Params p{};
    p.x = (const float*)d_in[0]; p.norm_g = (const float*)d_in[1]; p.w_in = (const float*)d_in[2]; p.b_f = (const float*)d_in[3]; p.b_gate = (const float*)d_in[4];
    p.moba_qk_g = (const float*)d_in[5]; p.nsa_q_g = (const float*)d_in[6]; p.nsa_k_g = (const float*)d_in[7]; p.fox_qk_g = (const float*)d_in[8];
    p.cmp_pe = (const float*)d_in[9]; p.cmp_w1 = (const float*)d_in[10]; p.cmp_w2 = (const float*)d_in[11];
    p.w_up_moba = (const float*)d_in[12]; p.w_up_nsa = (const float*)d_in[13]; p.w_up_fox = (const float*)d_in[14]; p.w_out = (const float*)d_in[15];
    p.out = (float*)d_out; p.ws = (unsigned char*)d_ws;
#if N_LAUNCH_MODE == 1
    for (int ph = 0; ph < 16; ++ph) { p.ph_lo = ph; p.ph_hi = ph + 1; hipLaunchKernelGGL(fwd_kernel, dim3(grid), dim3(512), LDS_BYTES, stream, p); }
#else
    p.ph_lo = 0; p.ph_hi = 16;
    void* args[] = {&p};
    hipError_t e = hipLaunchCooperativeKernel((const void*)fwd_kernel, dim3(grid), dim3(512), args, LDS_BYTES, stream);
    if (e != hipSuccess) fprintf(stderr, "kernel_launch: cooperative launch failed: %s (grid %d)\n", hipGetErrorString(e), grid);
#endif
}
```

```cpp
#include <hip/hip_runtime.h>
#include <hip/hip_cooperative_groups.h>
#include <cstdio>
#include <cstdint>
namespace cg = cooperative_groups;

#ifndef N_LAUNCH_MODE
#define N_LAUNCH_MODE 0
#endif

typedef unsigned short bf16;
typedef short bf16x8 __attribute__((ext_vector_type(8)));
typedef float f32x4 __attribute__((ext_vector_type(4)));
typedef float f32x16 __attribute__((ext_vector_type(16)));
typedef unsigned u32x4 __attribute__((ext_vector_type(4)));
typedef unsigned u32x2 __attribute__((ext_vector_type(2)));
#define LAS __attribute__((address_space(3)))

constexpr int SEQ = 16384, DM = 1024, INC = 7058, PAC = 4096, NGL = 3072;
constexpr float LOG2E = 1.4426950408889634f;
constexpr float C2 = 0.125f * LOG2E;
constexpr float RMS_EPS = 1e-6f;
constexpr int LDS_BYTES = 131072 + 256;
constexpr int NPH = 9;

constexpr int C_MK = 0, C_MV = 384, C_KC = 768, C_VC = 832, C_KSL = 896, C_VSL = 960, C_MQ = 1024, C_MZ = 1408, C_NQ = 1792, C_KW = 2048, C_VW = 2112,
              C_NZ = 2176, C_FQ = 2432, C_FK = 2816, C_FV = 3200, C_FZ = 3584, C_NG = 3968, C_FF = 3980, C_GL = 1024;
constexpr int C_OM = 0, C_OF = 384, C_ON = 768;

constexpr size_t MiB = 1u << 20;
constexpr size_t WS_CTL = 0, WS_WA = 1 * MiB, WS_WG = 9 * MiB, WS_WUPM = 15 * MiB, WS_WUPN = 15 * MiB + 768 * 1024, WS_WUPF = 15 * MiB + 1280 * 1024,
                 WS_WO = 17 * MiB, WS_W1T = 19 * MiB, WS_W2T = 21 * MiB, WS_KMEAN = 21 * MiB + 128 * 1024,
                 WS_CS = 21 * MiB + 256 * 1024, WS_CSTOT = 21 * MiB + 768 * 1024, WS_KCMP = 22 * MiB, WS_VCMP = 22 * MiB + 128 * 1024,
                 WS_KF = 23 * MiB, WS_VF = 51 * MiB, WS_H2 = 23 * MiB  , WS_PA = 80 * MiB,
                 WS_H = 208 * MiB  , WS_PART = 208 * MiB, WS_LPART = 244 * MiB, WS_LOWN = 246 * MiB, WS_LIST = 247 * MiB,
                 WS_END = 256 * MiB;
constexpr size_t STREAM_ELEMS = (size_t)SEQ * 64;

struct Params {
    const float* x; const float* norm_g; const float* w_in; const float* b_f; const float* b_gate;
    const float* moba_qk_g; const float* nsa_q_g; const float* nsa_k_g; const float* fox_qk_g;
    const float* cmp_pe; const float* cmp_w1; const float* cmp_w2; const float* w_up_moba; const float* w_up_nsa; const float* w_up_fox; const float* w_out;
    float* out; unsigned char* ws; int ph_lo, ph_hi;
};

__device__ __forceinline__ unsigned cvt_pk_bf16(float lo, float hi) { unsigned r; asm volatile("v_cvt_pk_bf16_f32 %0, %1, %2" : "=v"(r) : "v"(lo), "v"(hi)); return r; }
__device__ __forceinline__ float bf2f(unsigned short b) { return __builtin_bit_cast(float, (unsigned)b << 16); }
__device__ __forceinline__ float bflo(unsigned w) { return __builtin_bit_cast(float, w << 16); }
__device__ __forceinline__ float bfhi(unsigned w) { return __builtin_bit_cast(float, w & 0xffff0000u); }
__device__ __forceinline__ unsigned short f2bf(float f) { return (unsigned short)(cvt_pk_bf16(f, 0.f) & 0xffffu); }
__device__ __forceinline__ float shx(float v, int m, int lane) { return __builtin_bit_cast(float, __builtin_amdgcn_ds_bpermute((lane ^ m) << 2, __builtin_bit_cast(int, v))); }
__device__ __forceinline__ int shxi(int v, int m, int lane) { return __builtin_amdgcn_ds_bpermute((lane ^ m) << 2, v); }
__device__ __forceinline__ float shfrom(float v, int src) { return __builtin_bit_cast(float, __builtin_amdgcn_ds_bpermute(src << 2, __builtin_bit_cast(int, v))); }
__device__ __forceinline__ int shfromi(int v, int src) { return __builtin_amdgcn_ds_bpermute(src << 2, v); }
__device__ __forceinline__ float wave_sum(float v, int lane) {
#pragma unroll
    for (int o = 1; o < 64; o <<= 1) v += shx(v, o, lane);
    return v;
}
__device__ __forceinline__ float wave_max(float v, int lane) {
#pragma unroll
    for (int o = 1; o < 64; o <<= 1) v = fmaxf(v, shx(v, o, lane));
    return v;
}
__device__ __forceinline__ int crow(int r, int hi) { return (r & 3) + 8 * (r >> 2) + 4 * hi; }
__device__ __forceinline__ float sigmoidf_(float z) { return 1.f / (1.f + __expf(-z)); }
__device__ __forceinline__ float siluf_(float z) { return z / (1.f + __expf(-z)); }
#define MFMA32(a, b, c) __builtin_amdgcn_mfma_f32_32x32x16_bf16((a), (b), (c), 0, 0, 0)
#define LDS_FENCE() asm volatile("s_waitcnt lgkmcnt(0)" ::: "memory")

namespace pg8 {
typedef unsigned short bf16_t;
constexpr int BM = 256, BK = 64, HALF = 128, HTB = HALF * BK * 2, NXCD = 8, WGM = 8;
__host__ __device__ __forceinline__ int lds_byte(int r, int c) { const int st = (r >> 4) * 2 + (c >> 5), rr = r & 15, cc = c & 31, ob = rr * 64 + cc * 2; return st * 1024 + (ob ^ (((ob >> 9) & 1) << 5)); }
__host__ __device__ __forceinline__ void stage_rc(int b, int& R, int& C) { const int st = b / 1024, sb = b % 1024, swz = sb ^ (((sb >> 9) & 1) << 5); R = (st >> 1) * 16 + swz / 64; C = (st & 1) * 32 + (swz % 64) / 2; }
__host__ __device__ __forceinline__ int perm32(int rho) { const int n = rho >> 4, i = rho & 15; return 8 * (i >> 2) + 4 * n + (i & 3); }
struct Unit { int pm, pn; };
struct Gemm { const bf16_t* A; const bf16_t* Bt; int M, N, K, lda; };
struct StaticOrder {
    int nM, nN, nwg, G, c;
    __device__ void init(int M, int N, int G_, int c_) { nM = M / BM; nN = N / BM; nwg = nM * nN; G = G_; c = c_; }
    __device__ bool next(int i, Unit& u) const {
        const long L = (long)i * G + c; if (L >= nwg) return false;
        int wgid = (int)L; { const int q = nwg / NXCD, r = nwg % NXCD, xcd = wgid % NXCD, off = wgid / NXCD; wgid = (xcd < r ? xcd * (q + 1) : r * (q + 1) + (xcd - r) * q) + off; }
        const int nig = WGM * nN, gid = wgid / nig, fm = gid * WGM, gsz = (nM - fm) < WGM ? (nM - fm) : WGM;
        u.pm = fm + ((wgid % nig) % gsz); u.pn = (wgid % nig) / gsz; return true;
    }
};
struct EpiBf16 {
    bf16_t* O; int ldc;
    __device__ __forceinline__ void operator()(const f32x4 (&acc)[2][2][4][2], const Unit& u, int wr, int wc, int fr, int fq) const {
        const int row0 = u.pm * BM + wr * 64 + fr, col0 = u.pn * BM + wc * 32 + 8 * fq;
#pragma unroll
        for (int ai = 0; ai < 2; ++ai)
#pragma unroll
            for (int m = 0; m < 4; ++m) { bf16_t* rowp = O + (size_t)(row0 + ai * HALF + m * 16) * ldc + col0;
#pragma unroll
                for (int bj = 0; bj < 2; ++bj) { const f32x4 v0 = acc[ai][bj][m][0], v1 = acc[ai][bj][m][1];
                    u32x4 w; w.x = cvt_pk_bf16(v0[0], v0[1]); w.y = cvt_pk_bf16(v0[2], v0[3]); w.z = cvt_pk_bf16(v1[0], v1[1]); w.w = cvt_pk_bf16(v1[2], v1[3]);
                    *(u32x4*)(rowp + bj * HALF) = w; } }
    }
};
struct EpiMerge {
    bf16_t* Mg; const bf16_t* gl; const float* bg; int first;
    __device__ __forceinline__ void operator()(const f32x4 (&acc)[2][2][4][2], const Unit& u, int wr, int wc, int fr, int fq) const {
        const int row0 = u.pm * BM + wr * 64 + fr, col0 = u.pn * BM + wc * 32 + 8 * fq;
#pragma unroll
        for (int bj = 0; bj < 2; ++bj) {
            const int col = col0 + bj * HALF;
            const f32x4 b0 = *(const f32x4*)(bg + col), b1 = *(const f32x4*)(bg + col + 4);
#pragma unroll
            for (int ai = 0; ai < 2; ++ai)
#pragma unroll
                for (int m = 0; m < 4; ++m) {
                    const size_t row = (size_t)(row0 + ai * HALF + m * 16);
                    const u32x4 g = *(const u32x4*)(gl + row * PAC + col);
                    const f32x4 a0 = acc[ai][bj][m][0], a1 = acc[ai][bj][m][1];
                    float v[8];
                    v[0] = a0[0] * sigmoidf_(bflo(g.x) + b0[0]); v[1] = a0[1] * sigmoidf_(bfhi(g.x) + b0[1]);
                    v[2] = a0[2] * sigmoidf_(bflo(g.y) + b0[2]); v[3] = a0[3] * sigmoidf_(bfhi(g.y) + b0[3]);
                    v[4] = a1[0] * sigmoidf_(bflo(g.z) + b1[0]); v[5] = a1[1] * sigmoidf_(bfhi(g.z) + b1[1]);
                    v[6] = a1[2] * sigmoidf_(bflo(g.w) + b1[2]); v[7] = a1[3] * sigmoidf_(bfhi(g.w) + b1[3]);
                    bf16_t* mp = Mg + row * DM + col;
                    if (!first) { const u32x4 p = *(const u32x4*)mp;
                        v[0] += bflo(p.x); v[1] += bfhi(p.x); v[2] += bflo(p.y); v[3] += bfhi(p.y); v[4] += bflo(p.z); v[5] += bfhi(p.z); v[6] += bflo(p.w); v[7] += bfhi(p.w); }
                    u32x4 w; w.x = cvt_pk_bf16(v[0], v[1]); w.y = cvt_pk_bf16(v[2], v[3]); w.z = cvt_pk_bf16(v[4], v[5]); w.w = cvt_pk_bf16(v[6], v[7]);
                    *(u32x4*)mp = w;
                }
        }
    }
};
struct EpiOut {
    const float* xin; float* out;
    __device__ __forceinline__ void operator()(const f32x4 (&acc)[2][2][4][2], const Unit& u, int wr, int wc, int fr, int fq) const {
        const int row0 = u.pm * BM + wr * 64 + fr, col0 = u.pn * BM + wc * 32 + 8 * fq;
#pragma unroll
        for (int ai = 0; ai < 2; ++ai)
#pragma unroll
            for (int m = 0; m < 4; ++m)
#pragma unroll
                for (int bj = 0; bj < 2; ++bj) {
                    const size_t off = (size_t)(row0 + ai * HALF + m * 16) * DM + col0 + bj * HALF;
                    const f32x4 x0 = *(const f32x4*)(xin + off), x1 = *(const f32x4*)(xin + off + 4);
                    *(f32x4*)(out + off) = x0 + acc[ai][bj][m][0]; *(f32x4*)(out + off + 4) = x1 + acc[ai][bj][m][1];
                }
    }
};

template <class Epi, class Sched>
__device__ __forceinline__ void gemm_phase(LAS unsigned char* lds, const Gemm g, const Sched& S, const Epi& E, const int tid) {
    const int wid = __builtin_amdgcn_readfirstlane(tid >> 6), lane = tid & 63, wr = wid >> 2, wc = wid & 3, fr = lane & 15, fq = lane >> 4;
    const int K = g.K, nt = K / BK, lda = g.lda;
    unsigned voffA[2], voffB[2];
#pragma unroll
    for (int i = 0; i < 2; ++i) { int R, C; stage_rc(tid * 16 + i * 8192, R, C); const int Rb = (R & ~31) + perm32(R & 31);
        voffA[i] = (unsigned)(R * lda + C) * 2u; voffB[i] = (unsigned)(Rb * K + C) * 2u; }
    const size_t kstep = (size_t)(BK * 2);
    const size_t hstepA = (size_t)HALF * lda * 2, hstepB = (size_t)HALF * K * 2;
    const size_t tstepA = 2 * hstepA, tstepB = 2 * hstepB;
    const unsigned ldsw = (unsigned)wid * 1024u;
    const int aoff = lds_byte(wr * 64 + fr, fq * 8), boff = lds_byte(wc * 32 + fr, fq * 8);
#define PG8_SA(b, h) (((b) * 2 + (h)) * HTB)
#define PG8_SB(b, h) ((4 + (b) * 2 + (h)) * HTB)
#define PG8_STAGE(bufoff, gbase, voff) do { _Pragma("unroll") for (int _i = 0; _i < 2; ++_i) \
        __builtin_amdgcn_global_load_lds((const unsigned*)((const char*)(gbase) + (voff)[_i]), (LAS unsigned*)(lds + (bufoff) + ldsw + _i * 8192), 16, 0, 0); } while (0)
#define PG8_LDA(dst, b, h) do { _Pragma("unroll") for (int m = 0; m < 4; ++m) _Pragma("unroll") for (int k = 0; k < 2; ++k) dst[m][k] = *(const LAS bf16x8*)(lds + PG8_SA(b, h) + aoff + m * 2048 + k * 1024); } while (0)
#define PG8_LDB(dst, b, h) do { _Pragma("unroll") for (int n = 0; n < 2; ++n) _Pragma("unroll") for (int k = 0; k < 2; ++k) dst[n][k] = *(const LAS bf16x8*)(lds + PG8_SB(b, h) + boff + n * 2048 + k * 1024); } while (0)
#define PG8_MMA(ai, bj, At, Bt) do { __builtin_amdgcn_s_setprio(1); _Pragma("unroll") for (int m = 0; m < 4; ++m) _Pragma("unroll") for (int n = 0; n < 2; ++n) _Pragma("unroll") for (int k = 0; k < 2; ++k) \
        acc[ai][bj][m][n] = __builtin_amdgcn_mfma_f32_16x16x32_bf16(Bt[n][k], At[m][k], acc[ai][bj][m][n], 0, 0, 0); __builtin_amdgcn_s_setprio(0); } while (0)
#define PG8_WAIT_V(n) asm volatile("s_waitcnt vmcnt(" #n ")" ::: "memory")
#define PG8_WAIT_L(n) asm volatile("s_waitcnt lgkmcnt(" #n ")" ::: "memory")
#define PG8_BAR __builtin_amdgcn_s_barrier()
#define PG8_SCHED __builtin_amdgcn_sched_barrier(0)
    Unit cur, nxt; int ui = 0;
    if (!S.next(0, cur)) return;
    f32x4 acc[2][2][4][2];
#pragma unroll
    for (int a = 0; a < 2; ++a)
#pragma unroll
        for (int b = 0; b < 2; ++b)
#pragma unroll
            for (int m = 0; m < 4; ++m)
#pragma unroll
                for (int n = 0; n < 2; ++n) acc[a][b][m][n] = (f32x4){0.f, 0.f, 0.f, 0.f};
    bf16x8 At[4][2], B0[2][2], B1[2][2];
    const char* cA = (const char*)g.A + (size_t)cur.pm * tstepA; const char* cB = (const char*)g.Bt + (size_t)cur.pn * tstepB;
    PG8_STAGE(PG8_SB(0, 0), cB, voffB); PG8_STAGE(PG8_SB(0, 1), cB + hstepB, voffB); PG8_STAGE(PG8_SA(0, 0), cA, voffA); PG8_STAGE(PG8_SA(0, 1), cA + hstepA, voffA);
    if (wr == 1) PG8_BAR;
    PG8_WAIT_V(2); PG8_BAR;
    PG8_STAGE(PG8_SB(1, 0), cB + kstep, voffB); PG8_STAGE(PG8_SA(1, 0), cA + kstep, voffA); PG8_STAGE(PG8_SB(1, 1), cB + hstepB + kstep, voffB);
    PG8_WAIT_V(6); PG8_BAR;
    for (;;) {
        const bool has_next = S.next(ui + 1, nxt);
        const char* nA = has_next ? (const char*)g.A + (size_t)nxt.pm * tstepA : cA; const char* nB = has_next ? (const char*)g.Bt + (size_t)nxt.pn * tstepB : cB;
        for (int t = 0; t < nt; t += 2) {
            const bool last = (t == nt - 2);
            const char* a1 = cA + (size_t)(t + 1) * kstep;
            const char* a2 = last ? nA : cA + (size_t)(t + 2) * kstep; const char* b2 = last ? nB : cB + (size_t)(t + 2) * kstep;
            const char* a3 = a2 + kstep; const char* b3 = b2 + kstep;
            PG8_LDB(B0, 0, 0); PG8_LDB(B1, 0, 1); PG8_SCHED; PG8_LDA(At, 0, 0); PG8_STAGE(PG8_SA(1, 1), a1 + hstepA, voffA);
            PG8_WAIT_V(8); PG8_WAIT_L(0); PG8_BAR; PG8_MMA(0, 0, At, B0); PG8_MMA(0, 1, At, B1); PG8_BAR; PG8_SCHED;
            PG8_LDA(At, 0, 1); PG8_STAGE(PG8_SB(0, 0), b2, voffB); PG8_STAGE(PG8_SB(0, 1), b2 + hstepB, voffB); PG8_STAGE(PG8_SA(0, 0), a2, voffA);
            PG8_WAIT_V(8); PG8_WAIT_L(0); PG8_BAR; PG8_MMA(1, 0, At, B0); PG8_MMA(1, 1, At, B1); PG8_BAR; PG8_SCHED;
            PG8_LDB(B0, 1, 0); PG8_LDB(B1, 1, 1); PG8_SCHED; PG8_LDA(At, 1, 0); PG8_STAGE(PG8_SA(0, 1), a2 + hstepA, voffA);
            PG8_WAIT_V(8); PG8_WAIT_L(0); PG8_BAR; PG8_MMA(0, 0, At, B0); PG8_MMA(0, 1, At, B1); PG8_BAR; PG8_SCHED;
            PG8_LDA(At, 1, 1); PG8_STAGE(PG8_SB(1, 0), b3, voffB); PG8_STAGE(PG8_SB(1, 1), b3 + hstepB, voffB); PG8_STAGE(PG8_SA(1, 0), a3, voffA);
            PG8_WAIT_V(8); PG8_WAIT_L(0); PG8_BAR; PG8_MMA(1, 0, At, B0); PG8_MMA(1, 1, At, B1); PG8_BAR; PG8_SCHED;
        }
        if (wr == 0) PG8_BAR;
        E(acc, cur, wr, wc, fr, fq);
        if (!has_next) break;
#pragma unroll
        for (int a = 0; a < 2; ++a)
#pragma unroll
            for (int b = 0; b < 2; ++b)
#pragma unroll
                for (int m = 0; m < 4; ++m)
#pragma unroll
                    for (int n = 0; n < 2; ++n) acc[a][b][m][n] = (f32x4){0.f, 0.f, 0.f, 0.f};
        cur = nxt; cA = nA; cB = nB; ++ui;
        if (wr == 1) PG8_BAR;
    }
    PG8_WAIT_V(0);
    PG8_BAR;
#undef PG8_SA
#undef PG8_SB
#undef PG8_STAGE
#undef PG8_LDA
#undef PG8_LDB
#undef PG8_MMA
#undef PG8_WAIT_V
#undef PG8_WAIT_L
#undef PG8_BAR
#undef PG8_SCHED
}
}

struct Frame { LAS unsigned char* lds; int tid, lane, wave, gw, NGW; unsigned char* ws; bf16* PA; };

__device__ __forceinline__ int srcA(int n) {
    if (n < 384) return 384 + n;
    if (n < 768) return 768 + (n - 384);
    if (n < 1024) return 1792 + (n - 768);
    if (n < 1408) return n - 1024;
    if (n < 1792) return 1152 + (n - 1408);
    if (n < 2048) return 1536 + (n - 1792);
    if (n < 2176) return 2048 + (n - 2048);
    if (n < 2432) return 2188 + (n - 2176);
    if (n < 3584) return 2444 + (n - 2432);
    if (n < 3968) return 3602 + (n - 3584);
    if (n < 3980) return 2176 + (n - 3968);
    if (n < 3986) return 3596 + (n - 3980);
    return -1;
}
__device__ __forceinline__ void tr_item(const float* W, int ldw, bf16* WT, int Kd, int k0, int n0, int mode, int off, LAS float* scr, int lane) {
    const int nn = n0 + (lane & 31);
    const int sc = mode == 0 ? srcA(nn) : nn + off;
#pragma unroll 8
    for (int i = 0; i < 32; ++i) { const int kk = 2 * i + (lane >> 5); scr[kk * 33 + (lane & 31)] = sc >= 0 ? W[(size_t)(k0 + kk) * ldw + sc] : 0.f; }
    LDS_FENCE();
    const int c = lane & 7;
#pragma unroll
    for (int j = 0; j < 4; ++j) { const int n = (lane >> 3) + 8 * j; const LAS float* s = scr + (8 * c) * 33 + n;
        u32x4 o; o.x = cvt_pk_bf16(s[0 * 33], s[1 * 33]); o.y = cvt_pk_bf16(s[2 * 33], s[3 * 33]); o.z = cvt_pk_bf16(s[4 * 33], s[5 * 33]); o.w = cvt_pk_bf16(s[6 * 33], s[7 * 33]);
        *(u32x4*)(WT + (size_t)(n0 + n) * Kd + k0 + 8 * c) = o; }
    LDS_FENCE();
}
__device__ __forceinline__ void rms_rows(const Params& P, const Frame& F, int layer, const float* xin, bf16* H) {
    const float* g = P.norm_g + layer * DM;
    for (int m = F.gw; m < SEQ; m += F.NGW) {
        const f32x4* xr = (const f32x4*)(xin + (size_t)m * DM) + F.lane;
        f32x4 v[4]; float s = 0.f;
#pragma unroll
        for (int j = 0; j < 4; ++j) { v[j] = xr[64 * j]; s += (v[j].x * v[j].x + v[j].y * v[j].y) + (v[j].z * v[j].z + v[j].w * v[j].w); }
        const float rs = rsqrtf(wave_sum(s, F.lane) * (1.f / DM) + RMS_EPS);
        unsigned long long* o8 = (unsigned long long*)(H + (size_t)m * DM) + F.lane;
#pragma unroll
        for (int j = 0; j < 4; ++j) { const f32x4 gg = ((const f32x4*)g)[F.lane + 64 * j];
            o8[64 * j] = (unsigned long long)cvt_pk_bf16(v[j].x * rs * gg.x, v[j].y * rs * gg.y) | ((unsigned long long)cvt_pk_bf16(v[j].z * rs * gg.z, v[j].w * rs * gg.w) << 32); }
    }
}
__device__ __forceinline__ void phase0(const Params& P, const Frame& F, int layer, const float* xin) {
    LAS float* scr = (LAS float*)(F.lds + F.wave * 16384);
    unsigned char* ws = F.ws;
    if (F.gw == 0) { unsigned* ctl = (unsigned*)(ws + WS_CTL);
        if (F.lane == 0) { ctl[16 * layer] = 0u; ctl[16 * layer + 8] = 0u; }
        for (int i = F.lane; i < 384; i += 64) ctl[64 + 512 * layer + i] = 0u; }
    constexpr int I_A = 16 * 128, I_G = 16 * 96, I_UM = 6 * 32, I_UN = 4 * 32, I_UF = 6 * 32, I_O = 16 * 32, I_1 = 32 * 8, I_2 = 4 * 2;
    constexpr int NIT = I_A + I_G + I_UM + I_UN + I_UF + I_O + 2 * I_1 + 2 * I_2;
    const float* w_in = P.w_in + (size_t)layer * DM * INC;
    for (int it = F.gw; it < NIT; it += F.NGW) {
        int r = it;
        if (r < I_A) { tr_item(w_in, INC, (bf16*)(ws + WS_WA), 1024, 64 * (r / 128), 32 * (r % 128), 0, 0, scr, F.lane); continue; } r -= I_A;
        if (r < I_G) { tr_item(w_in, INC, (bf16*)(ws + WS_WG), 1024, 64 * (r / 96), 32 * (r % 96), 1, 3986, scr, F.lane); continue; } r -= I_G;
        if (r < I_UM) { tr_item(P.w_up_moba + (size_t)layer * 384 * 1024, 1024, (bf16*)(ws + WS_WUPM), 384, 64 * (r / 32), 32 * (r % 32), 1, 0, scr, F.lane); continue; } r -= I_UM;
        if (r < I_UN) { tr_item(P.w_up_nsa + (size_t)layer * 256 * 1024, 1024, (bf16*)(ws + WS_WUPN), 256, 64 * (r / 32), 32 * (r % 32), 1, 0, scr, F.lane); continue; } r -= I_UN;
        if (r < I_UF) { tr_item(P.w_up_fox + (size_t)layer * 384 * 1024, 1024, (bf16*)(ws + WS_WUPF), 384, 64 * (r / 32), 32 * (r % 32), 1, 0, scr, F.lane); continue; } r -= I_UF;
        if (r < I_O) { tr_item(P.w_out + (size_t)layer * 1024 * 1024, 1024, (bf16*)(ws + WS_WO), 1024, 64 * (r / 32), 32 * (r % 32), 1, 0, scr, F.lane); continue; } r -= I_O;
        if (r < 2 * I_1) { const int kv = r / I_1; r %= I_1;
            tr_item(P.cmp_w1 + (size_t)(layer * 2 + kv) * 2048 * 256, 256, (bf16*)(ws + WS_W1T) + (size_t)kv * 256 * 2048, 2048, 64 * (r / 8), 32 * (r % 8), 1, 0, scr, F.lane); continue; } r -= 2 * I_1;
        { const int kv = r / I_2; r %= I_2;
            tr_item(P.cmp_w2 + (size_t)(layer * 2 + kv) * 256 * 64, 64, (bf16*)(ws + WS_W2T) + (size_t)kv * 64 * 256, 256, 64 * (r / 2), 32 * (r % 2), 1, 0, scr, F.lane); }
    }
    rms_rows(P, F, layer, xin, (bf16*)(ws + WS_H));
}

__device__ __forceinline__ void rope_sincos(float pos, int i, float& cs, float& sn) {
    constexpr float INV[8] = {1.0f, 0.1939227432012558f, 0.03760603070259094f, 0.007292664609849453f, 0.0014142135623842478f, 0.00027424818836152554f, 5.3182957344688475e-05f, 1.0313385246263351e-05f};
    const float ang = pos * INV[i];
    double rev = (double)ang * 0.15915494309189535; rev -= floor(rev);
    const float fr = (float)rev;
    sn = __builtin_amdgcn_sinf(fr); cs = __builtin_amdgcn_cosf(fr);
}
__device__ __forceinline__ void norm_load(const bf16* rowp, const float* g, bool rope, int t, float (&v)[64]) {
    float ss = 0.f;
#pragma unroll
    for (int j = 0; j < 8; ++j) { const u32x4 w = ((const u32x4*)rowp)[j];
        v[8 * j + 0] = bflo(w.x); v[8 * j + 1] = bfhi(w.x); v[8 * j + 2] = bflo(w.y); v[8 * j + 3] = bfhi(w.y);
        v[8 * j + 4] = bflo(w.z); v[8 * j + 5] = bfhi(w.z); v[8 * j + 6] = bflo(w.w); v[8 * j + 7] = bfhi(w.w); }
#pragma unroll
    for (int d = 0; d < 64; ++d) ss += v[d] * v[d];
    const float rs = rsqrtf(ss * (1.f / 64.f) + RMS_EPS);
#pragma unroll
    for (int d = 0; d < 64; ++d) v[d] = v[d] * rs * g[d];
    if (rope) {
#pragma unroll
        for (int i = 0; i < 8; ++i) { float cs, sn; rope_sincos((float)t, i, cs, sn); const float a = v[i], b = v[i + 8]; v[i] = a * cs - b * sn; v[i + 8] = b * cs + a * sn; }
    }
}
__device__ __forceinline__ void norm_store(const Frame& F, const float (&v)[64], float osc, bf16* rowp, int kstream, int t) {
    bf16* dst = kstream < 0 ? rowp : (bf16*)(F.ws + WS_KF) + (size_t)kstream * STREAM_ELEMS + ((size_t)(t >> 5) * 256 + (t & 31)) * 8;
#pragma unroll
    for (int j = 0; j < 8; ++j) {
        u32x4 w; w.x = cvt_pk_bf16(v[8 * j] * osc, v[8 * j + 1] * osc); w.y = cvt_pk_bf16(v[8 * j + 2] * osc, v[8 * j + 3] * osc);
        w.z = cvt_pk_bf16(v[8 * j + 4] * osc, v[8 * j + 5] * osc); w.w = cvt_pk_bf16(v[8 * j + 6] * osc, v[8 * j + 7] * osc);
        bf16* p = kstream < 0 ? dst + 8 * j : dst + ((j >> 1) * 64 + (j & 1) * 32) * 8;
        *(u32x4*)p = w;
    }
}
__device__ __forceinline__ void p2_normrow(const Params& P, const Frame& F, int layer, int idx) {
    const int t = idx / 24, slot = idx - t * 24;
    int col, kstream = -1; const float* g; bool rope = true; float osc = 1.f;
    if (slot < 6) { col = C_MQ + slot * 64; g = P.moba_qk_g + layer * 128; osc = C2; }
    else if (slot < 10) { col = C_NQ + (slot - 6) * 64; g = P.nsa_q_g + layer * 64; osc = C2; }
    else if (slot == 10) { col = C_KSL; g = P.nsa_k_g + layer * 192 + 64; kstream = 6; }
    else if (slot == 11) { col = C_KW; g = P.nsa_k_g + layer * 192 + 128; kstream = 7; }
    else if (slot < 18) { col = C_FQ + (slot - 12) * 64; g = P.fox_qk_g + layer * 128; rope = false; osc = C2; }
    else { col = C_FK + (slot - 18) * 64; g = P.fox_qk_g + layer * 128 + 64; rope = false; kstream = 8 + (slot - 18); }
    bf16* rowp = F.PA + (size_t)t * PAC + col;
    float v[64];
    norm_load(rowp, g, rope, t, v);
    norm_store(F, v, osc, rowp, kstream, t);
}
__device__ __forceinline__ void p2_mk_unit(const Params& P, const Frame& F, int layer, int u) {
    const int blk = u / 3, pr = u - blk * 3, head = pr * 2 + (F.tid >> 8), t = blk * 256 + (F.tid & 255);
    bf16* rowp = F.PA + (size_t)t * PAC + C_MK + head * 64;
    float v[64];
    norm_load(rowp, P.moba_qk_g + layer * 128 + 64, true, t, v);
    norm_store(F, v, 1.f, rowp, head, t);
    float mine = 0.f;
#pragma unroll
    for (int d = 0; d < 64; ++d) { const float s = wave_sum(v[d], F.lane); mine = (F.lane == d) ? s : mine; }
    LAS float* part = (LAS float*)F.lds;
    part[F.wave * 64 + F.lane] = mine;
    __syncthreads();
    if (F.tid < 128) { const int hh = F.tid >> 6, d = F.tid & 63;
        const float s = (part[(hh * 4 + 0) * 64 + d] + part[(hh * 4 + 1) * 64 + d]) + (part[(hh * 4 + 2) * 64 + d] + part[(hh * 4 + 3) * 64 + d]);
        ((float*)(F.ws + WS_KMEAN))[((pr * 2 + hh) * 64 + blk) * 64 + d] = s * (1.f / 256.f); }
    __syncthreads();
}
__device__ __forceinline__ void p2_vfrag(const Frame& F, size_t f) {
    const int st = (int)(f >> 17); const int r = (int)(f & 131071);
    const int T = r >> 8, dt = (r >> 7) & 1, s = (r >> 6) & 1, ln = r & 63, c = ln & 31, hg = ln >> 5;
    const int col0 = st < 6 ? C_MV + st * 64 : (st == 6 ? C_VSL : (st == 7 ? C_VW : C_FV + (st - 8) * 64));
    const bf16* src = F.PA + (size_t)(32 * T + 16 * s + 4 * hg) * PAC + col0 + dt * 32 + c;
    unsigned short e[8];
#pragma unroll
    for (int j = 0; j < 8; ++j) e[j] = src[(size_t)((j & 3) + 8 * (j >> 2)) * PAC];
    u32x4 w; w.x = e[0] | ((unsigned)e[1] << 16); w.y = e[2] | ((unsigned)e[3] << 16); w.z = e[4] | ((unsigned)e[5] << 16); w.w = e[6] | ((unsigned)e[7] << 16);
    *(u32x4*)((bf16*)(F.ws + WS_VF) + (size_t)st * STREAM_ELEMS + (size_t)r * 8) = w;
}
__device__ __forceinline__ void p2_compress(const Params& P, const Frame& F, int layer, int item) {
    const int kv = item >> 5, T = item & 31, lane = F.lane, c = lane & 31, hg = lane >> 5, w = F.wave;
    const int col0 = C_KC + kv * 64;
    const bf16* W1T = (const bf16*)(F.ws + WS_W1T) + (size_t)kv * 256 * 2048 + (size_t)(w * 32 + c) * 2048 + hg * 8;
    const bf16* W2T = (const bf16*)(F.ws + WS_W2T) + (size_t)kv * 64 * 256;
    const float* pe = P.cmp_pe + (size_t)(layer * 2 + kv) * 2048 + hg * 8;
    f32x16 acc;
#pragma unroll
    for (int r = 0; r < 16; ++r) acc[r] = 0.f;
    const int blk = 32 * T + c;
#pragma unroll 8
    for (int ks = 0; ks < 128; ++ks) {
        const int pos = ks >> 2, dsub = (ks & 3) * 16;
        int row = 16 * blk + pos; row = row > SEQ - 1 ? SEQ - 1 : row;
        const u32x4 bw = *(const u32x4*)(F.PA + (size_t)row * PAC + col0 + dsub + hg * 8);
        const f32x4 p0 = *(const f32x4*)(pe + ks * 16), p1 = *(const f32x4*)(pe + ks * 16 + 4);
        u32x4 bs; bs.x = cvt_pk_bf16(bflo(bw.x) + p0[0], bfhi(bw.x) + p0[1]); bs.y = cvt_pk_bf16(bflo(bw.y) + p0[2], bfhi(bw.y) + p0[3]);
        bs.z = cvt_pk_bf16(bflo(bw.z) + p1[0], bfhi(bw.z) + p1[1]); bs.w = cvt_pk_bf16(bflo(bw.w) + p1[2], bfhi(bw.w) + p1[3]);
        const bf16x8 a = *(const bf16x8*)(W1T + ks * 16);
        acc = MFMA32(a, __builtin_bit_cast(bf16x8, bs), acc);
    }
    LAS u32x4* hid = (LAS u32x4*)F.lds;
#pragma unroll
    for (int s = 0; s < 2; ++s) {
        float hv[8];
#pragma unroll
        for (int r = 0; r < 8; ++r) hv[r] = siluf_(acc[8 * s + r]);
        u32x4 pw4; pw4.x = cvt_pk_bf16(hv[0], hv[1]); pw4.y = cvt_pk_bf16(hv[2], hv[3]); pw4.z = cvt_pk_bf16(hv[4], hv[5]); pw4.w = cvt_pk_bf16(hv[6], hv[7]);
        hid[(w * 2 + s) * 64 + lane] = pw4;
    }
    __syncthreads();
    if (w == 0) {
        f32x16 o[2];
#pragma unroll
        for (int r = 0; r < 16; ++r) { o[0][r] = 0.f; o[1][r] = 0.f; }
#pragma unroll
        for (int nt = 0; nt < 8; ++nt)
#pragma unroll
            for (int s = 0; s < 2; ++s) {
                const bf16x8 pb = __builtin_bit_cast(bf16x8, hid[(nt * 2 + s) * 64 + lane]);
#pragma unroll
                for (int dt = 0; dt < 2; ++dt) {
                    const bf16* wp = W2T + (size_t)(dt * 32 + c) * 256 + nt * 32 + 16 * s + 4 * hg;
                    const u32x2 lo = *(const u32x2*)wp, hi = *(const u32x2*)(wp + 8);
                    u32x4 aw; aw.x = lo.x; aw.y = lo.y; aw.z = hi.x; aw.w = hi.y;
                    o[dt] = MFMA32(__builtin_bit_cast(bf16x8, aw), pb, o[dt]);
                }
            }
        if (kv == 0) {
            const float* g = P.nsa_k_g + layer * 192;
            float ss = 0.f;
#pragma unroll
            for (int dt = 0; dt < 2; ++dt)
#pragma unroll
                for (int r = 0; r < 16; ++r) ss += o[dt][r] * o[dt][r];
            ss += shx(ss, 32, lane);
            const float rs = rsqrtf(ss * (1.f / 64.f) + RMS_EPS);
#pragma unroll
            for (int dt = 0; dt < 2; ++dt)
#pragma unroll
                for (int r = 0; r < 16; ++r) o[dt][r] = o[dt][r] * rs * g[dt * 32 + crow(r, hg)];
            const float pos = (float)(16 * blk + 31);
#pragma unroll
            for (int r = 0; r < 4; ++r) {
                float c0, s0, c1, s1; rope_sincos(pos, r, c0, s0); rope_sincos(pos, r + 4, c1, s1);
                const float cs = hg ? c1 : c0, sn = hg ? s1 : s0;
                const float a = o[0][r], b = o[0][r + 4]; o[0][r] = a * cs - b * sn; o[0][r + 4] = b * cs + a * sn;
            }
            bf16* KC = (bf16*)(F.ws + WS_KCMP);
#pragma unroll
            for (int dt = 0; dt < 2; ++dt)
#pragma unroll
                for (int gq = 0; gq < 4; ++gq) {
                    const int ks = dt * 2 + (gq >> 1), hgp = gq & 1;
                    u32x2 wv; wv.x = cvt_pk_bf16(o[dt][4 * gq], o[dt][4 * gq + 1]); wv.y = cvt_pk_bf16(o[dt][4 * gq + 2], o[dt][4 * gq + 3]);
                    *(u32x2*)(KC + ((size_t)(T * 4 + ks) * 64 + hgp * 32 + c) * 8 + 4 * hg) = wv;
                }
        } else {
            bf16* VC = (bf16*)(F.ws + WS_VCMP);
            const int s = c >> 4, hgp = (c >> 2) & 1, j = ((c >> 3) & 1) * 4 + (c & 3);
#pragma unroll
            for (int dt = 0; dt < 2; ++dt)
#pragma unroll
                for (int r = 0; r < 16; ++r)
                    VC[((size_t)((T * 2 + dt) * 2 + s) * 64 + hgp * 32 + crow(r, hg)) * 8 + j] = f2bf(o[dt][r]);
        }
    }
    __syncthreads();
}
__device__ __forceinline__ void phase2(const Params& P, const Frame& F, int layer) {
#ifndef NO_CMP
    if ((F.gw >> 3) < 64) p2_compress(P, F, layer, F.gw >> 3);
#endif
    for (int it = F.gw; it < 6 * 256; it += F.NGW) {
        const int h = it >> 8, ch = it & 255, t = ch * 64 + F.lane;
        const float z = bf2f(F.PA[(size_t)t * PAC + C_FF + h]) + P.b_f[layer * 6 + h];
        float v = (fminf(z, 0.f) - log1pf(__expf(-fabsf(z)))) * LOG2E;
#pragma unroll
        for (int o = 1; o < 64; o <<= 1) { const float y = shfrom(v, (F.lane - o) & 63); if (F.lane >= o) v += y; }
        ((float*)(F.ws + WS_CS))[h * SEQ + t] = v;
        if (F.lane == 63) ((float*)(F.ws + WS_CSTOT))[h * 256 + ch] = v;
    }
#ifndef NO_NORMROW
    for (int u = (F.NGW >> 3) - 1 - (F.gw >> 3); u < 192; u += (F.NGW >> 3)) p2_mk_unit(P, F, layer, u);
    for (int it = F.gw; it < SEQ * 24 / 64; it += F.NGW) p2_normrow(P, F, layer, it * 64 + F.lane);
#endif
    for (int it = F.gw; it < 14 * 131072 / 64; it += F.NGW) p2_vfrag(F, (size_t)it * 64 + F.lane);
}

__device__ __forceinline__ int list_off(int j) { return 256 * (63 * j - (j * (j - 1)) / 2); }
constexpr int LIST_HEAD = 256 * 2016;
__device__ __forceinline__ void phase3(const Params& P, const Frame& F, int layer) {
    for (int it = F.gw; it < 6 * 256; it += F.NGW) {
        const int h = it >> 8, ch = it & 255;
        const float* tot = (const float*)(F.ws + WS_CSTOT) + h * 256;
        float s = 0.f;
        for (int cc = F.lane; cc < ch; cc += 64) s += tot[cc];
        s = wave_sum(s, F.lane);
        float* cs = (float*)(F.ws + WS_CS) + h * SEQ + ch * 64 + F.lane;
        *cs = *cs + s;
    }
    unsigned* cnt = (unsigned*)(F.ws + WS_CTL) + 64 + 512 * layer;
    unsigned short* LIST = (unsigned short*)(F.ws + WS_LIST);
    for (int it = F.gw; it < 6 * 256; it += F.NGW) {
        const int h = it >> 8, t = (it & 255) * 64 + F.lane, cur = t >> 8;
        if (cur == 0) continue;
        const bf16* qrow = F.PA + (size_t)t * PAC + C_MQ + h * 64;
        float qv[64];
#pragma unroll
        for (int j = 0; j < 8; ++j) { const u32x4 w = ((const u32x4*)qrow)[j];
            qv[8 * j + 0] = bflo(w.x); qv[8 * j + 1] = bfhi(w.x); qv[8 * j + 2] = bflo(w.y); qv[8 * j + 3] = bfhi(w.y);
            qv[8 * j + 4] = bflo(w.z); qv[8 * j + 5] = bfhi(w.z); qv[8 * j + 6] = bflo(w.w); qv[8 * j + 7] = bfhi(w.w); }
        float v1 = -3e38f, v2 = -3e38f, v3 = -3e38f; int i1 = -1, i2 = -1, i3 = -1;
        const float* km = (const float*)(F.ws + WS_KMEAN) + (size_t)h * 64 * 64;
        for (int j = 0; j < cur; ++j) {
            float g0 = 0.f, g1 = 0.f;
#pragma unroll
            for (int d = 0; d < 64; d += 2) { g0 += qv[d] * km[j * 64 + d]; g1 += qv[d + 1] * km[j * 64 + d + 1]; }
            const float g = g0 + g1;
            if (g > v3) { if (g > v2) { v3 = v2; i3 = i2; if (g > v1) { v2 = v1; i2 = i1; v1 = g; i1 = j; } else { v2 = g; i2 = j; } } else { v3 = g; i3 = j; } }
        }
        if (i1 >= 0) { const unsigned p = __hip_atomic_fetch_add(cnt + h * 64 + i1, 1u, __ATOMIC_RELAXED, __HIP_MEMORY_SCOPE_AGENT); LIST[(size_t)h * LIST_HEAD + list_off(i1) + p] = (unsigned short)((t << 2) | 0); }
        if (i2 >= 0) { const unsigned p = __hip_atomic_fetch_add(cnt + h * 64 + i2, 1u, __ATOMIC_RELAXED, __HIP_MEMORY_SCOPE_AGENT); LIST[(size_t)h * LIST_HEAD + list_off(i2) + p] = (unsigned short)((t << 2) | 1); }
        if (i3 >= 0) { const unsigned p = __hip_atomic_fetch_add(cnt + h * 64 + i3, 1u, __ATOMIC_RELAXED, __HIP_MEMORY_SCOPE_AGENT); LIST[(size_t)h * LIST_HEAD + list_off(i3) + p] = (unsigned short)((t << 2) | 2); }
    }
}

constexpr int RING_OFF = 65536;
__device__ __forceinline__ f32x16 qk_lds(LAS unsigned char* buf, const bf16x8 (&qf)[4], int lane) {
    const LAS bf16x8* p = (const LAS bf16x8*)buf + lane;
    f32x16 s;
#pragma unroll
    for (int r = 0; r < 16; ++r) s[r] = 0.f;
#pragma unroll
    for (int ks = 0; ks < 4; ++ks) s = MFMA32(p[ks * 64], qf[ks], s);
    return s;
}
__device__ __forceinline__ void pv_lds(LAS unsigned char* buf, const float (&e)[16], f32x16 (&o)[2], int lane) {
    const LAS bf16x8* p = (const LAS bf16x8*)(buf + 4096) + lane;
    u32x4 w0, w1;
    w0.x = cvt_pk_bf16(e[0], e[1]); w0.y = cvt_pk_bf16(e[2], e[3]); w0.z = cvt_pk_bf16(e[4], e[5]); w0.w = cvt_pk_bf16(e[6], e[7]);
    w1.x = cvt_pk_bf16(e[8], e[9]); w1.y = cvt_pk_bf16(e[10], e[11]); w1.z = cvt_pk_bf16(e[12], e[13]); w1.w = cvt_pk_bf16(e[14], e[15]);
    const bf16x8 pb0 = __builtin_bit_cast(bf16x8, w0), pb1 = __builtin_bit_cast(bf16x8, w1);
    o[0] = MFMA32(p[0], pb0, o[0]); o[0] = MFMA32(p[64], pb1, o[0]);
    o[1] = MFMA32(p[128], pb0, o[1]); o[1] = MFMA32(p[192], pb1, o[1]);
}
__device__ __forceinline__ float gain_bound(const float* gq, const float* gk, int lane) {
    const float a = wave_max(fabsf(gq[lane]), lane), b = wave_max(fabsf(gk[lane]), lane);
    return (8.f * a * b * 1.02f + 0.05f) * LOG2E;
}
__device__ __forceinline__ void write_gated(const Frame& F, const f32x16 (&o)[2], float scale, int t, int ocol, int zcol, int hg) {
    bf16* rowp = F.PA + (size_t)t * PAC;
#pragma unroll
    for (int dt = 0; dt < 2; ++dt)
#pragma unroll
        for (int g = 0; g < 4; ++g) {
            const int d0 = dt * 32 + 8 * g + 4 * hg;
            const u32x2 z = *(const u32x2*)(rowp + zcol + d0);
            u32x2 w;
            w.x = cvt_pk_bf16(o[dt][4 * g] * scale * siluf_(bflo(z.x)), o[dt][4 * g + 1] * scale * siluf_(bfhi(z.x)));
            w.y = cvt_pk_bf16(o[dt][4 * g + 2] * scale * siluf_(bflo(z.y)), o[dt][4 * g + 3] * scale * siluf_(bfhi(z.y)));
            *(u32x2*)(rowp + ocol + d0) = w;
        }
}
#define ZERO_O(o) do { _Pragma("unroll") for (int _r = 0; _r < 16; ++_r) { o[0][_r] = 0.f; o[1][_r] = 0.f; } } while (0)
#define VMW(n) asm volatile("s_waitcnt vmcnt(" #n ")" ::: "memory")
#define DMA2(p) do { _Pragma("unroll") for (int _q = 0; _q < 2; ++_q) \
    __builtin_amdgcn_global_load_lds((const unsigned*)(_src + (ptrdiff_t)(2 * (p) + _q) * _st), (LAS unsigned*)(_ring + ((((p) & 3) * 2 + _q) * 8192) + _wo), 16, 0, 0); } while (0)
#define STREAM_BEGIN(KFp, VFp, TFIRST, STEP, NTILES) { \
    const int _nt = (NTILES), _n = (_nt + 1) >> 1; \
    const char* _src = (const char*)((F.wave < 4) ? (KFp) : (VFp)) + (ptrdiff_t)(TFIRST) * 4096 + (F.wave & 3) * 1024 + F.lane * 16; \
    const ptrdiff_t _st = (ptrdiff_t)(STEP) * 4096; \
    LAS unsigned char* _ring = F.lds + RING_OFF; const unsigned _wo = (unsigned)F.wave * 1024u; \
    asm volatile("s_waitcnt vmcnt(0) lgkmcnt(0)" ::: "memory"); __builtin_amdgcn_s_barrier(); \
    if (_n > 0) DMA2(0); if (_n > 1) DMA2(1); if (_n > 2) DMA2(2); \
    for (int _i = 0; _i < _n; ++_i) { \
        if (_i + 2 < _n) VMW(4); else if (_i + 1 < _n) VMW(2); else VMW(0); \
        asm volatile("s_waitcnt lgkmcnt(0)" ::: "memory"); __builtin_amdgcn_s_barrier(); \
        if (_i + 3 < _n) DMA2(_i + 3); \
        _Pragma("unroll") for (int _s = 0; _s < 2; ++_s) { \
            const int T = (TFIRST) + (2 * _i + _s) * (STEP); LAS unsigned char* _buf = _ring + ((_i & 3) * 2 + _s) * 8192; \
            if (2 * _i + _s < _nt) {
#define STREAM_END } } } asm volatile("s_waitcnt vmcnt(0) lgkmcnt(0)" ::: "memory"); __builtin_amdgcn_s_barrier(); }

__device__ __forceinline__ void wg_fox(const Params& P, const Frame& F, int layer, int h, int qb) {
    const int lane = F.lane, c = lane & 31, hg = lane >> 5, w = F.wave, t0 = qb * 256 + 32 * w, t = t0 + c;
    const float SH = gain_bound(P.fox_qk_g + layer * 128, P.fox_qk_g + layer * 128 + 64, lane);
    const float* cs = (const float*)(F.ws + WS_CS) + (size_t)h * SEQ;
    const bf16* qrow = F.PA + (size_t)t * PAC + C_FQ + h * 64;
    bf16x8 qf[4];
#pragma unroll
    for (int ks = 0; ks < 4; ++ks) qf[ks] = *(const bf16x8*)(qrow + ks * 16 + hg * 8);
    const float cq = cs[t];
    const float lim = -(2.f * SH + 40.f);
    const int Thw = qb * 8 + w, THI = qb * 8 + 7;
    int low, LO;
    { const float cs0 = cs[t0]; int lo = 0, hi = Thw; while (lo < hi) { const int mid = (lo + hi) >> 1; if (cs0 - cs[32 * mid + 31] >= lim) hi = mid; else lo = mid + 1; } low = lo; }
    { const float cs0 = cs[qb * 256]; int lo = 0, hi = qb * 8; while (lo < hi) { const int mid = (lo + hi) >> 1; if (cs0 - cs[32 * mid + 31] >= lim) hi = mid; else lo = mid + 1; } LO = lo; }
    low = __builtin_amdgcn_readfirstlane(low); LO = __builtin_amdgcn_readfirstlane(LO);
    const bf16* KF = (const bf16*)(F.ws + WS_KF) + (size_t)(8 + h) * STREAM_ELEMS;
    const bf16* VF = (const bf16*)(F.ws + WS_VF) + (size_t)(8 + h) * STREAM_ELEMS;
    f32x16 o[2]; ZERO_O(o); float l = 0.f;
    const int LOp = LO > 0 ? LO - 1 : 0, kbase = 32 * LOp, ncs = (THI - LOp + 1) * 32;
    LAS float* csl = (LAS float*)F.lds;
    for (int i = F.tid; i < ncs; i += 512) csl[i] = cs[kbase + i];
    STREAM_BEGIN(KF, VF, THI, -1, THI - LO + 1)
        if (T <= Thw && T >= low) {
            const f32x16 s = qk_lds(_buf, qf, lane);
            f32x4 ck[4];
#pragma unroll
            for (int g = 0; g < 4; ++g) ck[g] = *(const LAS f32x4*)(csl + 32 * T - kbase + 8 * g + 4 * hg);
            float e[16];
#pragma unroll
            for (int r = 0; r < 16; ++r) { const int key = 32 * T + crow(r, hg);
                e[r] = key <= t ? __builtin_amdgcn_exp2f(s[r] - SH + (cq - ck[r >> 2][r & 3])) : 0.f; l += e[r]; }
            pv_lds(_buf, e, o, lane);
        }
    STREAM_END
    l += shx(l, 32, lane);
    write_gated(F, o, l > 0.f ? 1.f / l : 0.f, t, C_OF + h * 64, C_FZ + h * 64, hg);
}

__device__ __forceinline__ void moba_load_block(const Frame& F, int h, int j) {
    const bf16* src = (const bf16*)(F.ws + (F.tid < 256 ? WS_KF : WS_VF)) + (size_t)h * STREAM_ELEMS + (size_t)(j * 8) * 2048 + (F.tid & 255) * 8;
    u32x4 r[8];
#pragma unroll
    for (int tt = 0; tt < 8; ++tt) r[tt] = *(const u32x4*)(src + tt * 2048);
#pragma unroll
    for (int tt = 0; tt < 8; ++tt) *(LAS u32x4*)(F.lds + RING_OFF + tt * 8192 + F.tid * 16) = r[tt];
    __syncthreads();
}
__device__ __forceinline__ void wg_moba_own(const Params& P, const Frame& F, int layer, int h, int blk) {
    const int lane = F.lane, c = lane & 31, hg = lane >> 5, w = F.wave, t0 = blk * 256 + 32 * w, t = t0 + c;
    const float SH = gain_bound(P.moba_qk_g + layer * 128, P.moba_qk_g + layer * 128 + 64, lane);
    const bf16* qrow = F.PA + (size_t)t * PAC + C_MQ + h * 64;
    bf16x8 qf[4];
#pragma unroll
    for (int ks = 0; ks < 4; ++ks) qf[ks] = *(const bf16x8*)(qrow + ks * 16 + hg * 8);
    moba_load_block(F, h, blk);
    f32x16 o[2]; ZERO_O(o); float l = 0.f;
    for (int tt = 0; tt <= w; ++tt) {
        LAS unsigned char* buf = F.lds + RING_OFF + tt * 8192;
        const f32x16 s = qk_lds(buf, qf, lane);
        float e[16];
#pragma unroll
        for (int r = 0; r < 16; ++r) { const int key = blk * 256 + 32 * tt + crow(r, hg); e[r] = key <= t ? __builtin_amdgcn_exp2f(s[r] - SH) : 0.f; l += e[r]; }
        pv_lds(buf, e, o, lane);
    }
    l += shx(l, 32, lane);
    bf16* rowp = F.PA + (size_t)t * PAC + C_OM + h * 64;
#pragma unroll
    for (int dt = 0; dt < 2; ++dt)
#pragma unroll
        for (int g = 0; g < 4; ++g) { u32x2 wv; wv.x = cvt_pk_bf16(o[dt][4 * g], o[dt][4 * g + 1]); wv.y = cvt_pk_bf16(o[dt][4 * g + 2], o[dt][4 * g + 3]);
            *(u32x2*)(rowp + dt * 32 + 8 * g + 4 * hg) = wv; }
    if (hg == 0) ((float*)(F.ws + WS_LOWN))[h * SEQ + t] = l;
    __syncthreads();
}
__device__ __forceinline__ void wg_moba_sel(const Params& P, const Frame& F, int layer, int h, int j) {
    const int lane = F.lane, c = lane & 31, hg = lane >> 5, w = F.wave;
    const int n = (int)((const unsigned*)(F.ws + WS_CTL))[64 + 512 * layer + h * 64 + j];
    if (n == 0) return;
    const float SH = gain_bound(P.moba_qk_g + layer * 128, P.moba_qk_g + layer * 128 + 64, lane);
    moba_load_block(F, h, j);
    const unsigned short* list = (const unsigned short*)(F.ws + WS_LIST) + (size_t)h * LIST_HEAD + list_off(j);
    bf16* PART = (bf16*)(F.ws + WS_PART); float* LPART = (float*)(F.ws + WS_LPART);
    for (int cb = w * 32; cb < n; cb += 256) {
        const int i = cb + c; const bool valid = i < n;
        const unsigned ent = list[valid ? i : cb];
        const int t = (int)(ent >> 2), slot = (int)(ent & 3u);
        const bf16* qrow = F.PA + (size_t)t * PAC + C_MQ + h * 64;
        bf16x8 qf[4];
#pragma unroll
        for (int ks = 0; ks < 4; ++ks) qf[ks] = *(const bf16x8*)(qrow + ks * 16 + hg * 8);
        f32x16 o[2]; ZERO_O(o); float l = 0.f;
#pragma unroll 2
        for (int tt = 0; tt < 8; ++tt) {
            LAS unsigned char* buf = F.lds + RING_OFF + tt * 8192;
            const f32x16 s = qk_lds(buf, qf, lane);
            float e[16];
#pragma unroll
            for (int r = 0; r < 16; ++r) { e[r] = __builtin_amdgcn_exp2f(s[r] - SH); l += e[r]; }
            pv_lds(buf, e, o, lane);
        }
        l += shx(l, 32, lane);
        if (valid) {
            const size_t rec = ((size_t)h * SEQ + t) * 3 + slot;
            bf16* pp = PART + rec * 64;
#pragma unroll
            for (int dt = 0; dt < 2; ++dt)
#pragma unroll
                for (int g = 0; g < 4; ++g) { u32x2 wv; wv.x = cvt_pk_bf16(o[dt][4 * g], o[dt][4 * g + 1]); wv.y = cvt_pk_bf16(o[dt][4 * g + 2], o[dt][4 * g + 3]);
                    *(u32x2*)(pp + dt * 32 + 8 * g + 4 * hg) = wv; }
            if (hg == 0) LPART[rec] = l;
        }
    }
    __syncthreads();
}

__device__ __forceinline__ void wg_nsa(const Params& P, const Frame& F, int layer, int qb) {
    const int lane = F.lane, c = lane & 31, hg = lane >> 5, w = F.wave, qi = c >> 2, h = c & 3, t0 = qb * 64 + 8 * w, t = t0 + qi, cur = qb;
    const float* kg = P.nsa_k_g + layer * 192; const float* qg = P.nsa_q_g + layer * 64;
    const float SHc = gain_bound(qg, kg, lane), SHs = gain_bound(qg, kg + 64, lane), SHw = gain_bound(qg, kg + 128, lane);
    const bf16* prow = F.PA + (size_t)t * PAC;
    bf16x8 qf[4];
#pragma unroll
    for (int ks = 0; ks < 4; ++ks) qf[ks] = *(const bf16x8*)(prow + C_NQ + h * 64 + ks * 16 + hg * 8);
    const float g0 = sigmoidf_(bf2f(prow[C_NG + h * 3 + 0])), g1 = sigmoidf_(bf2f(prow[C_NG + h * 3 + 1])), g2 = sigmoidf_(bf2f(prow[C_NG + h * 3 + 2]));
    LAS float* imp = (LAS float*)(F.lds + w * 8192);
    f32x16 accF[2]; ZERO_O(accF);
    f32x16 o[2]; float l;
    const int ntw = (t0 + 7 >= 31) ? (((t0 + 7 - 31) >> 4) >> 5) + 1 : 0;
    const int NT = (qb * 64 + 63 >= 31) ? (((qb * 64 + 63 - 31) >> 4) >> 5) + 1 : 0;
    const bf16* KC = (const bf16*)(F.ws + WS_KCMP); const bf16* VC = (const bf16*)(F.ws + WS_VCMP);
    ZERO_O(o); l = 0.f;
    STREAM_BEGIN(KC, VC, 0, 1, NT)
        if (T < ntw) {
            const f32x16 s = qk_lds(_buf, qf, lane);
            float e[16];
#pragma unroll
            for (int r = 0; r < 16; ++r) { const int n = 32 * T + crow(r, hg); e[r] = (16 * n + 31 <= t) ? __builtin_amdgcn_exp2f(s[r] - SHc) : 0.f; l += e[r]; }
            pv_lds(_buf, e, o, lane);
        }
    STREAM_END
    l += shx(l, 32, lane);
    const float invc = l > 0.f ? 1.f / l : 0.f;
    {
        const float sc = g0 * invc;
#pragma unroll
        for (int r = 0; r < 16; ++r) { accF[0][r] += sc * o[0][r]; accF[1][r] += sc * o[1][r]; }
    }
    {
        float prevEx = 0.f;
        STREAM_BEGIN(KC, VC, 0, 1, NT)
            if (T < ntw) {
                const f32x16 s = qk_lds(_buf, qf, lane);
#pragma unroll
                for (int g = 0; g < 4; ++g) {
                    float s4 = 0.f, ed = 0.f;
#pragma unroll
                    for (int k = 0; k < 4; ++k) { const int r = 4 * g + k; const int n = 32 * T + crow(r, hg);
                        const float p = (16 * n + 31 <= t) ? __builtin_amdgcn_exp2f(s[r] - SHc) * invc : 0.f; s4 += p; if (k == 3) ed = p; }
                    s4 += shx(s4, 1, lane); s4 += shx(s4, 2, lane); ed += shx(ed, 1, lane); ed += shx(ed, 2, lane);
                    const float Ex = shx(ed, 32, lane);
                    const float Sp = s4 + (hg ? Ex : prevEx); prevEx = Ex;
                    if (h == 0) imp[qi * 256 + 8 * T + 2 * g + hg] = Sp;
                }
            }
        STREAM_END
    }
    unsigned long long my0 = 0ull, my1 = 0ull, my2 = 0ull, my3 = 0ull, un0 = 0ull, un1 = 0ull, un2 = 0ull, un3 = 0ull;
    {
        const int qs = lane >> 3, sub = lane & 7;
        float val[32];
#pragma unroll
        for (int k = 0; k < 32; ++k) { const int m = sub + 8 * k;
            const float iv = imp[qs * 256 + m];
            val[k] = (m > cur) ? -3e38f : ((m == 0 || m == cur || m == cur - 1) ? 3e38f : iv); }
        const int nsel = cur + 1 < 16 ? cur + 1 : 16;
        for (int rd = 0; rd < nsel; ++rd) {
            float bv = val[0]; int bk = 0;
#pragma unroll
            for (int k = 1; k < 32; ++k) if (val[k] > bv) { bv = val[k]; bk = k; }
            int bm = sub + 8 * bk;
#pragma unroll
            for (int of = 1; of < 8; of <<= 1) { const float ov = shx(bv, of, lane); const int om = shxi(bm, of, lane);
                if (ov > bv || (ov == bv && om < bm)) { bv = ov; bm = om; } }
#pragma unroll
            for (int k = 0; k < 32; ++k) if (sub + 8 * k == bm) val[k] = -3e38f;
            const int wa = shfromi(bm, (c >> 2) * 8);
            { const unsigned long long bit = 1ull << (wa & 63); const int kk = wa >> 6;
              my0 |= kk == 0 ? bit : 0ull; my1 |= kk == 1 ? bit : 0ull; my2 |= kk == 2 ? bit : 0ull; my3 |= kk == 3 ? bit : 0ull; }
#pragma unroll
            for (int q = 0; q < 8; ++q) { const int wq = __builtin_amdgcn_readlane(bm, q * 8); const unsigned long long bit = 1ull << (wq & 63); const int kk = wq >> 6;
                un0 |= kk == 0 ? bit : 0ull; un1 |= kk == 1 ? bit : 0ull; un2 |= kk == 2 ? bit : 0ull; un3 |= kk == 3 ? bit : 0ull; }
        }
    }
    const bf16* KS = (const bf16*)(F.ws + WS_KF) + (size_t)6 * STREAM_ELEMS; const bf16* VS = (const bf16*)(F.ws + WS_VF) + (size_t)6 * STREAM_ELEMS;
    ZERO_O(o); l = 0.f;
    STREAM_BEGIN(KS, VS, 0, 1, 2 * (cur + 1))
        const int m = T >> 1, kk = m >> 6, b = m & 63;
        const unsigned long long uw = kk == 0 ? un0 : (kk == 1 ? un1 : (kk == 2 ? un2 : un3));
        if ((uw >> b) & 1ull) {
            const unsigned long long mw = kk == 0 ? my0 : (kk == 1 ? my1 : (kk == 2 ? my2 : my3));
            const bool flag = (mw >> b) & 1ull;
            const f32x16 s = qk_lds(_buf, qf, lane);
            float e[16];
#pragma unroll
            for (int r = 0; r < 16; ++r) { const int key = 32 * T + crow(r, hg); e[r] = (flag && key <= t) ? __builtin_amdgcn_exp2f(s[r] - SHs) : 0.f; l += e[r]; }
            pv_lds(_buf, e, o, lane);
        }
    STREAM_END
    l += shx(l, 32, lane);
    {
        const float sc = l > 0.f ? g1 / l : 0.f;
#pragma unroll
        for (int r = 0; r < 16; ++r) { accF[0][r] += sc * o[0][r]; accF[1][r] += sc * o[1][r]; }
    }
    const bf16* KW = (const bf16*)(F.ws + WS_KF) + (size_t)7 * STREAM_ELEMS; const bf16* VW = (const bf16*)(F.ws + WS_VF) + (size_t)7 * STREAM_ELEMS;
    ZERO_O(o); l = 0.f;
    const int Tlw = (t0 - 511 > 0 ? t0 - 511 : 0) >> 5, Thw = (t0 + 7) >> 5;
    const int TLO = (qb * 64 - 511 > 0 ? qb * 64 - 511 : 0) >> 5, THI = (qb * 64 + 63) >> 5;
    STREAM_BEGIN(KW, VW, TLO, 1, THI - TLO + 1)
        if (T >= Tlw && T <= Thw) {
            const f32x16 s = qk_lds(_buf, qf, lane);
            float e[16];
#pragma unroll
            for (int r = 0; r < 16; ++r) { const int key = 32 * T + crow(r, hg); e[r] = (key <= t && key >= t - 511) ? __builtin_amdgcn_exp2f(s[r] - SHw) : 0.f; l += e[r]; }
            pv_lds(_buf, e, o, lane);
        }
    STREAM_END
    l += shx(l, 32, lane);
    {
        const float sc = l > 0.f ? g2 / l : 0.f;
#pragma unroll
        for (int r = 0; r < 16; ++r) { accF[0][r] += sc * o[0][r]; accF[1][r] += sc * o[1][r]; }
    }
    write_gated(F, accF, 1.f, t, C_ON + h * 64, C_NZ + h * 64, hg);
}

__device__ __forceinline__ void phase4a(const Params& P, const Frame& F0, int layer, int rep) {
    unsigned* ctr = (unsigned*)(F0.ws + WS_CTL) + 16 * layer + 8 * rep;
    constexpr int N_NSA = 256, N_FOX = 384, N_SEL = 384, N_OWN = 384, N_ALL = N_NSA + N_FOX + N_SEL + N_OWN;
    volatile LAS unsigned* ubox = (volatile LAS unsigned*)(F0.lds + 131072);
    for (;;) {
        Frame F = F0;
        { unsigned char* wp = F0.ws; asm volatile("" : "+s"(wp)); int tv = F0.tid; asm volatile("" : "+v"(tv)); F.ws = wp; F.PA = (bf16*)(wp + WS_PA); F.tid = tv; F.lane = tv & 63; }
        if (F.tid == 0) *ubox = __hip_atomic_fetch_add(ctr, 1u, __ATOMIC_RELAXED, __HIP_MEMORY_SCOPE_AGENT);
        __syncthreads();
        const unsigned u = __builtin_amdgcn_readfirstlane(*ubox);
        __syncthreads();
        if (u >= (unsigned)N_ALL) break;
        if (u < (unsigned)N_NSA) wg_nsa(P, F, layer, 255 - (int)u);
        else if (u < (unsigned)(N_NSA + N_FOX)) { const unsigned v = u - N_NSA; wg_fox(P, F, layer, (int)(v % 6), 63 - (int)(v / 6)); }
        else if (u < (unsigned)(N_NSA + N_FOX + N_SEL)) { const unsigned v = u - (N_NSA + N_FOX); wg_moba_sel(P, F, layer, (int)(v % 6), (int)(v / 6)); }
        else { const unsigned v = u - (N_NSA + N_FOX + N_SEL); wg_moba_own(P, F, layer, (int)(v % 6), 63 - (int)(v / 6)); }
    }
}

__device__ __forceinline__ void phase4b(const Params& P, const Frame& F, int layer, const float* xin) {
    const bf16* PART = (const bf16*)(F.ws + WS_PART); const float* LPART = (const float*)(F.ws + WS_LPART); const float* LOWN = (const float*)(F.ws + WS_LOWN);
    for (int it = F.gw; it < SEQ * 48 / 64; it += F.NGW) {
        const int idx = it * 64 + F.lane, t = idx / 48, r = idx - t * 48, h = r >> 3, d8 = (r & 7) * 8, cur = t >> 8;
        bf16* op = F.PA + (size_t)t * PAC + C_OM + h * 64 + d8;
        const u32x4 ow = *(const u32x4*)op;
        float v[8] = {bflo(ow.x), bfhi(ow.x), bflo(ow.y), bfhi(ow.y), bflo(ow.z), bfhi(ow.z), bflo(ow.w), bfhi(ow.w)};
        float l = LOWN[h * SEQ + t];
        const size_t rec = ((size_t)h * SEQ + t) * 3;
#pragma unroll
        for (int s = 0; s < 3; ++s) if (s < cur) {
            const u32x4 pw = *(const u32x4*)(PART + (rec + s) * 64 + d8);
            v[0] += bflo(pw.x); v[1] += bfhi(pw.x); v[2] += bflo(pw.y); v[3] += bfhi(pw.y); v[4] += bflo(pw.z); v[5] += bfhi(pw.z); v[6] += bflo(pw.w); v[7] += bfhi(pw.w);
            l += LPART[rec + s];
        }
        const float inv = l > 0.f ? 1.f / l : 0.f;
        const u32x4 z = *(const u32x4*)(F.PA + (size_t)t * PAC + C_MZ + h * 64 + d8);
        u32x4 wv;
        wv.x = cvt_pk_bf16(v[0] * inv * siluf_(bflo(z.x)), v[1] * inv * siluf_(bfhi(z.x))); wv.y = cvt_pk_bf16(v[2] * inv * siluf_(bflo(z.y)), v[3] * inv * siluf_(bfhi(z.y)));
        wv.z = cvt_pk_bf16(v[4] * inv * siluf_(bflo(z.z)), v[5] * inv * siluf_(bfhi(z.z))); wv.w = cvt_pk_bf16(v[6] * inv * siluf_(bflo(z.w)), v[7] * inv * siluf_(bfhi(z.w)));
        *(u32x4*)op = wv;
    }
    rms_rows(P, F, layer, xin, (bf16*)(F.ws + WS_H2));
}

__global__ void __launch_bounds__(512, 2) fwd_kernel(Params P) {
    extern __shared__ __attribute__((aligned(16))) unsigned char lds_raw[];
    cg::grid_group grid = cg::this_grid();
    const int G = gridDim.x, bx = blockIdx.x;
    for (int ph = P.ph_lo; ph < P.ph_hi; ++ph) {
        unsigned char* wsb = P.ws; asm volatile("" : "+s"(wsb));
        int tidv = threadIdx.x; asm volatile("" : "+v"(tidv));
        Frame F;
        F.lds = (LAS unsigned char*)lds_raw;
        F.tid = tidv; F.lane = F.tid & 63; F.wave = __builtin_amdgcn_readfirstlane(F.tid >> 6);
        F.gw = bx * 8 + F.wave; F.NGW = G * 8;
        F.ws = wsb; F.PA = (bf16*)(wsb + WS_PA);
        const int layer = ph / NPH, k = ph - layer * NPH;
        const float* xin = layer == 0 ? P.x : P.out;
        if (k == 0) phase0(P, F, layer, xin);
        else if (k == 1 || k == 6) {
            pg8::Gemm g; pg8::StaticOrder S; pg8::EpiBf16 E;
            if (k == 1) { g = pg8::Gemm{(const bf16*)(wsb + WS_H), (const bf16*)(wsb + WS_WA), SEQ, PAC, DM, DM}; S.init(SEQ, PAC, G, bx); E = pg8::EpiBf16{F.PA, PAC}; }
            else { g = pg8::Gemm{(const bf16*)(wsb + WS_H2), (const bf16*)(wsb + WS_WG), SEQ, NGL, DM, DM}; S.init(SEQ, NGL, G, bx); E = pg8::EpiBf16{F.PA + C_GL, PAC}; }
            pg8::gemm_phase<pg8::EpiBf16, pg8::StaticOrder>(F.lds, g, S, E, F.tid);
        }
        else if (k == 2) phase2(P, F, layer);
        else if (k == 3) phase3(P, F, layer);
        else if (k == 4) {
#ifdef PROBE_P4X2
            for (int rep = 0; rep < 2; ++rep) { if (rep) grid.sync(); phase4a(P, F, layer, rep); }
#else
            phase4a(P, F, layer, 0);
#endif
        }
        else if (k == 5) phase4b(P, F, layer, xin);
        else if (k == 7) {
            for (int b = 0; b < 3; ++b) {
                const int Kb = b == 1 ? 256 : 384;
                const bf16* A = F.PA + (b == 0 ? C_OM : (b == 1 ? C_ON : C_OF));
                const bf16* Bt = (const bf16*)(wsb + (b == 0 ? WS_WUPM : (b == 1 ? WS_WUPN : WS_WUPF)));
                pg8::Gemm g{A, Bt, SEQ, DM, Kb, PAC}; pg8::StaticOrder S; S.init(SEQ, DM, G, bx);
                pg8::EpiMerge E{(bf16*)(wsb + WS_H), F.PA + C_GL + b * 1024, P.b_gate + layer * 3072 + b * 1024, b == 0 ? 1 : 0};
                pg8::gemm_phase<pg8::EpiMerge, pg8::StaticOrder>(F.lds, g, S, E, F.tid);
            }
        }
        else {
            pg8::Gemm g{(const bf16*)(wsb + WS_H), (const bf16*)(wsb + WS_WO), SEQ, DM, DM, DM}; pg8::StaticOrder S; S.init(SEQ, DM, G, bx);
            pg8::EpiOut E{xin, P.out};
            pg8::gemm_phase<pg8::EpiOut, pg8::StaticOrder>(F.lds, g, S, E, F.tid);
        }
        if (ph + 1 < P.ph_hi) grid.sync();
    }
}

extern "C" void kernel_launch(void* const* d_in, const int* in_sizes, int n_in, void* d_out, int out_size, void* d_ws, size_t ws_size, hipStream_t stream) {
    static int grid = 0;
    if (grid == 0) {
        if (n_in != 16 || out_size != SEQ * DM || ws_size < WS_END) { fprintf(stderr, "kernel_launch: unexpected problem shape (n_in %d out %d ws %zu)\n", n_in, out_size, ws_size); grid = -1; return; }
        int dev = 0, cus = 0, per_cu = 0;
        hipGetDevice(&dev);
        hipDeviceGetAttribute(&cus, hipDeviceAttributeMultiprocessorCount, dev);
        hipFuncSetAttribute((const void*)fwd_kernel, hipFuncAttributeMaxDynamicSharedMemorySize, LDS_BYTES);
        hipOccupancyMaxActiveBlocksPerMultiprocessor(&per_cu, (const void*)fwd_kernel, 512, LDS_BYTES);
        if (per_cu < 1) { fprintf(stderr, "kernel_launch: occupancy query says %d blocks per CU\n", per_cu); per_cu = 1; }
        (void)hipGetLastError();
        grid = cus * per_cu;
    }
    if (grid < 0) return;
    Params p{};
    p.x = (const float*)d_in[0]; p.norm_g = (const float*)d_in[1]; p.w_in = (const float*)d_in[2]; p.b_f = (const float*)d_in[3]; p.b_gate = (const float*)d_in[4];
    p.moba_qk_g = (const float*)d_in[5]; p.nsa_q_g = (const float*)d_in[6]; p.nsa_k_g = (const float*)d_in[7]; p.fox_qk_g = (const float*)d_in[8];
    p.cmp_pe = (const float*)d_in[9]; p.cmp_w1 = (const float*)d_in[10]; p.cmp_w2 = (const float*)d_in[11];
    p.w_up_moba = (const float*)d_in[12]; p.w_up_nsa = (const float*)d_in[13]; p.w_up_fox = (const float*)d_in[14]; p.w_out = (const float*)d_in[15];
    p.out = (float*)d_out; p.ws = (unsigned char*)d_ws;
#if N_LAUNCH_MODE == 1
    for (int ph = 0; ph < 2 * NPH; ++ph) { p.ph_lo = ph; p.ph_hi = ph + 1; hipLaunchKernelGGL(fwd_kernel, dim3(grid), dim3(512), LDS_BYTES, stream, p); }
#else
    p.ph_lo = 0; p.ph_hi = 2 * NPH;
    void* args[] = {&p};
    hipError_t e = hipLaunchCooperativeKernel((const void*)fwd_kernel, dim3(grid), dim3(512), args, LDS_BYTES, stream);
    if (e != hipSuccess) fprintf(stderr, "kernel_launch: cooperative launch failed: %s (grid %d)\n", hipGetErrorString(e), grid);
#endif
}
```

```cpp
#include <hip/hip_runtime.h>
#include <hip/hip_cooperative_groups.h>
#include <cstdio>
#include <cstdint>
namespace cg = cooperative_groups;

#ifndef N_LAUNCH_MODE
#define N_LAUNCH_MODE 0
#endif

typedef unsigned short bf16;
typedef short bf16x8 __attribute__((ext_vector_type(8)));
typedef float f32x4 __attribute__((ext_vector_type(4)));
typedef float f32x16 __attribute__((ext_vector_type(16)));
typedef unsigned u32x4 __attribute__((ext_vector_type(4)));
typedef unsigned u32x2 __attribute__((ext_vector_type(2)));
#define LAS __attribute__((address_space(3)))

constexpr int SEQ = 16384, DM = 1024, INC = 7058, PAC = 4096, NGL = 3072;
constexpr float LOG2E = 1.4426950408889634f;
constexpr float C2 = 0.125f * LOG2E;
constexpr float RMS_EPS = 1e-6f;
constexpr int LDS_BYTES = 131072 + 256;
constexpr int NPH = 8;

constexpr int C_MK = 0, C_MV = 384, C_KC = 768, C_VC = 832, C_KSL = 896, C_VSL = 960, C_MQ = 1024, C_MZ = 1408, C_NQ = 1792, C_KW = 2048, C_VW = 2112,
              C_NZ = 2176, C_FQ = 2432, C_FK = 2816, C_FV = 3200, C_FZ = 3584, C_NG = 3968, C_FF = 3980, C_GL = 1024;
constexpr int C_OM = 0, C_OF = 384, C_ON = 768;

constexpr size_t MiB = 1u << 20;
constexpr size_t WS_BAR = 512 * 1024  ;
constexpr size_t WS_CTL = 0, WS_WA = 1 * MiB, WS_WG = 9 * MiB, WS_WUPM = 15 * MiB, WS_WUPN = 15 * MiB + 768 * 1024, WS_WUPF = 15 * MiB + 1280 * 1024,
                 WS_WO = 17 * MiB, WS_W1T = 19 * MiB, WS_W2T = 21 * MiB, WS_KMEAN = 21 * MiB + 128 * 1024,
                 WS_CS = 21 * MiB + 256 * 1024, WS_CSTOT = 21 * MiB + 768 * 1024, WS_KCMP = 22 * MiB, WS_VCMP = 22 * MiB + 128 * 1024,
                 WS_KF = 23 * MiB, WS_VF = 51 * MiB, WS_MG = 23 * MiB  , WS_PA = 80 * MiB,
                 WS_H = 208 * MiB  , WS_P2 = 240 * MiB  ,
                 WS_LIST = 1 * MiB  , WS_LPART = 19 * MiB, WS_LOWN = 19 * MiB + 1280 * 1024  ,
                 WS_END = 256 * MiB;
constexpr size_t STREAM_ELEMS = (size_t)SEQ * 64;

struct Params {
    const float* x; const float* norm_g; const float* w_in; const float* b_f; const float* b_gate;
    const float* moba_qk_g; const float* nsa_q_g; const float* nsa_k_g; const float* fox_qk_g;
    const float* cmp_pe; const float* cmp_w1; const float* cmp_w2; const float* w_up_moba; const float* w_up_nsa; const float* w_up_fox; const float* w_out;
    float* out; unsigned char* ws; int ph_lo, ph_hi;
};

typedef float f32x2_t __attribute__((ext_vector_type(2)));
typedef __bf16 bf16x2_t __attribute__((ext_vector_type(2)));
__device__ __forceinline__ unsigned cvt_pk_bf16(float lo, float hi) { const f32x2_t v = {lo, hi}; const bf16x2_t b = __builtin_convertvector(v, bf16x2_t); return __builtin_bit_cast(unsigned, b); }
__device__ __forceinline__ float bf2f(unsigned short b) { return __builtin_bit_cast(float, (unsigned)b << 16); }
__device__ __forceinline__ float bflo(unsigned w) { return __builtin_bit_cast(float, w << 16); }
__device__ __forceinline__ float bfhi(unsigned w) { return __builtin_bit_cast(float, w & 0xffff0000u); }
__device__ __forceinline__ unsigned short f2bf(float f) { return (unsigned short)(cvt_pk_bf16(f, 0.f) & 0xffffu); }
__device__ __forceinline__ float shx(float v, int m, int lane) { return __builtin_bit_cast(float, __builtin_amdgcn_ds_bpermute((lane ^ m) << 2, __builtin_bit_cast(int, v))); }
__device__ __forceinline__ int shxi(int v, int m, int lane) { return __builtin_amdgcn_ds_bpermute((lane ^ m) << 2, v); }
__device__ __forceinline__ float shfrom(float v, int src) { return __builtin_bit_cast(float, __builtin_amdgcn_ds_bpermute(src << 2, __builtin_bit_cast(int, v))); }
__device__ __forceinline__ int shfromi(int v, int src) { return __builtin_amdgcn_ds_bpermute(src << 2, v); }
__device__ __forceinline__ float dpp_x1(float v) { return __builtin_bit_cast(float, __builtin_amdgcn_update_dpp(0, __builtin_bit_cast(int, v), 0xB1, 0xf, 0xf, false)); }
__device__ __forceinline__ float dpp_x2(float v) { return __builtin_bit_cast(float, __builtin_amdgcn_update_dpp(0, __builtin_bit_cast(int, v), 0x4E, 0xf, 0xf, false)); }
__device__ __forceinline__ float wave_sum(float v, int lane) {
#pragma unroll
    for (int o = 1; o < 64; o <<= 1) v += shx(v, o, lane);
    return v;
}
__device__ __forceinline__ float wave_max(float v, int lane) {
#pragma unroll
    for (int o = 1; o < 64; o <<= 1) v = fmaxf(v, shx(v, o, lane));
    return v;
}
__device__ __forceinline__ int crow(int r, int hi) { return (r & 3) + 8 * (r >> 2) + 4 * hi; }
__device__ __forceinline__ float sigmoidf_(float z) { return __builtin_amdgcn_rcpf(1.f + __builtin_amdgcn_exp2f(-LOG2E * z)); }
__device__ __forceinline__ float siluf_(float z) { return z * __builtin_amdgcn_rcpf(1.f + __builtin_amdgcn_exp2f(-LOG2E * z)); }
#define MFMA32(a, b, c) __builtin_amdgcn_mfma_f32_32x32x16_bf16((a), (b), (c), 0, 0, 0)
#define LDS_FENCE() asm volatile("s_waitcnt lgkmcnt(0)" ::: "memory")

namespace pg8 {
typedef unsigned short bf16_t;
constexpr int BM = 256, BK = 64, HALF = 128, HTB = HALF * BK * 2, NXCD = 8, WGM = 8;
__host__ __device__ __forceinline__ int lds_byte(int r, int c) { const int st = (r >> 4) * 2 + (c >> 5), rr = r & 15, cc = c & 31, ob = rr * 64 + cc * 2; return st * 1024 + (ob ^ (((ob >> 9) & 1) << 5)); }
__host__ __device__ __forceinline__ void stage_rc(int b, int& R, int& C) { const int st = b / 1024, sb = b % 1024, swz = sb ^ (((sb >> 9) & 1) << 5); R = (st >> 1) * 16 + swz / 64; C = (st & 1) * 32 + (swz % 64) / 2; }
__host__ __device__ __forceinline__ int perm32(int rho) { const int n = rho >> 4, i = rho & 15; return 8 * (i >> 2) + 4 * n + (i & 3); }
struct Unit { int pm, pn; };
struct Gemm { const bf16_t* A; const bf16_t* Bt; int M, N, K, lda; };
struct StaticOrder {
    int nM, nN, nwg, G, c;
    __device__ void init(int M, int N, int G_, int c_) { nM = M / BM; nN = N / BM; nwg = nM * nN; G = G_; c = c_; }
    __device__ bool next(int i, Unit& u) const {
        const long L = (long)i * G + c; if (L >= nwg) return false;
        int wgid = (int)L; { const int q = nwg / NXCD, r = nwg % NXCD, xcd = wgid % NXCD, off = wgid / NXCD; wgid = (xcd < r ? xcd * (q + 1) : r * (q + 1) + (xcd - r) * q) + off; }
        const int nig = WGM * nN, gid = wgid / nig, fm = gid * WGM, gsz = (nM - fm) < WGM ? (nM - fm) : WGM;
        u.pm = fm + ((wgid % nig) % gsz); u.pn = (wgid % nig) / gsz; return true;
    }
};
struct FixedUnits {
    Unit u0; int n, stride;
    __device__ bool next(int i, Unit& o) const { if (i >= n) return false; o.pm = u0.pm; o.pn = u0.pn + i * stride; return true; }
};
struct EpiBf16 {
    bf16_t* O; int ldc;
    __device__ __forceinline__ void operator()(const f32x4 (&acc)[2][2][4][2], const Unit& u, int wr, int wc, int fr, int fq) const {
        const int row0 = u.pm * BM + wr * 64 + fr, col0 = u.pn * BM + wc * 32 + 8 * fq;
#pragma unroll
        for (int ai = 0; ai < 2; ++ai)
#pragma unroll
            for (int m = 0; m < 4; ++m) { bf16_t* rowp = O + (size_t)(row0 + ai * HALF + m * 16) * ldc + col0;
#pragma unroll
                for (int bj = 0; bj < 2; ++bj) { const f32x4 v0 = acc[ai][bj][m][0], v1 = acc[ai][bj][m][1];
                    u32x4 w; w.x = cvt_pk_bf16(v0[0], v0[1]); w.y = cvt_pk_bf16(v0[2], v0[3]); w.z = cvt_pk_bf16(v1[0], v1[1]); w.w = cvt_pk_bf16(v1[2], v1[3]);
                    *(u32x4*)(rowp + bj * HALF) = w; } }
    }
};
struct EpiMerge {
    bf16_t* Mg; const bf16_t* gl; const float* bg; int first;
    __device__ __forceinline__ void operator()(const f32x4 (&acc)[2][2][4][2], const Unit& u, int wr, int wc, int fr, int fq) const {
        const int row0 = u.pm * BM + wr * 64 + fr, col0 = u.pn * BM + wc * 32 + 8 * fq;
#pragma unroll
        for (int bj = 0; bj < 2; ++bj) {
            const int col = col0 + bj * HALF;
            const f32x4 b0 = *(const f32x4*)(bg + col), b1 = *(const f32x4*)(bg + col + 4);
#pragma unroll
            for (int ai = 0; ai < 2; ++ai)
#pragma unroll
                for (int m = 0; m < 4; ++m) {
                    const size_t row = (size_t)(row0 + ai * HALF + m * 16);
                    const u32x4 g = *(const u32x4*)(gl + row * PAC + col);
                    const f32x4 a0 = acc[ai][bj][m][0], a1 = acc[ai][bj][m][1];
                    float v[8];
                    v[0] = a0[0] * sigmoidf_(bflo(g.x) + b0[0]); v[1] = a0[1] * sigmoidf_(bfhi(g.x) + b0[1]);
                    v[2] = a0[2] * sigmoidf_(bflo(g.y) + b0[2]); v[3] = a0[3] * sigmoidf_(bfhi(g.y) + b0[3]);
                    v[4] = a1[0] * sigmoidf_(bflo(g.z) + b1[0]); v[5] = a1[1] * sigmoidf_(bfhi(g.z) + b1[1]);
                    v[6] = a1[2] * sigmoidf_(bflo(g.w) + b1[2]); v[7] = a1[3] * sigmoidf_(bfhi(g.w) + b1[3]);
                    bf16_t* mp = Mg + row * DM + col;
                    if (!first) { const u32x4 p = *(const u32x4*)mp;
                        v[0] += bflo(p.x); v[1] += bfhi(p.x); v[2] += bflo(p.y); v[3] += bfhi(p.y); v[4] += bflo(p.z); v[5] += bfhi(p.z); v[6] += bflo(p.w); v[7] += bfhi(p.w); }
                    u32x4 w; w.x = cvt_pk_bf16(v[0], v[1]); w.y = cvt_pk_bf16(v[2], v[3]); w.z = cvt_pk_bf16(v[4], v[5]); w.w = cvt_pk_bf16(v[6], v[7]);
                    *(u32x4*)mp = w;
                }
        }
    }
};
struct EpiOut {
    const float* xin; float* out;
    __device__ __forceinline__ void operator()(const f32x4 (&acc)[2][2][4][2], const Unit& u, int wr, int wc, int fr, int fq) const {
        const int row0 = u.pm * BM + wr * 64 + fr, col0 = u.pn * BM + wc * 32 + 8 * fq;
#pragma unroll
        for (int ai = 0; ai < 2; ++ai)
#pragma unroll
            for (int m = 0; m < 4; ++m)
#pragma unroll
                for (int bj = 0; bj < 2; ++bj) {
                    const size_t off = (size_t)(row0 + ai * HALF + m * 16) * DM + col0 + bj * HALF;
                    const f32x4 x0 = *(const f32x4*)(xin + off), x1 = *(const f32x4*)(xin + off + 4);
                    *(f32x4*)(out + off) = x0 + acc[ai][bj][m][0]; *(f32x4*)(out + off + 4) = x1 + acc[ai][bj][m][1];
                }
    }
};

template <class Epi, class Sched>
__device__ __forceinline__ void gemm_phase(LAS unsigned char* lds, const Gemm g, const Sched& S, const Epi& E, const int tid) {
    const int wid = __builtin_amdgcn_readfirstlane(tid >> 6), lane = tid & 63, wr = wid >> 2, wc = wid & 3, fr = lane & 15, fq = lane >> 4;
    const int K = g.K, nt = K / BK, lda = g.lda;
    unsigned voffA[2], voffB[2];
#pragma unroll
    for (int i = 0; i < 2; ++i) { int R, C; stage_rc(tid * 16 + i * 8192, R, C); const int Rb = (R & ~31) + perm32(R & 31);
        voffA[i] = (unsigned)(R * lda + C) * 2u; voffB[i] = (unsigned)(Rb * K + C) * 2u; }
    const size_t kstep = (size_t)(BK * 2);
    const size_t hstepA = (size_t)HALF * lda * 2, hstepB = (size_t)HALF * K * 2;
    const size_t tstepA = 2 * hstepA, tstepB = 2 * hstepB;
    const unsigned ldsw = (unsigned)wid * 1024u;
    const int aoff = lds_byte(wr * 64 + fr, fq * 8), boff = lds_byte(wc * 32 + fr, fq * 8);
#define PG8_SA(b, h) (((b) * 2 + (h)) * HTB)
#define PG8_SB(b, h) ((4 + (b) * 2 + (h)) * HTB)
#define PG8_STAGE(bufoff, gbase, voff) do { _Pragma("unroll") for (int _i = 0; _i < 2; ++_i) \
        __builtin_amdgcn_global_load_lds((const unsigned*)((const char*)(gbase) + (voff)[_i]), (LAS unsigned*)(lds + (bufoff) + ldsw + _i * 8192), 16, 0, 0); } while (0)
#define PG8_LDA(dst, b, h) do { _Pragma("unroll") for (int m = 0; m < 4; ++m) _Pragma("unroll") for (int k = 0; k < 2; ++k) dst[m][k] = *(const LAS bf16x8*)(lds + PG8_SA(b, h) + aoff + m * 2048 + k * 1024); } while (0)
#define PG8_LDB(dst, b, h) do { _Pragma("unroll") for (int n = 0; n < 2; ++n) _Pragma("unroll") for (int k = 0; k < 2; ++k) dst[n][k] = *(const LAS bf16x8*)(lds + PG8_SB(b, h) + boff + n * 2048 + k * 1024); } while (0)
#define PG8_MMA(ai, bj, At, Bt) do { __builtin_amdgcn_s_setprio(1); _Pragma("unroll") for (int m = 0; m < 4; ++m) _Pragma("unroll") for (int n = 0; n < 2; ++n) _Pragma("unroll") for (int k = 0; k < 2; ++k) \
        acc[ai][bj][m][n] = __builtin_amdgcn_mfma_f32_16x16x32_bf16(Bt[n][k], At[m][k], acc[ai][bj][m][n], 0, 0, 0); __builtin_amdgcn_s_setprio(0); } while (0)
#define PG8_WAIT_V(n) asm volatile("s_waitcnt vmcnt(" #n ")" ::: "memory")
#define PG8_WAIT_L(n) asm volatile("s_waitcnt lgkmcnt(" #n ")" ::: "memory")
#define PG8_BAR __builtin_amdgcn_s_barrier()
#define PG8_SCHED __builtin_amdgcn_sched_barrier(0)
    Unit cur, nxt; int ui = 0;
    if (!S.next(0, cur)) return;
    f32x4 acc[2][2][4][2];
#pragma unroll
    for (int a = 0; a < 2; ++a)
#pragma unroll
        for (int b = 0; b < 2; ++b)
#pragma unroll
            for (int m = 0; m < 4; ++m)
#pragma unroll
                for (int n = 0; n < 2; ++n) acc[a][b][m][n] = (f32x4){0.f, 0.f, 0.f, 0.f};
    bf16x8 At[4][2], B0[2][2], B1[2][2];
    const char* cA = (const char*)g.A + (size_t)cur.pm * tstepA; const char* cB = (const char*)g.Bt + (size_t)cur.pn * tstepB;
    PG8_STAGE(PG8_SB(0, 0), cB, voffB); PG8_STAGE(PG8_SB(0, 1), cB + hstepB, voffB); PG8_STAGE(PG8_SA(0, 0), cA, voffA); PG8_STAGE(PG8_SA(0, 1), cA + hstepA, voffA);
    if (wr == 1) PG8_BAR;
    PG8_WAIT_V(2); PG8_BAR;
    PG8_STAGE(PG8_SB(1, 0), cB + kstep, voffB); PG8_STAGE(PG8_SA(1, 0), cA + kstep, voffA); PG8_STAGE(PG8_SB(1, 1), cB + hstepB + kstep, voffB);
    PG8_WAIT_V(6); PG8_BAR;
    for (;;) {
        const bool has_next = S.next(ui + 1, nxt);
        const char* nA = has_next ? (const char*)g.A + (size_t)nxt.pm * tstepA : cA; const char* nB = has_next ? (const char*)g.Bt + (size_t)nxt.pn * tstepB : cB;
        for (int t = 0; t < nt; t += 2) {
            const bool last = (t == nt - 2);
            const char* a1 = cA + (size_t)(t + 1) * kstep;
            const char* a2 = last ? nA : cA + (size_t)(t + 2) * kstep; const char* b2 = last ? nB : cB + (size_t)(t + 2) * kstep;
            const char* a3 = a2 + kstep; const char* b3 = b2 + kstep;
            PG8_LDB(B0, 0, 0); PG8_LDB(B1, 0, 1); PG8_SCHED; PG8_LDA(At, 0, 0); PG8_STAGE(PG8_SA(1, 1), a1 + hstepA, voffA);
            PG8_WAIT_V(8); PG8_WAIT_L(0); PG8_BAR; PG8_MMA(0, 0, At, B0); PG8_MMA(0, 1, At, B1); PG8_BAR; PG8_SCHED;
            PG8_LDA(At, 0, 1); PG8_STAGE(PG8_SB(0, 0), b2, voffB); PG8_STAGE(PG8_SB(0, 1), b2 + hstepB, voffB); PG8_STAGE(PG8_SA(0, 0), a2, voffA);
            PG8_WAIT_V(8); PG8_WAIT_L(0); PG8_BAR; PG8_MMA(1, 0, At, B0); PG8_MMA(1, 1, At, B1); PG8_BAR; PG8_SCHED;
            PG8_LDB(B0, 1, 0); PG8_LDB(B1, 1, 1); PG8_SCHED; PG8_LDA(At, 1, 0); PG8_STAGE(PG8_SA(0, 1), a2 + hstepA, voffA);
            PG8_WAIT_V(8); PG8_WAIT_L(0); PG8_BAR; PG8_MMA(0, 0, At, B0); PG8_MMA(0, 1, At, B1); PG8_BAR; PG8_SCHED;
            PG8_LDA(At, 1, 1); PG8_STAGE(PG8_SB(1, 0), b3, voffB); PG8_STAGE(PG8_SB(1, 1), b3 + hstepB, voffB); PG8_STAGE(PG8_SA(1, 0), a3, voffA);
            PG8_WAIT_V(8); PG8_WAIT_L(0); PG8_BAR; PG8_MMA(1, 0, At, B0); PG8_MMA(1, 1, At, B1); PG8_BAR; PG8_SCHED;
        }
        if (wr == 0) PG8_BAR;
        E(acc, cur, wr, wc, fr, fq);
        if (!has_next) break;
#pragma unroll
        for (int a = 0; a < 2; ++a)
#pragma unroll
            for (int b = 0; b < 2; ++b)
#pragma unroll
                for (int m = 0; m < 4; ++m)
#pragma unroll
                    for (int n = 0; n < 2; ++n) acc[a][b][m][n] = (f32x4){0.f, 0.f, 0.f, 0.f};
        cur = nxt; cA = nA; cB = nB; ++ui;
        if (wr == 1) PG8_BAR;
    }
    PG8_WAIT_V(0);
    PG8_BAR;
#undef PG8_SA
#undef PG8_SB
#undef PG8_STAGE
#undef PG8_LDA
#undef PG8_LDB
#undef PG8_MMA
#undef PG8_WAIT_V
#undef PG8_WAIT_L
#undef PG8_BAR
#undef PG8_SCHED
}
}

struct Frame { LAS unsigned char* lds; int tid, lane, wave, gw, NGW; unsigned char* ws; bf16* PA; };

__device__ __forceinline__ int srcA(int n) {
    if (n < 384) return 384 + n;
    if (n < 768) return 768 + (n - 384);
    if (n < 1024) return 1792 + (n - 768);
    if (n < 1408) return n - 1024;
    if (n < 1792) return 1152 + (n - 1408);
    if (n < 2048) return 1536 + (n - 1792);
    if (n < 2176) return 2048 + (n - 2048);
    if (n < 2432) return 2188 + (n - 2176);
    if (n < 3584) return 2444 + (n - 2432);
    if (n < 3968) return 3602 + (n - 3584);
    if (n < 3980) return 2176 + (n - 3968);
    if (n < 3986) return 3596 + (n - 3980);
    return -1;
}
__device__ __forceinline__ void tr_item(const float* W, int ldw, bf16* WT, int Kd, int k0, int n0, int mode, int off, LAS float* scr, int lane) {
    const int nn = n0 + (lane & 31);
    const int sc = mode == 0 ? srcA(nn) : nn + off;
#pragma unroll 16
    for (int i = 0; i < 32; ++i) { const int kk = 2 * i + (lane >> 5); scr[kk * 33 + (lane & 31)] = sc >= 0 ? W[(size_t)(k0 + kk) * ldw + sc] : 0.f; }
    LDS_FENCE();
    const int c = lane & 7;
#pragma unroll
    for (int j = 0; j < 4; ++j) { const int n = (lane >> 3) + 8 * j; const LAS float* s = scr + (8 * c) * 33 + n;
        u32x4 o; o.x = cvt_pk_bf16(s[0 * 33], s[1 * 33]); o.y = cvt_pk_bf16(s[2 * 33], s[3 * 33]); o.z = cvt_pk_bf16(s[4 * 33], s[5 * 33]); o.w = cvt_pk_bf16(s[6 * 33], s[7 * 33]);
        if (mode == 2) { const int nn2 = n0 + n, kk2 = k0 + 8 * c;
            *(u32x4*)(WT + ((size_t)((nn2 >> 5) * (Kd >> 4) + (kk2 >> 4)) * 64 + ((kk2 >> 3) & 1) * 32 + (nn2 & 31)) * 8) = o; }
        else *(u32x4*)(WT + (size_t)(n0 + n) * Kd + k0 + 8 * c) = o; }
    LDS_FENCE();
}
__device__ __forceinline__ void rms_rows(const Params& P, const Frame& F, int layer, const float* xin, bf16* H) {
    const float* g = P.norm_g + layer * DM;
    for (int m0 = F.gw; m0 < SEQ; m0 += 2 * F.NGW) {
        const int m1 = m0 + F.NGW < SEQ ? m0 + F.NGW : m0;
        const f32x4* xr0 = (const f32x4*)(xin + (size_t)m0 * DM) + F.lane; const f32x4* xr1 = (const f32x4*)(xin + (size_t)m1 * DM) + F.lane;
        f32x4 v0[4], v1[4]; float s0 = 0.f, s1 = 0.f;
#pragma unroll
        for (int j = 0; j < 4; ++j) { v0[j] = xr0[64 * j]; v1[j] = xr1[64 * j]; }
#pragma unroll
        for (int j = 0; j < 4; ++j) { s0 += (v0[j].x * v0[j].x + v0[j].y * v0[j].y) + (v0[j].z * v0[j].z + v0[j].w * v0[j].w); s1 += (v1[j].x * v1[j].x + v1[j].y * v1[j].y) + (v1[j].z * v1[j].z + v1[j].w * v1[j].w); }
        const float r0 = rsqrtf(wave_sum(s0, F.lane) * (1.f / DM) + RMS_EPS), r1 = rsqrtf(wave_sum(s1, F.lane) * (1.f / DM) + RMS_EPS);
        unsigned long long* o0 = (unsigned long long*)(H + (size_t)m0 * DM) + F.lane; unsigned long long* o1 = (unsigned long long*)(H + (size_t)m1 * DM) + F.lane;
#pragma unroll
        for (int j = 0; j < 4; ++j) { const f32x4 gg = ((const f32x4*)g)[F.lane + 64 * j];
            o0[64 * j] = (unsigned long long)cvt_pk_bf16(v0[j].x * r0 * gg.x, v0[j].y * r0 * gg.y) | ((unsigned long long)cvt_pk_bf16(v0[j].z * r0 * gg.z, v0[j].w * r0 * gg.w) << 32);
            o1[64 * j] = (unsigned long long)cvt_pk_bf16(v1[j].x * r1 * gg.x, v1[j].y * r1 * gg.y) | ((unsigned long long)cvt_pk_bf16(v1[j].z * r1 * gg.z, v1[j].w * r1 * gg.w) << 32); }
    }
}
__device__ __forceinline__ void phase0(const Params& P, const Frame& F, int layer, const float* xin) {
    LAS float* scr = (LAS float*)(F.lds + F.wave * 16384);
    unsigned char* ws = F.ws;
    if (F.gw == 0) { unsigned* ctl = (unsigned*)(ws + WS_CTL);
        if (F.lane == 0) { ctl[16 * layer] = 0u; ctl[16 * layer + 8] = 0u; }
        for (int i = F.lane; i < 384; i += 64) ctl[1024 + 16384 * layer + i * 32] = 0u; }
    constexpr int I_A = 16 * 128, I_G = 16 * 96, I_UM = 6 * 32, I_UN = 4 * 32, I_UF = 6 * 32, I_O = 16 * 32, I_1 = 32 * 8, I_2 = 4 * 2;
    constexpr int NIT = I_A + I_G + I_UM + I_UN + I_UF + I_O + 2 * I_1 + 2 * I_2;
    const float* w_in = P.w_in + (size_t)layer * DM * INC;
    for (int it = F.gw; it < NIT; it += F.NGW) {
        int r = it;
        if (r < I_A) { tr_item(w_in, INC, (bf16*)(ws + WS_WA), 1024, 64 * (r / 128), 32 * (r % 128), 0, 0, scr, F.lane); continue; } r -= I_A;
        if (r < I_G) { tr_item(w_in, INC, (bf16*)(ws + WS_WG), 1024, 64 * (r / 96), 32 * (r % 96), 1, 3986, scr, F.lane); continue; } r -= I_G;
        if (r < I_UM) { tr_item(P.w_up_moba + (size_t)layer * 384 * 1024, 1024, (bf16*)(ws + WS_WUPM), 384, 64 * (r / 32), 32 * (r % 32), 1, 0, scr, F.lane); continue; } r -= I_UM;
        if (r < I_UN) { tr_item(P.w_up_nsa + (size_t)layer * 256 * 1024, 1024, (bf16*)(ws + WS_WUPN), 256, 64 * (r / 32), 32 * (r % 32), 1, 0, scr, F.lane); continue; } r -= I_UN;
        if (r < I_UF) { tr_item(P.w_up_fox + (size_t)layer * 384 * 1024, 1024, (bf16*)(ws + WS_WUPF), 384, 64 * (r / 32), 32 * (r % 32), 1, 0, scr, F.lane); continue; } r -= I_UF;
        if (r < I_O) { tr_item(P.w_out + (size_t)layer * 1024 * 1024, 1024, (bf16*)(ws + WS_WO), 1024, 64 * (r / 32), 32 * (r % 32), 1, 0, scr, F.lane); continue; } r -= I_O;
        if (r < 2 * I_1) { const int kv = r / I_1; r %= I_1;
            tr_item(P.cmp_w1 + (size_t)(layer * 2 + kv) * 2048 * 256, 256, (bf16*)(ws + WS_W1T) + (size_t)kv * 256 * 2048, 2048, 64 * (r / 8), 32 * (r % 8), 2, 0, scr, F.lane); continue; } r -= 2 * I_1;
        { const int kv = r / I_2; r %= I_2;
            tr_item(P.cmp_w2 + (size_t)(layer * 2 + kv) * 256 * 64, 64, (bf16*)(ws + WS_W2T) + (size_t)kv * 64 * 256, 256, 64 * (r / 2), 32 * (r % 2), 1, 0, scr, F.lane); }
    }
    rms_rows(P, F, layer, xin, (bf16*)(ws + WS_H));
}

__device__ __forceinline__ void rope_sincos(float pos, int i, float& cs, float& sn) {
    constexpr float INV[8] = {1.0f, 0.1939227432012558f, 0.03760603070259094f, 0.007292664609849453f, 0.0014142135623842478f, 0.00027424818836152554f, 5.3182957344688475e-05f, 1.0313385246263351e-05f};
    const float ang = pos * INV[i];
    double rev = (double)ang * 0.15915494309189535; rev -= floor(rev);
    const float fr = (float)rev;
    sn = __builtin_amdgcn_sinf(fr); cs = __builtin_amdgcn_cosf(fr);
}
__device__ __forceinline__ void norm_load(const bf16* rowp, const float* g, bool rope, int t, float (&v)[64]) {
    float ss = 0.f;
#pragma unroll
    for (int j = 0; j < 8; ++j) { const u32x4 w = ((const u32x4*)rowp)[j];
        v[8 * j + 0] = bflo(w.x); v[8 * j + 1] = bfhi(w.x); v[8 * j + 2] = bflo(w.y); v[8 * j + 3] = bfhi(w.y);
        v[8 * j + 4] = bflo(w.z); v[8 * j + 5] = bfhi(w.z); v[8 * j + 6] = bflo(w.w); v[8 * j + 7] = bfhi(w.w); }
#pragma unroll
    for (int d = 0; d < 64; ++d) ss += v[d] * v[d];
    const float rs = rsqrtf(ss * (1.f / 64.f) + RMS_EPS);
#pragma unroll
    for (int d = 0; d < 64; ++d) v[d] = v[d] * rs * g[d];
    if (rope) {
#pragma unroll
        for (int i = 0; i < 8; ++i) { float cs, sn; rope_sincos((float)t, i, cs, sn); const float a = v[i], b = v[i + 8]; v[i] = a * cs - b * sn; v[i + 8] = b * cs + a * sn; }
    }
}
__device__ __forceinline__ void norm_store(const Frame& F, const float (&v)[64], float osc, bf16* rowp, int kstream, int t) {
    bf16* dst = kstream < 0 ? rowp : (bf16*)(F.ws + WS_KF) + (size_t)kstream * STREAM_ELEMS + ((size_t)(t >> 5) * 256 + (t & 31)) * 8;
#pragma unroll
    for (int j = 0; j < 8; ++j) {
        u32x4 w; w.x = cvt_pk_bf16(v[8 * j] * osc, v[8 * j + 1] * osc); w.y = cvt_pk_bf16(v[8 * j + 2] * osc, v[8 * j + 3] * osc);
        w.z = cvt_pk_bf16(v[8 * j + 4] * osc, v[8 * j + 5] * osc); w.w = cvt_pk_bf16(v[8 * j + 6] * osc, v[8 * j + 7] * osc);
        bf16* p = kstream < 0 ? dst + 8 * j : dst + ((j >> 1) * 64 + (j & 1) * 32) * 8;
        *(u32x4*)p = w;
    }
}
__device__ __forceinline__ void p2_normrow(const Params& P, const Frame& F, int layer, int idx) {
    const int t = idx / 24, slot = idx - t * 24;
    int col, kstream = -1; const float* g; bool rope = true; float osc = 1.f;
    if (slot < 6) { col = C_MQ + slot * 64; g = P.moba_qk_g + layer * 128; osc = C2; }
    else if (slot < 10) { col = C_NQ + (slot - 6) * 64; g = P.nsa_q_g + layer * 64; osc = C2; }
    else if (slot == 10) { col = C_KSL; g = P.nsa_k_g + layer * 192 + 64; kstream = 6; }
    else if (slot == 11) { col = C_KW; g = P.nsa_k_g + layer * 192 + 128; kstream = 7; }
    else if (slot < 18) { col = C_FQ + (slot - 12) * 64; g = P.fox_qk_g + layer * 128; rope = false; osc = C2; }
    else { col = C_FK + (slot - 18) * 64; g = P.fox_qk_g + layer * 128 + 64; rope = false; kstream = 8 + (slot - 18); }
    bf16* rowp = F.PA + (size_t)t * PAC + col;
    float v[64];
    norm_load(rowp, g, rope, t, v);
    norm_store(F, v, osc, rowp, kstream, t);
}
__device__ __forceinline__ void p2_mk_unit(const Params& P, const Frame& F, int layer, int u) {
    const int blk = u / 3, pr = u - blk * 3, head = pr * 2 + (F.tid >> 8), t = blk * 256 + (F.tid & 255);
    bf16* rowp = F.PA + (size_t)t * PAC + C_MK + head * 64;
    float v[64];
    norm_load(rowp, P.moba_qk_g + layer * 128 + 64, true, t, v);
    norm_store(F, v, 1.f, rowp, head, t);
    float mine = 0.f;
#pragma unroll
    for (int d = 0; d < 64; ++d) { const float s = wave_sum(v[d], F.lane); mine = (F.lane == d) ? s : mine; }
    LAS float* part = (LAS float*)F.lds;
    part[F.wave * 64 + F.lane] = mine;
    __syncthreads();
    if (F.tid < 128) { const int hh = F.tid >> 6, d = F.tid & 63;
        const float s = (part[(hh * 4 + 0) * 64 + d] + part[(hh * 4 + 1) * 64 + d]) + (part[(hh * 4 + 2) * 64 + d] + part[(hh * 4 + 3) * 64 + d]);
        ((float*)(F.ws + WS_KMEAN))[((pr * 2 + hh) * 64 + blk) * 64 + d] = s * (1.f / 256.f); }
    __syncthreads();
}
__device__ __forceinline__ void p2_vfrag8(const Frame& F, int g) {
    const int st = g >> 14, r = g & 16383, T = r >> 5, q5 = r & 31, dt = q5 >> 4, s = (q5 >> 3) & 1, hg = (q5 >> 2) & 1, c8 = q5 & 3;
    const int col0 = st < 6 ? C_MV + st * 64 : (st == 6 ? C_VSL : (st == 7 ? C_VW : C_FV + (st - 8) * 64));
    const bf16* src = F.PA + (size_t)(32 * T + 16 * s + 4 * hg) * PAC + col0 + dt * 32 + c8 * 8;
    u32x4 R[8];
#pragma unroll
    for (int j = 0; j < 8; ++j) R[j] = *(const u32x4*)(src + (size_t)((j & 3) + 8 * (j >> 2)) * PAC);
    bf16* dst = (bf16*)(F.ws + WS_VF) + (size_t)st * STREAM_ELEMS + ((size_t)(((T * 2 + dt) * 2 + s) * 64 + hg * 32 + c8 * 8)) * 8;
#pragma unroll
    for (int dd = 0; dd < 8; ++dd) {
        const unsigned sel = (dd & 1) ? 0x07060302u : 0x05040100u;
        u32x4 w;
        w.x = __builtin_amdgcn_perm(R[1][dd >> 1], R[0][dd >> 1], sel); w.y = __builtin_amdgcn_perm(R[3][dd >> 1], R[2][dd >> 1], sel);
        w.z = __builtin_amdgcn_perm(R[5][dd >> 1], R[4][dd >> 1], sel); w.w = __builtin_amdgcn_perm(R[7][dd >> 1], R[6][dd >> 1], sel);
        *(u32x4*)(dst + dd * 8) = w;
    }
}
__device__ __forceinline__ void p2_compress(const Params& P, const Frame& F, int layer, int item) {
    const int kv = item >> 5, T = item & 31, lane = F.lane, c = lane & 31, hg = lane >> 5, w = F.wave;
    const int col0 = C_KC + kv * 64;
    const bf16x8* W1F = (const bf16x8*)((const bf16*)(F.ws + WS_W1T) + (size_t)kv * 256 * 2048) + (size_t)w * 128 * 64 + lane;
    const bf16* W2T = (const bf16*)(F.ws + WS_W2T) + (size_t)kv * 64 * 256;
    LAS float* pel = (LAS float*)(F.lds + 16384);
    { const float* pe = P.cmp_pe + (size_t)(layer * 2 + kv) * 2048; for (int i = F.tid; i < 512; i += 512) ((LAS f32x4*)pel)[i] = ((const f32x4*)pe)[i]; }
    __syncthreads();
    f32x16 acc;
#pragma unroll
    for (int r = 0; r < 16; ++r) acc[r] = 0.f;
    const int blk = 32 * T + c;
    const int rowb = 16 * blk;
#pragma unroll 16
    for (int ks = 0; ks < 128; ++ks) {
        const int pos = ks >> 2, dsub = (ks & 3) * 16;
        int row = rowb + pos; row = row > SEQ - 1 ? SEQ - 1 : row;
        const u32x4 bw = *(const u32x4*)(F.PA + (size_t)row * PAC + col0 + dsub + hg * 8);
        const f32x4 p0 = *(const LAS f32x4*)(pel + ks * 16 + hg * 8), p1 = *(const LAS f32x4*)(pel + ks * 16 + hg * 8 + 4);
        u32x4 bs; bs.x = cvt_pk_bf16(bflo(bw.x) + p0[0], bfhi(bw.x) + p0[1]); bs.y = cvt_pk_bf16(bflo(bw.y) + p0[2], bfhi(bw.y) + p0[3]);
        bs.z = cvt_pk_bf16(bflo(bw.z) + p1[0], bfhi(bw.z) + p1[1]); bs.w = cvt_pk_bf16(bflo(bw.w) + p1[2], bfhi(bw.w) + p1[3]);
        const bf16x8 a = W1F[ks * 64];
        acc = MFMA32(a, __builtin_bit_cast(bf16x8, bs), acc);
    }
    LAS u32x4* hid = (LAS u32x4*)F.lds;
#pragma unroll
    for (int s = 0; s < 2; ++s) {
        float hv[8];
#pragma unroll
        for (int r = 0; r < 8; ++r) hv[r] = siluf_(acc[8 * s + r]);
        u32x4 pw4; pw4.x = cvt_pk_bf16(hv[0], hv[1]); pw4.y = cvt_pk_bf16(hv[2], hv[3]); pw4.z = cvt_pk_bf16(hv[4], hv[5]); pw4.w = cvt_pk_bf16(hv[6], hv[7]);
        hid[(w * 2 + s) * 64 + lane] = pw4;
    }
    __syncthreads();
    if (w == 0) {
        f32x16 o[2];
#pragma unroll
        for (int r = 0; r < 16; ++r) { o[0][r] = 0.f; o[1][r] = 0.f; }
#pragma unroll
        for (int nt = 0; nt < 8; ++nt)
#pragma unroll
            for (int s = 0; s < 2; ++s) {
                const bf16x8 pb = __builtin_bit_cast(bf16x8, hid[(nt * 2 + s) * 64 + lane]);
#pragma unroll
                for (int dt = 0; dt < 2; ++dt) {
                    const bf16* wp = W2T + (size_t)(dt * 32 + c) * 256 + nt * 32 + 16 * s + 4 * hg;
                    const u32x2 lo = *(const u32x2*)wp, hi = *(const u32x2*)(wp + 8);
                    u32x4 aw; aw.x = lo.x; aw.y = lo.y; aw.z = hi.x; aw.w = hi.y;
                    o[dt] = MFMA32(__builtin_bit_cast(bf16x8, aw), pb, o[dt]);
                }
            }
        if (kv == 0) {
            const float* g = P.nsa_k_g + layer * 192;
            float ss = 0.f;
#pragma unroll
            for (int dt = 0; dt < 2; ++dt)
#pragma unroll
                for (int r = 0; r < 16; ++r) ss += o[dt][r] * o[dt][r];
            ss += shx(ss, 32, lane);
            const float rs = rsqrtf(ss * (1.f / 64.f) + RMS_EPS);
#pragma unroll
            for (int dt = 0; dt < 2; ++dt)
#pragma unroll
                for (int r = 0; r < 16; ++r) o[dt][r] = o[dt][r] * rs * g[dt * 32 + crow(r, hg)];
            const float pos = (float)(16 * blk + 31);
#pragma unroll
            for (int r = 0; r < 4; ++r) {
                float c0, s0, c1, s1; rope_sincos(pos, r, c0, s0); rope_sincos(pos, r + 4, c1, s1);
                const float cs = hg ? c1 : c0, sn = hg ? s1 : s0;
                const float a = o[0][r], b = o[0][r + 4]; o[0][r] = a * cs - b * sn; o[0][r + 4] = b * cs + a * sn;
            }
            bf16* KC = (bf16*)(F.ws + WS_KCMP);
#pragma unroll
            for (int dt = 0; dt < 2; ++dt)
#pragma unroll
                for (int gq = 0; gq < 4; ++gq) {
                    const int ks = dt * 2 + (gq >> 1), hgp = gq & 1;
                    u32x2 wv; wv.x = cvt_pk_bf16(o[dt][4 * gq], o[dt][4 * gq + 1]); wv.y = cvt_pk_bf16(o[dt][4 * gq + 2], o[dt][4 * gq + 3]);
                    *(u32x2*)(KC + ((size_t)(T * 4 + ks) * 64 + hgp * 32 + c) * 8 + 4 * hg) = wv;
                }
        } else {
            bf16* VC = (bf16*)(F.ws + WS_VCMP);
            const int s = c >> 4, hgp = (c >> 2) & 1, j = ((c >> 3) & 1) * 4 + (c & 3);
#pragma unroll
            for (int dt = 0; dt < 2; ++dt)
#pragma unroll
                for (int r = 0; r < 16; ++r)
                    VC[((size_t)((T * 2 + dt) * 2 + s) * 64 + hgp * 32 + crow(r, hg)) * 8 + j] = f2bf(o[dt][r]);
        }
    }
    __syncthreads();
}
#ifdef PROBE_P2PART
#define P2T(i) do { if (PROBE_P2PART == (i)) { const unsigned long long _t = __builtin_amdgcn_s_memrealtime(); if ((F.gw >> 3) == PROBE_P2BLK && F.tid == 0) p2acc += (long long)(_t); } } while (0)
#define P2T0(i) do { if (PROBE_P2PART == (i)) { const unsigned long long _t = __builtin_amdgcn_s_memrealtime(); if ((F.gw >> 3) == PROBE_P2BLK && F.tid == 0) p2acc -= (long long)(_t); } } while (0)
#else
#define P2T(i) do {} while (0)
#define P2T0(i) do {} while (0)
#endif
__device__ __forceinline__ void phase2(const Params& P, const Frame& F, int layer, long long& p2acc) {
    const int G = F.NGW >> 3, bxv = F.gw >> 3;
    const bool split = G >= 128;
    if (bxv < 64) { p2_compress(P, F, layer, bxv); if (split) return; }
    if (!split && G < 64) { for (int u = bxv + G; u < 64; u += G) p2_compress(P, F, layer, u); }
    const int vgw = split ? F.gw - 512 : F.gw, VN = split ? F.NGW - 512 : F.NGW, vbx = split ? bxv - 64 : bxv, VG = split ? G - 64 : G;
    for (int it = vgw; it < 6 * 256; it += VN) {
        const int h = it >> 8, ch = it & 255, t = ch * 64 + F.lane;
        const float z = bf2f(F.PA[(size_t)t * PAC + C_FF + h]) + P.b_f[layer * 6 + h];
        float v = (fminf(z, 0.f) - log1pf(__expf(-fabsf(z)))) * LOG2E;
#pragma unroll
        for (int o = 1; o < 64; o <<= 1) { const float y = shfrom(v, (F.lane - o) & 63); if (F.lane >= o) v += y; }
        ((float*)(F.ws + WS_CS))[h * SEQ + t] = v;
        if (F.lane == 63) ((float*)(F.ws + WS_CSTOT))[h * 256 + ch] = v;
    }
    for (int u = vbx; u < 192; u += VG) p2_mk_unit(P, F, layer, u);
    for (int it = vgw; it < SEQ * 24 / 64; it += VN) p2_normrow(P, F, layer, it * 64 + F.lane);
    for (int it = vgw; it < 14 * 16384 / 64; it += VN) p2_vfrag8(F, it * 64 + F.lane);
    (void)p2acc;
}

__device__ __forceinline__ int list_off(int j) { return 256 * (63 * j - (j * (j - 1)) / 2); }
constexpr int LIST_HEAD = 256 * 2016;
__device__ __forceinline__ void phase3(const Params& P, const Frame& F, int layer) {
    for (int it = F.gw; it < 6 * 256; it += F.NGW) {
        const int h = it >> 8, ch = it & 255;
        const float* tot = (const float*)(F.ws + WS_CSTOT) + h * 256;
        float s = 0.f;
        for (int cc = F.lane; cc < ch; cc += 64) s += tot[cc];
        s = wave_sum(s, F.lane);
        float* cs = (float*)(F.ws + WS_CS) + h * SEQ + ch * 64 + F.lane;
        *cs = *cs + s;
    }
    unsigned* cnt = (unsigned*)(F.ws + WS_CTL) + 1024 + 16384 * layer;
    unsigned short* LIST = (unsigned short*)(F.ws + WS_LIST);
    LAS float* kml = (LAS float*)F.lds;
    for (int u = (F.gw >> 3); u < 6 * 32; u += (F.NGW >> 3)) {
        const int h = u >> 5, t = (u & 31) * 512 + F.tid, cur = t >> 8, nb = (((u & 31) * 512 + 511) >> 8);
        const float* km = (const float*)(F.ws + WS_KMEAN) + (size_t)h * 64 * 64;
        LAS unsigned* lcnt = (LAS unsigned*)(F.lds + 32768); LAS unsigned* lbase = lcnt + 64;
        for (int i = F.tid; i < nb * 16; i += 512) ((LAS f32x4*)kml)[i] = ((const f32x4*)km)[i];
        if (F.tid < 64) lcnt[F.tid] = 0u;
        __syncthreads();
        int i1 = -1, i2 = -1, i3 = -1; unsigned p1 = 0, p2 = 0, p3 = 0;
        if (cur > 0) {
            const bf16* qrow = F.PA + (size_t)t * PAC + C_MQ + h * 64;
            float qv[64];
#pragma unroll
            for (int j = 0; j < 8; ++j) { const u32x4 w = ((const u32x4*)qrow)[j];
                qv[8 * j + 0] = bflo(w.x); qv[8 * j + 1] = bfhi(w.x); qv[8 * j + 2] = bflo(w.y); qv[8 * j + 3] = bfhi(w.y);
                qv[8 * j + 4] = bflo(w.z); qv[8 * j + 5] = bfhi(w.z); qv[8 * j + 6] = bflo(w.w); qv[8 * j + 7] = bfhi(w.w); }
            float v1 = -3e38f, v2 = -3e38f, v3 = -3e38f;
            for (int j = 0; j < cur; ++j) {
                float g0 = 0.f, g1 = 0.f;
#pragma unroll
                for (int d4 = 0; d4 < 16; ++d4) { const f32x4 k4 = ((const LAS f32x4*)kml)[j * 16 + d4];
                    g0 += qv[4 * d4] * k4[0]; g1 += qv[4 * d4 + 1] * k4[1]; g0 += qv[4 * d4 + 2] * k4[2]; g1 += qv[4 * d4 + 3] * k4[3]; }
                const float g = g0 + g1;
                if (g > v3) { if (g > v2) { v3 = v2; i3 = i2; if (g > v1) { v2 = v1; i2 = i1; v1 = g; i1 = j; } else { v2 = g; i2 = j; } } else { v3 = g; i3 = j; } }
            }
            if (i1 >= 0) p1 = __hip_atomic_fetch_add(lcnt + i1, 1u, __ATOMIC_RELAXED, __HIP_MEMORY_SCOPE_WORKGROUP);
            if (i2 >= 0) p2 = __hip_atomic_fetch_add(lcnt + i2, 1u, __ATOMIC_RELAXED, __HIP_MEMORY_SCOPE_WORKGROUP);
            if (i3 >= 0) p3 = __hip_atomic_fetch_add(lcnt + i3, 1u, __ATOMIC_RELAXED, __HIP_MEMORY_SCOPE_WORKGROUP);
        }
        __syncthreads();
        if (F.tid < 64) { const unsigned c = lcnt[F.tid]; lbase[F.tid] = c ? __hip_atomic_fetch_add(cnt + (h * 64 + F.tid) * 32, c, __ATOMIC_RELAXED, __HIP_MEMORY_SCOPE_AGENT) : 0u; }
        __syncthreads();
        if (i1 >= 0) LIST[(size_t)h * LIST_HEAD + list_off(i1) + lbase[i1] + p1] = (unsigned short)((t << 2) | 0);
        if (i2 >= 0) LIST[(size_t)h * LIST_HEAD + list_off(i2) + lbase[i2] + p2] = (unsigned short)((t << 2) | 1);
        if (i3 >= 0) LIST[(size_t)h * LIST_HEAD + list_off(i3) + lbase[i3] + p3] = (unsigned short)((t << 2) | 2);
        __syncthreads();
    }
}

constexpr int RING_OFF = 65536;
__device__ __forceinline__ f32x16 qk_lds(LAS unsigned char* buf, const bf16x8 (&qf)[4], int lane, float init = 0.f) {
    const LAS bf16x8* p = (const LAS bf16x8*)buf + lane;
    f32x16 s;
#pragma unroll
    for (int r = 0; r < 16; ++r) s[r] = init;
    const bf16x8 k0 = p[0], k1 = p[64], k2 = p[128], k3 = p[192];
    __builtin_amdgcn_s_setprio(1);
    s = MFMA32(k0, qf[0], s); s = MFMA32(k1, qf[1], s); s = MFMA32(k2, qf[2], s); s = MFMA32(k3, qf[3], s);
    __builtin_amdgcn_s_setprio(0);
    return s;
}
__device__ __forceinline__ void pv_lds(LAS unsigned char* buf, const float (&e)[16], f32x16 (&o)[2], int lane) {
    const LAS bf16x8* p = (const LAS bf16x8*)(buf + 4096) + lane;
    u32x4 w0, w1;
    w0.x = cvt_pk_bf16(e[0], e[1]); w0.y = cvt_pk_bf16(e[2], e[3]); w0.z = cvt_pk_bf16(e[4], e[5]); w0.w = cvt_pk_bf16(e[6], e[7]);
    w1.x = cvt_pk_bf16(e[8], e[9]); w1.y = cvt_pk_bf16(e[10], e[11]); w1.z = cvt_pk_bf16(e[12], e[13]); w1.w = cvt_pk_bf16(e[14], e[15]);
    const bf16x8 pb0 = __builtin_bit_cast(bf16x8, w0), pb1 = __builtin_bit_cast(bf16x8, w1);
    const bf16x8 v0 = p[0], v1 = p[64], v2 = p[128], v3 = p[192];
    __builtin_amdgcn_s_setprio(1);
    o[0] = MFMA32(v0, pb0, o[0]); o[1] = MFMA32(v2, pb0, o[1]); o[0] = MFMA32(v1, pb1, o[0]); o[1] = MFMA32(v3, pb1, o[1]);
    __builtin_amdgcn_s_setprio(0);
}
__device__ __forceinline__ float gain_bound(const float* gq, const float* gk, int lane) {
    const float a = wave_max(fabsf(gq[lane]), lane), b = wave_max(fabsf(gk[lane]), lane);
    return (8.f * a * b * 1.02f + 0.05f) * LOG2E;
}
__device__ __forceinline__ void write_gated(const Frame& F, const f32x16 (&o)[2], float scale, int t, int ocol, int zcol, int hg) {
    bf16* rowp = F.PA + (size_t)t * PAC;
#pragma unroll
    for (int dt = 0; dt < 2; ++dt)
#pragma unroll
        for (int g = 0; g < 4; ++g) {
            const int d0 = dt * 32 + 8 * g + 4 * hg;
            const u32x2 z = *(const u32x2*)(rowp + zcol + d0);
            u32x2 w;
            w.x = cvt_pk_bf16(o[dt][4 * g] * scale * siluf_(bflo(z.x)), o[dt][4 * g + 1] * scale * siluf_(bfhi(z.x)));
            w.y = cvt_pk_bf16(o[dt][4 * g + 2] * scale * siluf_(bflo(z.y)), o[dt][4 * g + 3] * scale * siluf_(bfhi(z.y)));
            *(u32x2*)(rowp + ocol + d0) = w;
        }
}
#define ZERO_O(o) do { _Pragma("unroll") for (int _r = 0; _r < 16; ++_r) { o[0][_r] = 0.f; o[1][_r] = 0.f; } } while (0)
__device__ __forceinline__ void glds16(const void* gsrc, unsigned lds_dst) { unsigned keep;
    asm volatile("s_mov_b32 %0, m0\n\ts_mov_b32 m0, %2\n\ts_nop 0\n\tglobal_load_lds_dwordx4 %1, off\n\ts_mov_b32 m0, %0" : "=&s"(keep) : "v"(gsrc), "s"(lds_dst) : "memory"); }
__device__ __forceinline__ unsigned lds_addr(LAS unsigned char* p) { return (unsigned)(size_t)p; }
#define SBAR() do { asm volatile("" ::: "memory"); __builtin_amdgcn_s_barrier(); asm volatile("" ::: "memory"); } while (0)
#define VMW(n) asm volatile("s_waitcnt vmcnt(" #n ")" ::: "memory")
#define DMA2(p) do { _Pragma("unroll") for (int _q = 0; _q < 2; ++_q) \
    glds16(_src + (ptrdiff_t)(2 * (p) + _q) * _st, (unsigned)__builtin_amdgcn_readfirstlane(_ringa + (unsigned)((((p) & 3) * 2 + _q) * 8192) + _wo)); } while (0)
#define STREAM_BEGIN(KFp, VFp, TFIRST, STEP, NTILES) { \
    const int _nt = (NTILES), _n = (_nt + 1) >> 1; \
    const char* _src = (const char*)((F.wave < 4) ? (KFp) : (VFp)) + (ptrdiff_t)(TFIRST) * 4096 + (F.wave & 3) * 1024 + F.lane * 16; \
    const ptrdiff_t _st = (ptrdiff_t)(STEP) * 4096; \
    LAS unsigned char* _ring = F.lds + RING_OFF; const unsigned _wo = (unsigned)F.wave * 1024u; const unsigned _ringa = lds_addr(_ring); \
    asm volatile("s_waitcnt vmcnt(0) lgkmcnt(0)" ::: "memory"); SBAR(); \
    if (_n > 0) DMA2(0); if (_n > 1) DMA2(1); if (_n > 2) DMA2(2); \
    for (int _i = 0; _i < _n; ++_i) { \
        if (_i + 2 < _n) VMW(4); else if (_i + 1 < _n) VMW(2); else VMW(0); \
        asm volatile("s_waitcnt lgkmcnt(0)" ::: "memory"); SBAR(); \
        if (_i + 3 < _n) DMA2(_i + 3); \
        _Pragma("unroll") for (int _s = 0; _s < 2; ++_s) { \
            const int T = (TFIRST) + (2 * _i + _s) * (STEP); LAS unsigned char* _buf = _ring + ((_i & 3) * 2 + _s) * 8192; \
            if (2 * _i + _s < _nt) {
#define STREAM_END } } } asm volatile("s_waitcnt vmcnt(0) lgkmcnt(0)" ::: "memory"); SBAR(); }
#define STREAM2_BEGIN(KFp, VFp, TFIRST, STEP, NTILES) { \
    const int _nt = (NTILES), _n = (_nt + 1) >> 1; \
    const char* _src = (const char*)((F.wave < 4) ? (KFp) : (VFp)) + (ptrdiff_t)(TFIRST) * 4096 + (F.wave & 3) * 1024 + F.lane * 16; \
    const ptrdiff_t _st = (ptrdiff_t)(STEP) * 4096; \
    LAS unsigned char* _ring = F.lds + RING_OFF; const unsigned _wo = (unsigned)F.wave * 1024u; const unsigned _ringa = lds_addr(_ring); \
    asm volatile("s_waitcnt vmcnt(0) lgkmcnt(0)" ::: "memory"); SBAR(); \
    if (_n > 0) DMA2(0); if (_n > 1) DMA2(1); if (_n > 2) DMA2(2); \
    for (int _i = 0; _i < _n; ++_i) { \
        if (_i + 2 < _n) VMW(4); else if (_i + 1 < _n) VMW(2); else VMW(0); \
        asm volatile("s_waitcnt lgkmcnt(0)" ::: "memory"); SBAR(); \
        if (_i + 3 < _n) DMA2(_i + 3); \
        const int T0 = (TFIRST) + (2 * _i) * (STEP), T1 = T0 + (STEP); const bool _v0 = true, _v1 = (2 * _i + 1 < _nt); \
        LAS unsigned char* _b0 = _ring + ((_i & 3) * 2) * 8192; LAS unsigned char* _b1 = _b0 + 8192;
#define STREAM2_END } asm volatile("s_waitcnt vmcnt(0) lgkmcnt(0)" ::: "memory"); SBAR(); }
template <class EF>
__device__ __forceinline__ void do_pair(bool ok0, bool ok1, LAS unsigned char* b0, LAS unsigned char* b1, int T0, int T1, const bf16x8 (&qf)[4], f32x16 (&o)[2], float& l, int lane, float nsh, EF ef) {
    if (ok0 && ok1) {
        const f32x16 s0 = qk_lds(b0, qf, lane, nsh), s1 = qk_lds(b1, qf, lane, nsh);
        float e0[16], e1[16];
#pragma unroll
        for (int r = 0; r < 16; ++r) { e0[r] = ef(T0, r, s0[r]); e1[r] = ef(T1, r, s1[r]); l += e0[r] + e1[r]; }
        pv_lds(b0, e0, o, lane); pv_lds(b1, e1, o, lane);
    } else if (ok0 || ok1) {
        LAS unsigned char* b = ok0 ? b0 : b1; const int T = ok0 ? T0 : T1;
        const f32x16 s = qk_lds(b, qf, lane, nsh);
        float e[16];
#pragma unroll
        for (int r = 0; r < 16; ++r) { e[r] = ef(T, r, s[r]); l += e[r]; }
        pv_lds(b, e, o, lane);
    }
}

__device__ __forceinline__ int first_keep(const float* cs, float cs0, float lim, int Tmax, int lane) {
    const int c1 = lane * 8;
    const bool k1 = c1 >= Tmax ? true : (cs0 - cs[32 * c1 + 31] >= lim);
    const unsigned long long b1 = __ballot(k1);
    const int f1 = b1 ? __builtin_ctzll(b1) : 64;
    if (f1 == 0) return 0;
    const int base = 8 * (f1 - 1) + 1, c2 = base + lane;
    const bool k2 = lane < 8 ? (c2 >= Tmax ? true : (cs0 - cs[32 * c2 + 31] >= lim)) : false;
    const unsigned long long b2 = __ballot(k2);
    const int r = base + (b2 ? __builtin_ctzll(b2) : 7);
    return r < Tmax ? r : Tmax;
}
__device__ __forceinline__ void wg_fox(const Params& P, const Frame& F, int layer, int h, int qb) {
    const int lane = F.lane, c = lane & 31, hg = lane >> 5, w = F.wave, t0 = qb * 256 + 32 * w, t = t0 + c;
    const float SH = gain_bound(P.fox_qk_g + layer * 128, P.fox_qk_g + layer * 128 + 64, lane);
    const float* cs = (const float*)(F.ws + WS_CS) + (size_t)h * SEQ;
    const bf16* qrow = F.PA + (size_t)t * PAC + C_FQ + h * 64;
    bf16x8 qf[4];
#pragma unroll
    for (int ks = 0; ks < 4; ++ks) qf[ks] = *(const bf16x8*)(qrow + ks * 16 + hg * 8);
    const float cq = cs[t];
    const float lim = -(2.f * SH + 40.f);
    const int Thw = qb * 8 + w, THI = qb * 8 + 7;
    int low = first_keep(cs, cs[t0], lim, Thw, lane), LO = first_keep(cs, cs[qb * 256], lim, qb * 8, lane);
    low = __builtin_amdgcn_readfirstlane(low); LO = __builtin_amdgcn_readfirstlane(LO);
    const bf16* KF = (const bf16*)(F.ws + WS_KF) + (size_t)(8 + h) * STREAM_ELEMS;
    const bf16* VF = (const bf16*)(F.ws + WS_VF) + (size_t)(8 + h) * STREAM_ELEMS;
    f32x16 o[2]; ZERO_O(o); float l = 0.f;
    const int LOp = LO > 0 ? LO - 1 : 0, kbase = 32 * LOp, ncs = (THI - LOp + 1) * 32;
    LAS float* csl = (LAS float*)F.lds;
    for (int i = F.tid; i < ncs; i += 512) csl[i] = cs[kbase + i];
    STREAM2_BEGIN(KF, VF, THI, -1, THI - LO + 1)
        do_pair(_v0 && T0 <= Thw && T0 >= low, _v1 && T1 <= Thw && T1 >= low, _b0, _b1, T0, T1, qf, o, l, lane, -SH,
                [=](int T, int r, float sv) { const int key = 32 * T + crow(r, hg); const float ck = csl[key - kbase];
                    return key <= t ? __builtin_amdgcn_exp2f(sv + (cq - ck)) : 0.f; });
    STREAM2_END
    l += shx(l, 32, lane);
    write_gated(F, o, l > 0.f ? 1.f / l : 0.f, t, C_OF + h * 64, C_FZ + h * 64, hg);
}

__device__ __forceinline__ void moba_load_block(const Frame& F, int h, int j) {
    const bf16* src = (const bf16*)(F.ws + (F.tid < 256 ? WS_KF : WS_VF)) + (size_t)h * STREAM_ELEMS + (size_t)(j * 8) * 2048 + (F.tid & 255) * 8;
    u32x4 r[8];
#pragma unroll
    for (int tt = 0; tt < 8; ++tt) r[tt] = *(const u32x4*)(src + tt * 2048);
#pragma unroll
    for (int tt = 0; tt < 8; ++tt) *(LAS u32x4*)(F.lds + RING_OFF + tt * 8192 + F.tid * 16) = r[tt];
    __syncthreads();
}
__device__ __forceinline__ bf16* moba_part(const Frame& F, int h, int t, int slot) {
    return slot == 0 ? F.PA + (size_t)t * PAC + C_FK + h * 64 : (slot == 1 ? F.PA + (size_t)t * PAC + C_FV + h * 64 : (bf16*)(F.ws + WS_P2) + ((size_t)h * SEQ + t) * 64);
}
__device__ __forceinline__ void wg_moba_own(const Params& P, const Frame& F, int layer, int h, int blk) {
    const int lane = F.lane, c = lane & 31, hg = lane >> 5, w = F.wave, t0 = blk * 256 + 32 * w, t = t0 + c;
    const float SH = gain_bound(P.moba_qk_g + layer * 128, P.moba_qk_g + layer * 128 + 64, lane);
    const bf16* qrow = F.PA + (size_t)t * PAC + C_MQ + h * 64;
    bf16x8 qf[4];
#pragma unroll
    for (int ks = 0; ks < 4; ++ks) qf[ks] = *(const bf16x8*)(qrow + ks * 16 + hg * 8);
    moba_load_block(F, h, blk);
    f32x16 o[2]; ZERO_O(o); float l = 0.f;
    for (int tp = 0; 2 * tp <= w; ++tp) {
        LAS unsigned char* b0 = F.lds + RING_OFF + (2 * tp) * 8192;
        do_pair(true, 2 * tp + 1 <= w, b0, b0 + 8192, blk * 8 + 2 * tp, blk * 8 + 2 * tp + 1, qf, o, l, lane, -SH,
                [=](int T, int r, float sv) { const int key = 32 * T + crow(r, hg); return key <= t ? __builtin_amdgcn_exp2f(sv) : 0.f; });
    }
    l += shx(l, 32, lane);
    bf16* rowp = F.PA + (size_t)t * PAC + C_OM + h * 64;
#pragma unroll
    for (int dt = 0; dt < 2; ++dt)
#pragma unroll
        for (int g = 0; g < 4; ++g) { u32x2 wv; wv.x = cvt_pk_bf16(o[dt][4 * g], o[dt][4 * g + 1]); wv.y = cvt_pk_bf16(o[dt][4 * g + 2], o[dt][4 * g + 3]);
            *(u32x2*)(rowp + dt * 32 + 8 * g + 4 * hg) = wv; }
    if (hg == 0) ((float*)(F.ws + WS_LOWN))[h * SEQ + t] = l;
    __syncthreads();
}
__device__ __forceinline__ void wg_moba_sel(const Params& P, const Frame& F, int layer, int h, int j) {
    const int lane = F.lane, c = lane & 31, hg = lane >> 5, w = F.wave;
    const int n = (int)((const unsigned*)(F.ws + WS_CTL))[1024 + 16384 * layer + (h * 64 + j) * 32];
    if (n == 0) return;
    const float SH = gain_bound(P.moba_qk_g + layer * 128, P.moba_qk_g + layer * 128 + 64, lane);
    moba_load_block(F, h, j);
    const unsigned short* list = (const unsigned short*)(F.ws + WS_LIST) + (size_t)h * LIST_HEAD + list_off(j);
    float* LPART = (float*)(F.ws + WS_LPART);
    bool valid = false; unsigned ent = 0u; bf16x8 qf[4];
    if (w * 32 < n) { const int i = w * 32 + c; valid = i < n; ent = list[valid ? i : w * 32];
        const bf16* qrow = F.PA + (size_t)(ent >> 2) * PAC + C_MQ + h * 64;
#pragma unroll
        for (int ks = 0; ks < 4; ++ks) qf[ks] = *(const bf16x8*)(qrow + ks * 16 + hg * 8); }
    for (int cb = w * 32; cb < n; cb += 256) {
        const int cbn = cb + 256; bool validn = false; unsigned entn = 0u; bf16x8 qfn[4];
        if (cbn < n) { const int in = cbn + c; validn = in < n; entn = list[validn ? in : cbn];
            const bf16* qrn = F.PA + (size_t)(entn >> 2) * PAC + C_MQ + h * 64;
#pragma unroll
            for (int ks = 0; ks < 4; ++ks) qfn[ks] = *(const bf16x8*)(qrn + ks * 16 + hg * 8); }
        const int t = (int)(ent >> 2), slot = (int)(ent & 3u);
        f32x16 o[2]; ZERO_O(o); float l = 0.f;
        for (int tp = 0; tp < 4; ++tp) {
            LAS unsigned char* b0 = F.lds + RING_OFF + (2 * tp) * 8192;
            do_pair(true, true, b0, b0 + 8192, 0, 0, qf, o, l, lane, -SH, [=](int, int, float sv) { return __builtin_amdgcn_exp2f(sv); });
        }
        l += shx(l, 32, lane);
        if (valid) {
            const size_t rec = ((size_t)h * SEQ + t) * 3 + slot;
            bf16* pp = moba_part(F, h, t, slot);
#pragma unroll
            for (int dt = 0; dt < 2; ++dt)
#pragma unroll
                for (int g = 0; g < 4; ++g) { u32x2 wv; wv.x = cvt_pk_bf16(o[dt][4 * g], o[dt][4 * g + 1]); wv.y = cvt_pk_bf16(o[dt][4 * g + 2], o[dt][4 * g + 3]);
                    *(u32x2*)(pp + dt * 32 + 8 * g + 4 * hg) = wv; }
            if (hg == 0) LPART[rec] = l;
        }
        valid = validn; ent = entn;
#pragma unroll
        for (int ks = 0; ks < 4; ++ks) qf[ks] = qfn[ks];
    }
    __syncthreads();
}

__device__ __forceinline__ void wg_nsa(const Params& P, const Frame& F, int layer, int qb) {
    const int lane = F.lane, c = lane & 31, hg = lane >> 5, w = F.wave, qi = c >> 2, h = c & 3, t0 = qb * 64 + 8 * w, t = t0 + qi, cur = qb;
    const float* kg = P.nsa_k_g + layer * 192; const float* qg = P.nsa_q_g + layer * 64;
    const float SHc = gain_bound(qg, kg, lane), SHs = gain_bound(qg, kg + 64, lane), SHw = gain_bound(qg, kg + 128, lane);
    const bf16* prow = F.PA + (size_t)t * PAC;
    bf16x8 qf[4];
#pragma unroll
    for (int ks = 0; ks < 4; ++ks) qf[ks] = *(const bf16x8*)(prow + C_NQ + h * 64 + ks * 16 + hg * 8);
    const float g0 = sigmoidf_(bf2f(prow[C_NG + h * 3 + 0])), g1 = sigmoidf_(bf2f(prow[C_NG + h * 3 + 1])), g2 = sigmoidf_(bf2f(prow[C_NG + h * 3 + 2]));
    LAS float* imp = (LAS float*)(F.lds + w * 8192);
    f32x16 accF[2]; ZERO_O(accF);
    f32x16 o[2]; float l;
    const int ntw = (t0 + 7 >= 31) ? (((t0 + 7 - 31) >> 4) >> 5) + 1 : 0;
    const int NT = (qb * 64 + 63 >= 31) ? (((qb * 64 + 63 - 31) >> 4) >> 5) + 1 : 0;
    const bf16* KC = (const bf16*)(F.ws + WS_KCMP); const bf16* VC = (const bf16*)(F.ws + WS_VCMP);
    ZERO_O(o); l = 0.f;
    STREAM2_BEGIN(KC, VC, 0, 1, NT)
        do_pair(_v0 && T0 < ntw, _v1 && T1 < ntw, _b0, _b1, T0, T1, qf, o, l, lane, -SHc,
                [=](int T, int r, float sv) { const int n = 32 * T + crow(r, hg); return (16 * n + 31 <= t) ? __builtin_amdgcn_exp2f(sv) : 0.f; });
    STREAM2_END
    l += shx(l, 32, lane);
    const float invc = l > 0.f ? 1.f / l : 0.f;
    {
        const float sc = g0 * invc;
#pragma unroll
        for (int r = 0; r < 16; ++r) { accF[0][r] += sc * o[0][r]; accF[1][r] += sc * o[1][r]; }
    }
    {
        float prevEx = 0.f;
        STREAM_BEGIN(KC, VC, 0, 1, NT)
            if (T < ntw) {
                const f32x16 s = qk_lds(_buf, qf, lane);
#pragma unroll
                for (int g = 0; g < 4; ++g) {
                    float s4 = 0.f, ed = 0.f;
#pragma unroll
                    for (int k = 0; k < 4; ++k) { const int r = 4 * g + k; const int n = 32 * T + crow(r, hg);
                        const float p = (16 * n + 31 <= t) ? __builtin_amdgcn_exp2f(s[r] - SHc) * invc : 0.f; s4 += p; if (k == 3) ed = p; }
                    s4 += dpp_x1(s4); s4 += dpp_x2(s4); ed += dpp_x1(ed); ed += dpp_x2(ed);
                    const float Ex = shx(ed, 32, lane);
                    const float Sp = s4 + (hg ? Ex : prevEx); prevEx = Ex;
                    if (h == 0) imp[qi * 256 + 8 * T + 2 * g + hg] = Sp;
                }
            }
        STREAM_END
    }
    unsigned long long my0 = 0ull, my1 = 0ull, my2 = 0ull, my3 = 0ull, un0 = 0ull, un1 = 0ull, un2 = 0ull, un3 = 0ull;
    {
        const int qs = lane >> 3, sub = lane & 7;
        float val[32];
#pragma unroll
        for (int k = 0; k < 32; ++k) { const int m = sub + 8 * k;
            const float iv = imp[qs * 256 + m];
            val[k] = (m > cur) ? -3e38f : ((m == 0 || m == cur || m == cur - 1) ? 3e38f : iv); }
        const int nsel = cur + 1 < 16 ? cur + 1 : 16;
        for (int rd = 0; rd < nsel; ++rd) {
            float bv = val[0]; int bk = 0;
#pragma unroll
            for (int k = 1; k < 32; ++k) if (val[k] > bv) { bv = val[k]; bk = k; }
            int bm = sub + 8 * bk;
#pragma unroll
            for (int of = 1; of < 8; of <<= 1) { const float ov = shx(bv, of, lane); const int om = shxi(bm, of, lane);
                if (ov > bv || (ov == bv && om < bm)) { bv = ov; bm = om; } }
#pragma unroll
            for (int k = 0; k < 32; ++k) if (sub + 8 * k == bm) val[k] = -3e38f;
            const int wa = shfromi(bm, (c >> 2) * 8);
            { const unsigned long long bit = 1ull << (wa & 63); const int kk = wa >> 6;
              my0 |= kk == 0 ? bit : 0ull; my1 |= kk == 1 ? bit : 0ull; my2 |= kk == 2 ? bit : 0ull; my3 |= kk == 3 ? bit : 0ull; }
#pragma unroll
            for (int q = 0; q < 8; ++q) { const int wq = __builtin_amdgcn_readlane(bm, q * 8); const unsigned long long bit = 1ull << (wq & 63); const int kk = wq >> 6;
                un0 |= kk == 0 ? bit : 0ull; un1 |= kk == 1 ? bit : 0ull; un2 |= kk == 2 ? bit : 0ull; un3 |= kk == 3 ? bit : 0ull; }
        }
    }
    const bf16* KS = (const bf16*)(F.ws + WS_KF) + (size_t)6 * STREAM_ELEMS; const bf16* VS = (const bf16*)(F.ws + WS_VF) + (size_t)6 * STREAM_ELEMS;
    ZERO_O(o); l = 0.f;
    {
        const int NG = (cur + 8) >> 3;
        const char* srcb = (const char*)((w < 4) ? KS : VS) + (w & 3) * 1024 + lane * 16;
        LAS unsigned char* ring0 = F.lds; const unsigned wo = (unsigned)w * 1024u; const unsigned ring0a = lds_addr(ring0);
#define DMAG(gi) do { _Pragma("unroll") for (int _tt = 0; _tt < 16; ++_tt) \
        glds16(srcb + (ptrdiff_t)((gi) * 16 + _tt) * 4096, (unsigned)__builtin_amdgcn_readfirstlane(ring0a + (unsigned)(_tt * 8192) + wo)); } while (0)
        asm volatile("s_waitcnt vmcnt(0) lgkmcnt(0)" ::: "memory"); SBAR();
        for (int gi = 0; gi < NG; ++gi) {
            DMAG(gi);
            VMW(0);
            SBAR();
#pragma unroll
            for (int bb = 0; bb < 8; ++bb) {
                const int m = gi * 8 + bb, kk = m >> 6, b = m & 63;
                const unsigned long long uw = kk == 0 ? un0 : (kk == 1 ? un1 : (kk == 2 ? un2 : un3));
                if (m < 256 && ((uw >> b) & 1ull)) {
                    const unsigned long long mw = kk == 0 ? my0 : (kk == 1 ? my1 : (kk == 2 ? my2 : my3));
                    const bool flag = (mw >> b) & 1ull;
                    {
                        LAS unsigned char* b0 = ring0 + (bb * 2) * 8192; LAS unsigned char* b1 = b0 + 8192;
                        const f32x16 s0 = qk_lds(b0, qf, lane, -SHs), s1 = qk_lds(b1, qf, lane, -SHs);
                        float e0[16], e1[16];
                        if (m == cur) {
#pragma unroll
                            for (int r = 0; r < 16; ++r) { const int key = 64 * m + crow(r, hg);
                                e0[r] = (flag && key <= t) ? __builtin_amdgcn_exp2f(s0[r]) : 0.f; e1[r] = (flag && key + 32 <= t) ? __builtin_amdgcn_exp2f(s1[r]) : 0.f; l += e0[r] + e1[r]; }
                        } else {
                            const float fl = flag ? 1.f : 0.f;
#pragma unroll
                            for (int r = 0; r < 16; ++r) { e0[r] = fl * __builtin_amdgcn_exp2f(s0[r]); e1[r] = fl * __builtin_amdgcn_exp2f(s1[r]); l += e0[r] + e1[r]; }
                        }
                        pv_lds(b0, e0, o, lane); pv_lds(b1, e1, o, lane);
                    }
                }
            }
            asm volatile("s_waitcnt lgkmcnt(0)" ::: "memory"); SBAR();
        }
#undef DMAG
    }
    l += shx(l, 32, lane);
    {
        const float sc = l > 0.f ? g1 / l : 0.f;
#pragma unroll
        for (int r = 0; r < 16; ++r) { accF[0][r] += sc * o[0][r]; accF[1][r] += sc * o[1][r]; }
    }
    const bf16* KW = (const bf16*)(F.ws + WS_KF) + (size_t)7 * STREAM_ELEMS; const bf16* VW = (const bf16*)(F.ws + WS_VF) + (size_t)7 * STREAM_ELEMS;
    ZERO_O(o); l = 0.f;
    const int Tlw = (t0 - 511 > 0 ? t0 - 511 : 0) >> 5, Thw = (t0 + 7) >> 5;
    const int TLO = (qb * 64 - 511 > 0 ? qb * 64 - 511 : 0) >> 5, THI = (qb * 64 + 63) >> 5;
    STREAM2_BEGIN(KW, VW, TLO, 1, THI - TLO + 1)
        do_pair(_v0 && T0 >= Tlw && T0 <= Thw, _v1 && T1 >= Tlw && T1 <= Thw, _b0, _b1, T0, T1, qf, o, l, lane, -SHw,
                [=](int T, int r, float sv) { const int key = 32 * T + crow(r, hg); return (key <= t && key >= t - 511) ? __builtin_amdgcn_exp2f(sv) : 0.f; });
    STREAM2_END
    l += shx(l, 32, lane);
    {
        const float sc = l > 0.f ? g2 / l : 0.f;
#pragma unroll
        for (int r = 0; r < 16; ++r) { accF[0][r] += sc * o[0][r]; accF[1][r] += sc * o[1][r]; }
    }
    write_gated(F, accF, 1.f, t, C_ON + h * 64, C_NZ + h * 64, hg);
}

__device__ __forceinline__ void phase4a(const Params& P, const Frame& F0, int layer, int rep) {
    unsigned* ctr = (unsigned*)(F0.ws + WS_CTL) + 16 * layer + 8 * rep;
    constexpr int N_NSA = 256, N_FOX = 384, N_SEL = 384, N_OWN = 384, N_ALL = N_NSA + N_FOX + N_SEL + N_OWN;
    volatile LAS unsigned* ubox = (volatile LAS unsigned*)(F0.lds + 131072);
    for (;;) {
        Frame F = F0;
        { unsigned char* wp = F0.ws; asm volatile("" : "+s"(wp)); int tv = F0.tid; asm volatile("" : "+v"(tv)); F.ws = wp; F.PA = (bf16*)(wp + WS_PA); F.tid = tv; F.lane = tv & 63; }
        if (F.tid == 0) *ubox = __hip_atomic_fetch_add(ctr, 1u, __ATOMIC_RELAXED, __HIP_MEMORY_SCOPE_AGENT);
        __syncthreads();
        const unsigned u = __builtin_amdgcn_readfirstlane(*ubox);
        __syncthreads();
        if (u >= (unsigned)N_ALL) break;
#ifndef PROBE_ONLY
#define PROBE_ONLY -1
#endif
        if (u < (unsigned)N_NSA) { if (PROBE_ONLY < 0 || PROBE_ONLY == 0) wg_nsa(P, F, layer, 255 - (int)u); }
        else if (u < (unsigned)(N_NSA + N_FOX)) { const unsigned v = u - N_NSA; if (PROBE_ONLY < 0 || PROBE_ONLY == 1) wg_fox(P, F, layer, (int)(v % 6), 63 - (int)(v / 6)); }
        else if (u < (unsigned)(N_NSA + N_FOX + N_SEL)) { const unsigned v = u - (N_NSA + N_FOX); if (PROBE_ONLY < 0 || PROBE_ONLY == 2) wg_moba_sel(P, F, layer, (int)(v % 6), (int)(v / 6)); }
        else { const unsigned v = u - (N_NSA + N_FOX + N_SEL); if (PROBE_ONLY < 0 || PROBE_ONLY == 3) wg_moba_own(P, F, layer, (int)(v % 6), 63 - (int)(v / 6)); }
    }
}

__device__ __forceinline__ void phase4b(const Params& P, const Frame& F, int layer, const float* xin) {
    const float* LPART = (const float*)(F.ws + WS_LPART); const float* LOWN = (const float*)(F.ws + WS_LOWN);
    for (int it = F.gw; it < SEQ * 48 / 64; it += F.NGW) {
        const int idx = it * 64 + F.lane, t = idx / 48, r = idx - t * 48, h = r >> 3, d8 = (r & 7) * 8, cur = t >> 8;
        bf16* op = F.PA + (size_t)t * PAC + C_OM + h * 64 + d8;
        const u32x4 ow = *(const u32x4*)op;
        float v[8] = {bflo(ow.x), bfhi(ow.x), bflo(ow.y), bfhi(ow.y), bflo(ow.z), bfhi(ow.z), bflo(ow.w), bfhi(ow.w)};
        float l = LOWN[h * SEQ + t];
        const size_t rec = ((size_t)h * SEQ + t) * 3;
#pragma unroll
        for (int s = 0; s < 3; ++s) if (s < cur) {
            const u32x4 pw = *(const u32x4*)(moba_part(F, h, t, s) + d8);
            v[0] += bflo(pw.x); v[1] += bfhi(pw.x); v[2] += bflo(pw.y); v[3] += bfhi(pw.y); v[4] += bflo(pw.z); v[5] += bfhi(pw.z); v[6] += bflo(pw.w); v[7] += bfhi(pw.w);
            l += LPART[rec + s];
        }
        const float inv = l > 0.f ? 1.f / l : 0.f;
        const u32x4 z = *(const u32x4*)(F.PA + (size_t)t * PAC + C_MZ + h * 64 + d8);
        u32x4 wv;
        wv.x = cvt_pk_bf16(v[0] * inv * siluf_(bflo(z.x)), v[1] * inv * siluf_(bfhi(z.x))); wv.y = cvt_pk_bf16(v[2] * inv * siluf_(bflo(z.y)), v[3] * inv * siluf_(bfhi(z.y)));
        wv.z = cvt_pk_bf16(v[4] * inv * siluf_(bflo(z.z)), v[5] * inv * siluf_(bfhi(z.z))); wv.w = cvt_pk_bf16(v[6] * inv * siluf_(bflo(z.w)), v[7] * inv * siluf_(bfhi(z.w)));
        *(u32x4*)op = wv;
    }
    (void)xin;
}


#define XB_TMO      128
#define XB_XCNT(j)  (256  + 64 * (j))
#define XB_XSUB(j)  (1280 + 64 * (j))
#define XB_XGEN(j)  (2304 + 64 * (j))
#define XB_TOP      3328
#define XB_TOPGEN   3392
#define XCD_BAR_WORDS 3456
#define XB_SPIN_CAP (1u << 22)
__device__ __forceinline__ unsigned xb_ld(unsigned* p)              { return __hip_atomic_load(p, __ATOMIC_RELAXED, __HIP_MEMORY_SCOPE_AGENT); }
__device__ __forceinline__ unsigned xb_add(unsigned* p, unsigned v) { return __hip_atomic_fetch_add(p, v, __ATOMIC_RELAXED, __HIP_MEMORY_SCOPE_AGENT); }
__device__ __forceinline__ unsigned xb_xcc_id() { return (unsigned)__builtin_amdgcn_s_getreg((3 << 11) | 20) & 0xFu; }
#define XB_SPIN(cond, bar) do { unsigned _sp = 0; while (cond) { __builtin_amdgcn_s_sleep(1); \
    if ((++_sp & 255u) == 0u) { if (xb_ld(&(bar)[XB_TMO])) break; if (_sp > XB_SPIN_CAP) { atomicAdd(&(bar)[XB_TMO], 1u); break; } } } } while (0)
struct XcdBarrier { unsigned* bar; unsigned x; volatile LAS unsigned* st; };
__device__ __forceinline__ XcdBarrier xcd_barrier_post(unsigned* bar, volatile LAS unsigned* st) {
    XcdBarrier b; b.bar = bar; b.x = xb_xcc_id(); b.st = st;
    if (threadIdx.x == 0) (void)xb_add(&bar[XB_XCNT(b.x)], 1u);
    return b;
}
__device__ __forceinline__ void xcd_barrier_complete(unsigned* bar, unsigned x, unsigned& nloc, unsigned& nx) {
    const unsigned G = gridDim.x * gridDim.y * gridDim.z;
    unsigned sum, cnt, mine, sp = 0u;
    for (;;) {
        sum = 0u; cnt = 0u; mine = 0u;
#pragma unroll
        for (unsigned j = 0; j < 16; ++j) { const unsigned c = xb_ld(&bar[XB_XCNT(j)]); sum += c; cnt += (c > 0u) ? 1u : 0u; mine = (j == x) ? c : mine; }
        if (sum == G) break;
        __builtin_amdgcn_s_sleep(1);
        if ((++sp & 255u) == 0u) { if (xb_ld(&bar[XB_TMO])) break; if (sp > XB_SPIN_CAP) { atomicAdd(&bar[XB_TMO], 1u); break; } }
    }
    nloc = mine > 0u ? mine : 1u; nx = cnt > 0u ? cnt : 1u;
}
__device__ __forceinline__ void xcd_barrier(const XcdBarrier& b) {
    asm volatile("s_waitcnt vmcnt(0)" ::: "memory");
    __syncthreads();
    if (threadIdx.x == 0) {
        unsigned* bar = b.bar;
        __builtin_amdgcn_s_waitcnt(0);
        unsigned nloc = b.st[0], nx = b.st[1];
        if (nloc == 0u) { xcd_barrier_complete(bar, b.x, nloc, nx); b.st[0] = nloc; b.st[1] = nx; }
        const unsigned old = xb_add(&bar[XB_XSUB(b.x)], 1u);
        const unsigned gen = old / nloc;
        if (old + 1u == (gen + 1u) * nloc) {
            __builtin_amdgcn_fence(__ATOMIC_RELEASE, "agent");
            asm volatile("s_waitcnt vmcnt(0)" ::: "memory");
            const unsigned og = xb_add(&bar[XB_TOP], 1u);
            const unsigned tg = og / nx;
            if (og + 1u == (tg + 1u) * nx) xb_add(&bar[XB_TOPGEN], 1u);
            else XB_SPIN(xb_ld(&bar[XB_TOPGEN]) == tg, bar);
            __builtin_amdgcn_fence(__ATOMIC_ACQUIRE, "agent");
            xb_add(&bar[XB_XGEN(b.x)], 1u);
            asm volatile("s_waitcnt vmcnt(0)" ::: "memory");
        } else {
            XB_SPIN(xb_ld(&bar[XB_XGEN(b.x)]) == gen, bar);
            __builtin_amdgcn_fence(__ATOMIC_ACQUIRE, "agent");
            asm volatile("s_waitcnt vmcnt(0)" ::: "memory");
        }
    }
    __syncthreads();
}

__global__ void __launch_bounds__(512, 2) fwd_kernel(Params P) {
    extern __shared__ __attribute__((aligned(16))) unsigned char lds_raw[];
    cg::grid_group grid = cg::this_grid();
    const int G = gridDim.x, bx = blockIdx.x;
    volatile LAS unsigned* bst = (volatile LAS unsigned*)((LAS unsigned char*)lds_raw + 131072 + 64);
    if (threadIdx.x == 0) { bst[0] = 0u; bst[1] = 0u; }
    __syncthreads();
    XcdBarrier gbar; gbar.bar = (unsigned*)(P.ws + WS_BAR); gbar.x = 0; gbar.st = bst;
    if (P.ph_hi - P.ph_lo > 1) gbar = xcd_barrier_post((unsigned*)(P.ws + WS_BAR), bst);
#ifdef PROBE_TS
    unsigned long long ts_acc = 0ull;
#endif
    long long p2acc = 0;
#ifdef PROBE_SYNC
    { const unsigned long long t0 = __builtin_amdgcn_s_memrealtime();
      for (int i = 0; i < 20; ++i) grid.sync();
      p2acc += (long long)(__builtin_amdgcn_s_memrealtime() - t0); }
#endif
    for (int ph = P.ph_lo; ph < P.ph_hi; ++ph) {
#ifdef PROBE_TS
        const unsigned long long ts0 = __builtin_amdgcn_s_memrealtime();
#endif
        unsigned char* wsb = P.ws; asm volatile("" : "+s"(wsb));
        int tidv = threadIdx.x; asm volatile("" : "+v"(tidv));
        Frame F;
        F.lds = (LAS unsigned char*)lds_raw;
        F.tid = tidv; F.lane = F.tid & 63; F.wave = __builtin_amdgcn_readfirstlane(F.tid >> 6);
        F.gw = bx * 8 + F.wave; F.NGW = G * 8;
        F.ws = wsb; F.PA = (bf16*)(wsb + WS_PA);
        const int layer = ph / NPH, k = ph - layer * NPH;
        const float* xin = layer == 0 ? P.x : P.out;
        if (k == 0) phase0(P, F, layer, xin);
        else if (k == 1) {
            pg8::Gemm g{(const bf16*)(wsb + WS_H), (const bf16*)(wsb + WS_WA), SEQ, PAC, DM, DM}; pg8::StaticOrder S; S.init(SEQ, PAC, G, bx); pg8::EpiBf16 E{F.PA, PAC};
            pg8::gemm_phase<pg8::EpiBf16, pg8::StaticOrder>(F.lds, g, S, E, F.tid);
        }
        else if (k == 6) {
            pg8::StaticOrder SM; SM.init(SEQ, DM, G, bx); pg8::Unit mu;
            for (int j = 0; SM.next(j, mu); ++j) {
                { unsigned char* wl = wsb; asm volatile("" : "+s"(wl)); int tl = tidv; asm volatile("" : "+v"(tl));
                  pg8::Gemm g{(const bf16*)(wl + WS_H), (const bf16*)(wl + WS_WG), SEQ, NGL, DM, DM}; pg8::FixedUnits S{mu, 3, 4}; pg8::EpiBf16 E{(bf16*)(wl + WS_PA) + C_GL, PAC};
                  pg8::gemm_phase<pg8::EpiBf16, pg8::FixedUnits>(F.lds, g, S, E, tl); }
                for (int b = 0; b < 3; ++b) {
                    unsigned char* wl = wsb; asm volatile("" : "+s"(wl)); int tl = tidv; asm volatile("" : "+v"(tl));
                    bf16* PAl = (bf16*)(wl + WS_PA);
                    const int Kb = b == 1 ? 256 : 384;
                    const bf16* A = PAl + (b == 0 ? C_OM : (b == 1 ? C_ON : C_OF));
                    const bf16* Bt = (const bf16*)(wl + (b == 0 ? WS_WUPM : (b == 1 ? WS_WUPN : WS_WUPF)));
                    pg8::Gemm g{A, Bt, SEQ, DM, Kb, PAC}; pg8::FixedUnits S{mu, 1, 0};
                    pg8::EpiMerge E{(bf16*)(wl + WS_MG), PAl + C_GL + b * 1024, P.b_gate + layer * 3072 + b * 1024, b == 0 ? 1 : 0};
                    pg8::gemm_phase<pg8::EpiMerge, pg8::FixedUnits>(F.lds, g, S, E, tl);
                }
            }
        }
        else if (k == 2) phase2(P, F, layer, p2acc);
        else if (k == 3) phase3(P, F, layer);
        else if (k == 4) {
#ifdef PROBE_P4X2
            for (int rep = 0; rep < 2; ++rep) { if (rep) grid.sync(); phase4a(P, F, layer, rep); }
#else
            phase4a(P, F, layer, 0);
#endif
        }
        else if (k == 5) phase4b(P, F, layer, xin);
        else {
            pg8::Gemm g{(const bf16*)(wsb + WS_MG), (const bf16*)(wsb + WS_WO), SEQ, DM, DM, DM}; pg8::StaticOrder S; S.init(SEQ, DM, G, bx);
            pg8::EpiOut E{xin, P.out};
            pg8::gemm_phase<pg8::EpiOut, pg8::StaticOrder>(F.lds, g, S, E, F.tid);
        }
        if (ph + 1 < P.ph_hi) { if (P.ph_hi < 0) grid.sync(); else xcd_barrier(gbar); }
#ifdef PROBE_TS
        if ((ph % NPH) == PROBE_TS) ts_acc += __builtin_amdgcn_s_memrealtime() - ts0;
        if (ph + 1 == P.ph_hi && bx == 0 && tidv == 0) { __threadfence(); P.out[0] += (float)ts_acc * 1e-3f; }
#endif
#ifdef PROBE_SYNC
        if (ph + 1 == P.ph_hi && bx == 0 && tidv == 0) { __threadfence(); P.out[0] += (float)p2acc * 1e-3f; }
#endif
#ifdef PROBE_P2PART
        if (ph + 1 == P.ph_hi && bx == PROBE_P2BLK && tidv == 0) { __threadfence(); P.out[0] += (float)p2acc * 1e-3f; }
#endif
    }
}

extern "C" void kernel_launch(void* const* d_in, const int* in_sizes, int n_in, void* d_out, int out_size, void* d_ws, size_t ws_size, hipStream_t stream) {
    static int grid = 0;
    if (grid == 0) {
        if (n_in != 16 || out_size != SEQ * DM || ws_size < WS_END) { fprintf(stderr, "kernel_launch: unexpected problem shape (n_in %d out %d ws %zu)\n", n_in, out_size, ws_size); grid = -1; return; }
        int dev = 0, cus = 0, per_cu = 0;
        hipGetDevice(&dev);
        hipDeviceGetAttribute(&cus, hipDeviceAttributeMultiprocessorCount, dev);
        hipFuncSetAttribute((const void*)fwd_kernel, hipFuncAttributeMaxDynamicSharedMemorySize, LDS_BYTES);
        hipOccupancyMaxActiveBlocksPerMultiprocessor(&per_cu, (const void*)fwd_kernel, 512, LDS_BYTES);
        if (per_cu < 1) { fprintf(stderr, "kernel_launch: occupancy query says %d blocks per CU\n", per_cu); per_cu = 1; }
        (void)hipGetLastError();
        grid = cus * per_cu;
    }
    if (grid < 0) return;
    Params p{};
    p.x = (const float*)d_in[0]; p.norm_g = (const float*)d_in[1]; p.w_in = (const float*)d_in[2]; p.b_f = (const float*)d_in[3]; p.b_gate = (const float*)d_in[4];
    p.moba_qk_g = (const float*)d_in[5]; p.nsa_q_g = (const float*)d_in[6]; p.nsa_k_g = (const float*)d_in[7]; p.fox_qk_g = (const float*)d_in[8];
    p.cmp_pe = (const float*)d_in[9]; p.cmp_w1 = (const float*)d_in[10]; p.cmp_w2 = (const float*)d_in[11];
    p.w_up_moba = (const float*)d_in[12]; p.w_up_nsa = (const float*)d_in[13]; p.w_up_fox = (const float*)d_in[14]; p.w_out = (const float*)d_in[15];
    p.out = (float*)d_out; p.ws = (unsigned char*)d_ws;
#if N_LAUNCH_MODE == 1
    for (int ph = 0; ph < 2 * NPH; ++ph) { p.ph_lo = ph; p.ph_hi = ph + 1; hipLaunchKernelGGL(fwd_kernel, dim3(grid), dim3(512), LDS_BYTES, stream, p); }
#else
    p.ph_lo = 0; p.ph_hi = 2 * NPH;
    if (hipMemsetAsync((char*)d_ws + WS_BAR, 0, 16384, stream) != hipSuccess) { fprintf(stderr, "kernel_launch: memset of the barrier words failed\n"); return; }
    void* args[] = {&p};
    hipError_t e = hipLaunchCooperativeKernel((const void*)fwd_kernel, dim3(grid), dim3(512), args, LDS_BYTES, stream);
    if (e != hipSuccess) fprintf(stderr, "kernel_launch: cooperative launch failed: %s (grid %d)\n", hipGetErrorString(e), grid);
#endif
}
```

```cpp
#include <hip/hip_runtime.h>
#include <hip/hip_cooperative_groups.h>
#include <cstdio>
#include <cstdint>
namespace cg = cooperative_groups;

#ifndef N_LAUNCH_MODE
#define N_LAUNCH_MODE 0
#endif

typedef unsigned short bf16;
typedef short bf16x8 __attribute__((ext_vector_type(8)));
typedef float f32x4 __attribute__((ext_vector_type(4)));
typedef float f32x16 __attribute__((ext_vector_type(16)));
typedef unsigned u32x4 __attribute__((ext_vector_type(4)));
typedef unsigned u32x2 __attribute__((ext_vector_type(2)));
#define LAS __attribute__((address_space(3)))

constexpr int SEQ = 16384, DM = 1024, INC = 7058, PAC = 4096, NGL = 3072;
constexpr float LOG2E = 1.4426950408889634f;
constexpr float C2 = 0.125f * LOG2E;
constexpr float RMS_EPS = 1e-6f;
constexpr int LDS_BYTES = 131072 + 256;
constexpr int NPH = 7;

constexpr int C_MK = 0, C_MV = 384, C_KC = 768, C_VC = 832, C_KSL = 896, C_VSL = 960, C_MQ = 1024, C_MZ = 1408, C_NQ = 1792, C_KW = 2048, C_VW = 2112,
              C_NZ = 2176, C_FQ = 2432, C_FK = 2816, C_FV = 3200, C_FZ = 3584, C_NG = 3968, C_FF = 3980, C_GL = 1024;
constexpr int C_OM = 0, C_OF = 384, C_ON = 768;

constexpr size_t MiB = 1u << 20;
constexpr size_t WS_BAR = 512 * 1024  ;
constexpr size_t WS_CTL = 0, WS_WA = 1 * MiB, WS_WG = 9 * MiB, WS_WUPM = 15 * MiB, WS_WUPN = 15 * MiB + 768 * 1024, WS_WUPF = 15 * MiB + 1280 * 1024,
                 WS_WO = 17 * MiB, WS_W1T = 19 * MiB, WS_W2T = 21 * MiB, WS_KMEAN = 21 * MiB + 128 * 1024,
                 WS_CS = 21 * MiB + 256 * 1024, WS_CSTOT = 21 * MiB + 768 * 1024, WS_KCMP = 22 * MiB, WS_VCMP = 22 * MiB + 128 * 1024,
                 WS_KF = 23 * MiB, WS_VF = 51 * MiB, WS_MG = 23 * MiB  , WS_PA = 80 * MiB,
                 WS_H = 208 * MiB  , WS_P2 = 240 * MiB  ,
                 WS_LIST = 1 * MiB  , WS_LPART = 19 * MiB, WS_LOWN = 19 * MiB + 1280 * 1024  ,
                 WS_END = 256 * MiB;
constexpr size_t STREAM_ELEMS = (size_t)SEQ * 64;

struct Params {
    const float* x; const float* norm_g; const float* w_in; const float* b_f; const float* b_gate;
    const float* moba_qk_g; const float* nsa_q_g; const float* nsa_k_g; const float* fox_qk_g;
    const float* cmp_pe; const float* cmp_w1; const float* cmp_w2; const float* w_up_moba; const float* w_up_nsa; const float* w_up_fox; const float* w_out;
    float* out; unsigned char* ws; int ph_lo, ph_hi;
};

typedef float f32x2_t __attribute__((ext_vector_type(2)));
typedef __bf16 bf16x2_t __attribute__((ext_vector_type(2)));
__device__ __forceinline__ unsigned cvt_pk_bf16(float lo, float hi) { const f32x2_t v = {lo, hi}; const bf16x2_t b = __builtin_convertvector(v, bf16x2_t); return __builtin_bit_cast(unsigned, b); }
__device__ __forceinline__ float bf2f(unsigned short b) { return __builtin_bit_cast(float, (unsigned)b << 16); }
__device__ __forceinline__ float bflo(unsigned w) { return __builtin_bit_cast(float, w << 16); }
__device__ __forceinline__ float bfhi(unsigned w) { return __builtin_bit_cast(float, w & 0xffff0000u); }
__device__ __forceinline__ unsigned short f2bf(float f) { return (unsigned short)(cvt_pk_bf16(f, 0.f) & 0xffffu); }
__device__ __forceinline__ float shx(float v, int m, int lane) { return __builtin_bit_cast(float, __builtin_amdgcn_ds_bpermute((lane ^ m) << 2, __builtin_bit_cast(int, v))); }
__device__ __forceinline__ int shxi(int v, int m, int lane) { return __builtin_amdgcn_ds_bpermute((lane ^ m) << 2, v); }
__device__ __forceinline__ float shfrom(float v, int src) { return __builtin_bit_cast(float, __builtin_amdgcn_ds_bpermute(src << 2, __builtin_bit_cast(int, v))); }
__device__ __forceinline__ int shfromi(int v, int src) { return __builtin_amdgcn_ds_bpermute(src << 2, v); }
__device__ __forceinline__ float dpp_x1(float v) { return __builtin_bit_cast(float, __builtin_amdgcn_update_dpp(0, __builtin_bit_cast(int, v), 0xB1, 0xf, 0xf, false)); }
__device__ __forceinline__ float dpp_x2(float v) { return __builtin_bit_cast(float, __builtin_amdgcn_update_dpp(0, __builtin_bit_cast(int, v), 0x4E, 0xf, 0xf, false)); }
__device__ __forceinline__ float wave_sum(float v, int lane) {
#pragma unroll
    for (int o = 1; o < 64; o <<= 1) v += shx(v, o, lane);
    return v;
}
__device__ __forceinline__ float wave_max(float v, int lane) {
#pragma unroll
    for (int o = 1; o < 64; o <<= 1) v = fmaxf(v, shx(v, o, lane));
    return v;
}
__device__ __forceinline__ int crow(int r, int hi) { return (r & 3) + 8 * (r >> 2) + 4 * hi; }
__device__ __forceinline__ float sigmoidf_(float z) { return __builtin_amdgcn_rcpf(1.f + __builtin_amdgcn_exp2f(-LOG2E * z)); }
__device__ __forceinline__ float siluf_(float z) { return z * __builtin_amdgcn_rcpf(1.f + __builtin_amdgcn_exp2f(-LOG2E * z)); }
#define MFMA32(a, b, c) __builtin_amdgcn_mfma_f32_32x32x16_bf16((a), (b), (c), 0, 0, 0)
#define LDS_FENCE() asm volatile("s_waitcnt lgkmcnt(0)" ::: "memory")

namespace pg8 {
typedef unsigned short bf16_t;
constexpr int BM = 256, BK = 64, HALF = 128, HTB = HALF * BK * 2, NXCD = 8, WGM = 8;
__host__ __device__ __forceinline__ int lds_byte(int r, int c) { const int st = (r >> 4) * 2 + (c >> 5), rr = r & 15, cc = c & 31, ob = rr * 64 + cc * 2; return st * 1024 + (ob ^ (((ob >> 9) & 1) << 5)); }
__host__ __device__ __forceinline__ void stage_rc(int b, int& R, int& C) { const int st = b / 1024, sb = b % 1024, swz = sb ^ (((sb >> 9) & 1) << 5); R = (st >> 1) * 16 + swz / 64; C = (st & 1) * 32 + (swz % 64) / 2; }
__host__ __device__ __forceinline__ int perm32(int rho) { const int n = rho >> 4, i = rho & 15; return 8 * (i >> 2) + 4 * n + (i & 3); }
struct Unit { int pm, pn; };
struct Gemm { const bf16_t* A; const bf16_t* Bt; int M, N, K, lda; };
struct StaticOrder {
    int nM, nN, nwg, G, c;
    __device__ void init(int M, int N, int G_, int c_) { nM = M / BM; nN = N / BM; nwg = nM * nN; G = G_; c = c_; }
    __device__ bool next(int i, Unit& u) const {
        const long L = (long)i * G + c; if (L >= nwg) return false;
        int wgid = (int)L; { const int q = nwg / NXCD, r = nwg % NXCD, xcd = wgid % NXCD, off = wgid / NXCD; wgid = (xcd < r ? xcd * (q + 1) : r * (q + 1) + (xcd - r) * q) + off; }
        const int nig = WGM * nN, gid = wgid / nig, fm = gid * WGM, gsz = (nM - fm) < WGM ? (nM - fm) : WGM;
        u.pm = fm + ((wgid % nig) % gsz); u.pn = (wgid % nig) / gsz; return true;
    }
};
struct FixedUnits {
    Unit u0; int n, stride;
    __device__ bool next(int i, Unit& o) const { if (i >= n) return false; o.pm = u0.pm; o.pn = u0.pn + i * stride; return true; }
};
struct EpiBf16 {
    bf16_t* O; int ldc;
    __device__ __forceinline__ void operator()(const f32x4 (&acc)[2][2][4][2], const Unit& u, int wr, int wc, int fr, int fq) const {
        const int row0 = u.pm * BM + wr * 64 + fr, col0 = u.pn * BM + wc * 32 + 8 * fq;
#pragma unroll
        for (int ai = 0; ai < 2; ++ai)
#pragma unroll
            for (int m = 0; m < 4; ++m) { bf16_t* rowp = O + (size_t)(row0 + ai * HALF + m * 16) * ldc + col0;
#pragma unroll
                for (int bj = 0; bj < 2; ++bj) { const f32x4 v0 = acc[ai][bj][m][0], v1 = acc[ai][bj][m][1];
                    u32x4 w; w.x = cvt_pk_bf16(v0[0], v0[1]); w.y = cvt_pk_bf16(v0[2], v0[3]); w.z = cvt_pk_bf16(v1[0], v1[1]); w.w = cvt_pk_bf16(v1[2], v1[3]);
                    *(u32x4*)(rowp + bj * HALF) = w; } }
    }
};
struct EpiMerge {
    bf16_t* Mg; const bf16_t* gl; const float* bg; int first;
    __device__ __forceinline__ void operator()(const f32x4 (&acc)[2][2][4][2], const Unit& u, int wr, int wc, int fr, int fq) const {
        const int row0 = u.pm * BM + wr * 64 + fr, col0 = u.pn * BM + wc * 32 + 8 * fq;
#pragma unroll
        for (int bj = 0; bj < 2; ++bj) {
            const int col = col0 + bj * HALF;
            const f32x4 b0 = *(const f32x4*)(bg + col), b1 = *(const f32x4*)(bg + col + 4);
#pragma unroll
            for (int ai = 0; ai < 2; ++ai)
#pragma unroll
                for (int m = 0; m < 4; ++m) {
                    const size_t row = (size_t)(row0 + ai * HALF + m * 16);
                    const u32x4 g = *(const u32x4*)(gl + row * PAC + col);
                    const f32x4 a0 = acc[ai][bj][m][0], a1 = acc[ai][bj][m][1];
                    float v[8];
                    v[0] = a0[0] * sigmoidf_(bflo(g.x) + b0[0]); v[1] = a0[1] * sigmoidf_(bfhi(g.x) + b0[1]);
                    v[2] = a0[2] * sigmoidf_(bflo(g.y) + b0[2]); v[3] = a0[3] * sigmoidf_(bfhi(g.y) + b0[3]);
                    v[4] = a1[0] * sigmoidf_(bflo(g.z) + b1[0]); v[5] = a1[1] * sigmoidf_(bfhi(g.z) + b1[1]);
                    v[6] = a1[2] * sigmoidf_(bflo(g.w) + b1[2]); v[7] = a1[3] * sigmoidf_(bfhi(g.w) + b1[3]);
                    bf16_t* mp = Mg + row * DM + col;
                    if (!first) { const u32x4 p = *(const u32x4*)mp;
                        v[0] += bflo(p.x); v[1] += bfhi(p.x); v[2] += bflo(p.y); v[3] += bfhi(p.y); v[4] += bflo(p.z); v[5] += bfhi(p.z); v[6] += bflo(p.w); v[7] += bfhi(p.w); }
                    u32x4 w; w.x = cvt_pk_bf16(v[0], v[1]); w.y = cvt_pk_bf16(v[2], v[3]); w.z = cvt_pk_bf16(v[4], v[5]); w.w = cvt_pk_bf16(v[6], v[7]);
                    *(u32x4*)mp = w;
                }
        }
    }
};
struct EpiOut {
    const float* xin; float* out;
    __device__ __forceinline__ void operator()(const f32x4 (&acc)[2][2][4][2], const Unit& u, int wr, int wc, int fr, int fq) const {
        const int row0 = u.pm * BM + wr * 64 + fr, col0 = u.pn * BM + wc * 32 + 8 * fq;
#pragma unroll
        for (int ai = 0; ai < 2; ++ai)
#pragma unroll
            for (int m = 0; m < 4; ++m)
#pragma unroll
                for (int bj = 0; bj < 2; ++bj) {
                    const size_t off = (size_t)(row0 + ai * HALF + m * 16) * DM + col0 + bj * HALF;
                    const f32x4 x0 = *(const f32x4*)(xin + off), x1 = *(const f32x4*)(xin + off + 4);
                    *(f32x4*)(out + off) = x0 + acc[ai][bj][m][0]; *(f32x4*)(out + off + 4) = x1 + acc[ai][bj][m][1];
                }
    }
};

template <class Epi, class Sched>
__device__ __forceinline__ void gemm_phase(LAS unsigned char* lds, const Gemm g, const Sched& S, const Epi& E, const int tid) {
    const int wid = __builtin_amdgcn_readfirstlane(tid >> 6), lane = tid & 63, wr = wid >> 2, wc = wid & 3, fr = lane & 15, fq = lane >> 4;
    const int K = g.K, nt = K / BK, lda = g.lda;
    unsigned voffA[2], voffB[2];
#pragma unroll
    for (int i = 0; i < 2; ++i) { int R, C; stage_rc(tid * 16 + i * 8192, R, C); const int Rb = (R & ~31) + perm32(R & 31);
        voffA[i] = (unsigned)(R * lda + C) * 2u; voffB[i] = (unsigned)(Rb * K + C) * 2u; }
    const size_t kstep = (size_t)(BK * 2);
    const size_t hstepA = (size_t)HALF * lda * 2, hstepB = (size_t)HALF * K * 2;
    const size_t tstepA = 2 * hstepA, tstepB = 2 * hstepB;
    const unsigned ldsw = (unsigned)wid * 1024u;
    const int aoff = lds_byte(wr * 64 + fr, fq * 8), boff = lds_byte(wc * 32 + fr, fq * 8);
#define PG8_SA(b, h) (((b) * 2 + (h)) * HTB)
#define PG8_SB(b, h) ((4 + (b) * 2 + (h)) * HTB)
#define PG8_STAGE(bufoff, gbase, voff) do { _Pragma("unroll") for (int _i = 0; _i < 2; ++_i) \
        __builtin_amdgcn_global_load_lds((const unsigned*)((const char*)(gbase) + (voff)[_i]), (LAS unsigned*)(lds + (bufoff) + ldsw + _i * 8192), 16, 0, 0); } while (0)
#define PG8_LDA(dst, b, h) do { _Pragma("unroll") for (int m = 0; m < 4; ++m) _Pragma("unroll") for (int k = 0; k < 2; ++k) dst[m][k] = *(const LAS bf16x8*)(lds + PG8_SA(b, h) + aoff + m * 2048 + k * 1024); } while (0)
#define PG8_LDB(dst, b, h) do { _Pragma("unroll") for (int n = 0; n < 2; ++n) _Pragma("unroll") for (int k = 0; k < 2; ++k) dst[n][k] = *(const LAS bf16x8*)(lds + PG8_SB(b, h) + boff + n * 2048 + k * 1024); } while (0)
#define PG8_MMA(ai, bj, At, Bt) do { __builtin_amdgcn_s_setprio(1); _Pragma("unroll") for (int m = 0; m < 4; ++m) _Pragma("unroll") for (int n = 0; n < 2; ++n) _Pragma("unroll") for (int k = 0; k < 2; ++k) \
        acc[ai][bj][m][n] = __builtin_amdgcn_mfma_f32_16x16x32_bf16(Bt[n][k], At[m][k], acc[ai][bj][m][n], 0, 0, 0); __builtin_amdgcn_s_setprio(0); } while (0)
#define PG8_WAIT_V(n) asm volatile("s_waitcnt vmcnt(" #n ")" ::: "memory")
#define PG8_WAIT_L(n) asm volatile("s_waitcnt lgkmcnt(" #n ")" ::: "memory")
#define PG8_BAR __builtin_amdgcn_s_barrier()
#define PG8_SCHED __builtin_amdgcn_sched_barrier(0)
    Unit cur, nxt; int ui = 0;
    if (!S.next(0, cur)) return;
    f32x4 acc[2][2][4][2];
#pragma unroll
    for (int a = 0; a < 2; ++a)
#pragma unroll
        for (int b = 0; b < 2; ++b)
#pragma unroll
            for (int m = 0; m < 4; ++m)
#pragma unroll
                for (int n = 0; n < 2; ++n) acc[a][b][m][n] = (f32x4){0.f, 0.f, 0.f, 0.f};
    bf16x8 At[4][2], B0[2][2], B1[2][2];
    const char* cA = (const char*)g.A + (size_t)cur.pm * tstepA; const char* cB = (const char*)g.Bt + (size_t)cur.pn * tstepB;
    PG8_STAGE(PG8_SB(0, 0), cB, voffB); PG8_STAGE(PG8_SB(0, 1), cB + hstepB, voffB); PG8_STAGE(PG8_SA(0, 0), cA, voffA); PG8_STAGE(PG8_SA(0, 1), cA + hstepA, voffA);
    if (wr == 1) PG8_BAR;
    PG8_WAIT_V(2); PG8_BAR;
    PG8_STAGE(PG8_SB(1, 0), cB + kstep, voffB); PG8_STAGE(PG8_SA(1, 0), cA + kstep, voffA); PG8_STAGE(PG8_SB(1, 1), cB + hstepB + kstep, voffB);
    PG8_WAIT_V(6); PG8_BAR;
    for (;;) {
        const bool has_next = S.next(ui + 1, nxt);
        const char* nA = has_next ? (const char*)g.A + (size_t)nxt.pm * tstepA : cA; const char* nB = has_next ? (const char*)g.Bt + (size_t)nxt.pn * tstepB : cB;
        for (int t = 0; t < nt; t += 2) {
            const bool last = (t == nt - 2);
            const char* a1 = cA + (size_t)(t + 1) * kstep;
            const char* a2 = last ? nA : cA + (size_t)(t + 2) * kstep; const char* b2 = last ? nB : cB + (size_t)(t + 2) * kstep;
            const char* a3 = a2 + kstep; const char* b3 = b2 + kstep;
            PG8_LDB(B0, 0, 0); PG8_LDB(B1, 0, 1); PG8_SCHED; PG8_LDA(At, 0, 0); PG8_STAGE(PG8_SA(1, 1), a1 + hstepA, voffA);
            PG8_WAIT_V(8); PG8_WAIT_L(0); PG8_BAR; PG8_MMA(0, 0, At, B0); PG8_MMA(0, 1, At, B1); PG8_BAR; PG8_SCHED;
            PG8_LDA(At, 0, 1); PG8_STAGE(PG8_SB(0, 0), b2, voffB); PG8_STAGE(PG8_SB(0, 1), b2 + hstepB, voffB); PG8_STAGE(PG8_SA(0, 0), a2, voffA);
            PG8_WAIT_V(8); PG8_WAIT_L(0); PG8_BAR; PG8_MMA(1, 0, At, B0); PG8_MMA(1, 1, At, B1); PG8_BAR; PG8_SCHED;
            PG8_LDB(B0, 1, 0); PG8_LDB(B1, 1, 1); PG8_SCHED; PG8_LDA(At, 1, 0); PG8_STAGE(PG8_SA(0, 1), a2 + hstepA, voffA);
            PG8_WAIT_V(8); PG8_WAIT_L(0); PG8_BAR; PG8_MMA(0, 0, At, B0); PG8_MMA(0, 1, At, B1); PG8_BAR; PG8_SCHED;
            PG8_LDA(At, 1, 1); PG8_STAGE(PG8_SB(1, 0), b3, voffB); PG8_STAGE(PG8_SB(1, 1), b3 + hstepB, voffB); PG8_STAGE(PG8_SA(1, 0), a3, voffA);
            PG8_WAIT_V(8); PG8_WAIT_L(0); PG8_BAR; PG8_MMA(1, 0, At, B0); PG8_MMA(1, 1, At, B1); PG8_BAR; PG8_SCHED;
        }
        if (wr == 0) PG8_BAR;
        E(acc, cur, wr, wc, fr, fq);
        if (!has_next) break;
#pragma unroll
        for (int a = 0; a < 2; ++a)
#pragma unroll
            for (int b = 0; b < 2; ++b)
#pragma unroll
                for (int m = 0; m < 4; ++m)
#pragma unroll
                    for (int n = 0; n < 2; ++n) acc[a][b][m][n] = (f32x4){0.f, 0.f, 0.f, 0.f};
        cur = nxt; cA = nA; cB = nB; ++ui;
        if (wr == 1) PG8_BAR;
    }
    PG8_WAIT_V(0);
    PG8_BAR;
#undef PG8_SA
#undef PG8_SB
#undef PG8_STAGE
#undef PG8_LDA
#undef PG8_LDB
#undef PG8_MMA
#undef PG8_WAIT_V
#undef PG8_WAIT_L
#undef PG8_BAR
#undef PG8_SCHED
}
}

struct Frame { LAS unsigned char* lds; int tid, lane, wave, gw, NGW; unsigned char* ws; bf16* PA; };

__device__ __forceinline__ int srcA(int n) {
    if (n < 384) return 384 + n;
    if (n < 768) return 768 + (n - 384);
    if (n < 1024) return 1792 + (n - 768);
    if (n < 1408) return n - 1024;
    if (n < 1792) return 1152 + (n - 1408);
    if (n < 2048) return 1536 + (n - 1792);
    if (n < 2176) return 2048 + (n - 2048);
    if (n < 2432) return 2188 + (n - 2176);
    if (n < 3584) return 2444 + (n - 2432);
    if (n < 3968) return 3602 + (n - 3584);
    if (n < 3980) return 2176 + (n - 3968);
    if (n < 3986) return 3596 + (n - 3980);
    return -1;
}
__device__ __forceinline__ void tr_item(const float* W, int ldw, bf16* WT, int Kd, int k0, int n0, int mode, int off, LAS float* scr, int lane) {
    const int nn = n0 + (lane & 31);
    const int sc = mode == 0 ? srcA(nn) : nn + off;
#pragma unroll 16
    for (int i = 0; i < 32; ++i) { const int kk = 2 * i + (lane >> 5); scr[kk * 33 + (lane & 31)] = sc >= 0 ? W[(size_t)(k0 + kk) * ldw + sc] : 0.f; }
    LDS_FENCE();
    const int c = lane & 7;
#pragma unroll
    for (int j = 0; j < 4; ++j) { const int n = (lane >> 3) + 8 * j; const LAS float* s = scr + (8 * c) * 33 + n;
        u32x4 o; o.x = cvt_pk_bf16(s[0 * 33], s[1 * 33]); o.y = cvt_pk_bf16(s[2 * 33], s[3 * 33]); o.z = cvt_pk_bf16(s[4 * 33], s[5 * 33]); o.w = cvt_pk_bf16(s[6 * 33], s[7 * 33]);
        if (mode == 2) { const int nn2 = n0 + n, kk2 = k0 + 8 * c;
            *(u32x4*)(WT + ((size_t)((nn2 >> 5) * (Kd >> 4) + (kk2 >> 4)) * 64 + ((kk2 >> 3) & 1) * 32 + (nn2 & 31)) * 8) = o; }
        else *(u32x4*)(WT + (size_t)(n0 + n) * Kd + k0 + 8 * c) = o; }
    LDS_FENCE();
}
__device__ __forceinline__ void rms_rows(const Params& P, const Frame& F, int layer, const float* xin, bf16* H) {
    const float* g = P.norm_g + layer * DM;
    for (int m0 = F.gw; m0 < SEQ; m0 += 2 * F.NGW) {
        const int m1 = m0 + F.NGW < SEQ ? m0 + F.NGW : m0;
        const f32x4* xr0 = (const f32x4*)(xin + (size_t)m0 * DM) + F.lane; const f32x4* xr1 = (const f32x4*)(xin + (size_t)m1 * DM) + F.lane;
        f32x4 v0[4], v1[4]; float s0 = 0.f, s1 = 0.f;
#pragma unroll
        for (int j = 0; j < 4; ++j) { v0[j] = xr0[64 * j]; v1[j] = xr1[64 * j]; }
#pragma unroll
        for (int j = 0; j < 4; ++j) { s0 += (v0[j].x * v0[j].x + v0[j].y * v0[j].y) + (v0[j].z * v0[j].z + v0[j].w * v0[j].w); s1 += (v1[j].x * v1[j].x + v1[j].y * v1[j].y) + (v1[j].z * v1[j].z + v1[j].w * v1[j].w); }
        const float r0 = rsqrtf(wave_sum(s0, F.lane) * (1.f / DM) + RMS_EPS), r1 = rsqrtf(wave_sum(s1, F.lane) * (1.f / DM) + RMS_EPS);
        unsigned long long* o0 = (unsigned long long*)(H + (size_t)m0 * DM) + F.lane; unsigned long long* o1 = (unsigned long long*)(H + (size_t)m1 * DM) + F.lane;
#pragma unroll
        for (int j = 0; j < 4; ++j) { const f32x4 gg = ((const f32x4*)g)[F.lane + 64 * j];
            o0[64 * j] = (unsigned long long)cvt_pk_bf16(v0[j].x * r0 * gg.x, v0[j].y * r0 * gg.y) | ((unsigned long long)cvt_pk_bf16(v0[j].z * r0 * gg.z, v0[j].w * r0 * gg.w) << 32);
            o1[64 * j] = (unsigned long long)cvt_pk_bf16(v1[j].x * r1 * gg.x, v1[j].y * r1 * gg.y) | ((unsigned long long)cvt_pk_bf16(v1[j].z * r1 * gg.z, v1[j].w * r1 * gg.w) << 32); }
    }
}
__device__ __forceinline__ void phase0(const Params& P, const Frame& F, int layer, const float* xin) {
    LAS float* scr = (LAS float*)(F.lds + F.wave * 16384);
    unsigned char* ws = F.ws;
    if (F.gw == 0) { unsigned* ctl = (unsigned*)(ws + WS_CTL);
        if (F.lane == 0) { ctl[16 * layer] = 0u; ctl[16 * layer + 8] = 0u; ctl[16 * layer + 4] = 0u; }
        for (int i = F.lane; i < 384; i += 64) ctl[1024 + 16384 * layer + i * 32] = 0u; }
    constexpr int I_A = 16 * 128, I_G = 16 * 96, I_UM = 6 * 32, I_UN = 4 * 32, I_UF = 6 * 32, I_O = 16 * 32, I_1 = 32 * 8, I_2 = 4 * 2;
    constexpr int NIT = I_A + I_G + I_UM + I_UN + I_UF + I_O + 2 * I_1 + 2 * I_2;
    const float* w_in = P.w_in + (size_t)layer * DM * INC;
    for (int it = F.gw; it < NIT; it += F.NGW) {
        int r = it;
        if (r < I_A) { tr_item(w_in, INC, (bf16*)(ws + WS_WA), 1024, 64 * (r / 128), 32 * (r % 128), 0, 0, scr, F.lane); continue; } r -= I_A;
        if (r < I_G) { tr_item(w_in, INC, (bf16*)(ws + WS_WG), 1024, 64 * (r / 96), 32 * (r % 96), 1, 3986, scr, F.lane); continue; } r -= I_G;
        if (r < I_UM) { tr_item(P.w_up_moba + (size_t)layer * 384 * 1024, 1024, (bf16*)(ws + WS_WUPM), 384, 64 * (r / 32), 32 * (r % 32), 1, 0, scr, F.lane); continue; } r -= I_UM;
        if (r < I_UN) { tr_item(P.w_up_nsa + (size_t)layer * 256 * 1024, 1024, (bf16*)(ws + WS_WUPN), 256, 64 * (r / 32), 32 * (r % 32), 1, 0, scr, F.lane); continue; } r -= I_UN;
        if (r < I_UF) { tr_item(P.w_up_fox + (size_t)layer * 384 * 1024, 1024, (bf16*)(ws + WS_WUPF), 384, 64 * (r / 32), 32 * (r % 32), 1, 0, scr, F.lane); continue; } r -= I_UF;
        if (r < I_O) { tr_item(P.w_out + (size_t)layer * 1024 * 1024, 1024, (bf16*)(ws + WS_WO), 1024, 64 * (r / 32), 32 * (r % 32), 1, 0, scr, F.lane); continue; } r -= I_O;
        if (r < 2 * I_1) { const int kv = r / I_1; r %= I_1;
            tr_item(P.cmp_w1 + (size_t)(layer * 2 + kv) * 2048 * 256, 256, (bf16*)(ws + WS_W1T) + (size_t)kv * 256 * 2048, 2048, 64 * (r / 8), 32 * (r % 8), 2, 0, scr, F.lane); continue; } r -= 2 * I_1;
        { const int kv = r / I_2; r %= I_2;
            tr_item(P.cmp_w2 + (size_t)(layer * 2 + kv) * 256 * 64, 64, (bf16*)(ws + WS_W2T) + (size_t)kv * 64 * 256, 256, 64 * (r / 2), 32 * (r % 2), 1, 0, scr, F.lane); }
    }
    rms_rows(P, F, layer, xin, (bf16*)(ws + WS_H));
}

__device__ __forceinline__ void rope_sincos(float pos, int i, float& cs, float& sn) {
    constexpr float INV[8] = {1.0f, 0.1939227432012558f, 0.03760603070259094f, 0.007292664609849453f, 0.0014142135623842478f, 0.00027424818836152554f, 5.3182957344688475e-05f, 1.0313385246263351e-05f};
    const float ang = pos * INV[i];
    double rev = (double)ang * 0.15915494309189535; rev -= floor(rev);
    const float fr = (float)rev;
    sn = __builtin_amdgcn_sinf(fr); cs = __builtin_amdgcn_cosf(fr);
}
__device__ __forceinline__ void norm_load(const bf16* rowp, const float* g, bool rope, int t, float (&v)[64]) {
    float ss = 0.f;
#pragma unroll
    for (int j = 0; j < 8; ++j) { const u32x4 w = ((const u32x4*)rowp)[j];
        v[8 * j + 0] = bflo(w.x); v[8 * j + 1] = bfhi(w.x); v[8 * j + 2] = bflo(w.y); v[8 * j + 3] = bfhi(w.y);
        v[8 * j + 4] = bflo(w.z); v[8 * j + 5] = bfhi(w.z); v[8 * j + 6] = bflo(w.w); v[8 * j + 7] = bfhi(w.w); }
#pragma unroll
    for (int d = 0; d < 64; ++d) ss += v[d] * v[d];
    const float rs = rsqrtf(ss * (1.f / 64.f) + RMS_EPS);
#pragma unroll
    for (int d = 0; d < 64; ++d) v[d] = v[d] * rs * g[d];
    if (rope) {
#pragma unroll
        for (int i = 0; i < 8; ++i) { float cs, sn; rope_sincos((float)t, i, cs, sn); const float a = v[i], b = v[i + 8]; v[i] = a * cs - b * sn; v[i + 8] = b * cs + a * sn; }
    }
}
__device__ __forceinline__ void norm_store(const Frame& F, const float (&v)[64], float osc, bf16* rowp, int kstream, int t) {
    bf16* dst = kstream < 0 ? rowp : (bf16*)(F.ws + WS_KF) + (size_t)kstream * STREAM_ELEMS + ((size_t)(t >> 5) * 256 + (t & 31)) * 8;
#pragma unroll
    for (int j = 0; j < 8; ++j) {
        u32x4 w; w.x = cvt_pk_bf16(v[8 * j] * osc, v[8 * j + 1] * osc); w.y = cvt_pk_bf16(v[8 * j + 2] * osc, v[8 * j + 3] * osc);
        w.z = cvt_pk_bf16(v[8 * j + 4] * osc, v[8 * j + 5] * osc); w.w = cvt_pk_bf16(v[8 * j + 6] * osc, v[8 * j + 7] * osc);
        bf16* p = kstream < 0 ? dst + 8 * j : dst + ((j >> 1) * 64 + (j & 1) * 32) * 8;
        *(u32x4*)p = w;
    }
}
__device__ __forceinline__ void p2_normrow(const Params& P, const Frame& F, int layer, int idx) {
    const int t = idx / 24, slot = idx - t * 24;
    int col, kstream = -1; const float* g; bool rope = true; float osc = 1.f;
    if (slot < 6) { col = C_MQ + slot * 64; g = P.moba_qk_g + layer * 128; osc = C2; }
    else if (slot < 10) { col = C_NQ + (slot - 6) * 64; g = P.nsa_q_g + layer * 64; osc = C2; }
    else if (slot == 10) { col = C_KSL; g = P.nsa_k_g + layer * 192 + 64; kstream = 6; }
    else if (slot == 11) { col = C_KW; g = P.nsa_k_g + layer * 192 + 128; kstream = 7; }
    else if (slot < 18) { col = C_FQ + (slot - 12) * 64; g = P.fox_qk_g + layer * 128; rope = false; osc = C2; }
    else { col = C_FK + (slot - 18) * 64; g = P.fox_qk_g + layer * 128 + 64; rope = false; kstream = 8 + (slot - 18); }
    bf16* rowp = F.PA + (size_t)t * PAC + col;
    float v[64];
    norm_load(rowp, g, rope, t, v);
    norm_store(F, v, osc, rowp, kstream, t);
}
__device__ __forceinline__ void p2_mk_unit(const Params& P, const Frame& F, int layer, int u) {
    const int blk = u / 3, pr = u - blk * 3, head = pr * 2 + (F.tid >> 8), t = blk * 256 + (F.tid & 255);
    bf16* rowp = F.PA + (size_t)t * PAC + C_MK + head * 64;
    float v[64];
    norm_load(rowp, P.moba_qk_g + layer * 128 + 64, true, t, v);
    norm_store(F, v, 1.f, rowp, head, t);
    float mine = 0.f;
#pragma unroll
    for (int d = 0; d < 64; ++d) { const float s = wave_sum(v[d], F.lane); mine = (F.lane == d) ? s : mine; }
    LAS float* part = (LAS float*)F.lds;
    part[F.wave * 64 + F.lane] = mine;
    __syncthreads();
    if (F.tid < 128) { const int hh = F.tid >> 6, d = F.tid & 63;
        const float s = (part[(hh * 4 + 0) * 64 + d] + part[(hh * 4 + 1) * 64 + d]) + (part[(hh * 4 + 2) * 64 + d] + part[(hh * 4 + 3) * 64 + d]);
        ((float*)(F.ws + WS_KMEAN))[((pr * 2 + hh) * 64 + blk) * 64 + d] = s * (1.f / 256.f); }
    __syncthreads();
}
__device__ __forceinline__ void p2_vfrag4(const Frame& F, size_t f0, size_t fstride, size_t fend) {
    unsigned short e[4][8]; size_t dsto[4]; bool ok[4];
#pragma unroll
    for (int q = 0; q < 4; ++q) {
        const size_t f = f0 + (size_t)q * fstride; ok[q] = f < fend; const size_t ff = ok[q] ? f : f0;
        const int st = (int)(ff >> 17); const int r = (int)(ff & 131071);
        const int T = r >> 8, dt = (r >> 7) & 1, s = (r >> 6) & 1, ln = r & 63, c = ln & 31, hg = ln >> 5;
        const int col0 = st < 6 ? C_MV + st * 64 : (st == 6 ? C_VSL : (st == 7 ? C_VW : C_FV + (st - 8) * 64));
        const bf16* src = F.PA + (size_t)(32 * T + 16 * s + 4 * hg) * PAC + col0 + dt * 32 + c;
#pragma unroll
        for (int j = 0; j < 8; ++j) e[q][j] = src[(size_t)((j & 3) + 8 * (j >> 2)) * PAC];
        dsto[q] = (size_t)st * STREAM_ELEMS + (size_t)r * 8;
    }
#pragma unroll
    for (int q = 0; q < 4; ++q) if (ok[q]) {
        u32x4 w; w.x = e[q][0] | ((unsigned)e[q][1] << 16); w.y = e[q][2] | ((unsigned)e[q][3] << 16); w.z = e[q][4] | ((unsigned)e[q][5] << 16); w.w = e[q][6] | ((unsigned)e[q][7] << 16);
        *(u32x4*)((bf16*)(F.ws + WS_VF) + dsto[q]) = w;
    }
}
__device__ __forceinline__ void p2_compress(const Params& P, const Frame& F, int layer, int item) {
    const int kv = item >> 5, T = item & 31, lane = F.lane, c = lane & 31, hg = lane >> 5, w = F.wave;
    const int col0 = C_KC + kv * 64;
    const bf16x8* W1F = (const bf16x8*)((const bf16*)(F.ws + WS_W1T) + (size_t)kv * 256 * 2048) + (size_t)w * 128 * 64 + lane;
    const bf16* W2T = (const bf16*)(F.ws + WS_W2T) + (size_t)kv * 64 * 256;
    LAS float* pel = (LAS float*)(F.lds + 16384);
    { const float* pe = P.cmp_pe + (size_t)(layer * 2 + kv) * 2048; for (int i = F.tid; i < 512; i += 512) ((LAS f32x4*)pel)[i] = ((const f32x4*)pe)[i]; }
    __syncthreads();
    f32x16 acc;
#pragma unroll
    for (int r = 0; r < 16; ++r) acc[r] = 0.f;
    const int blk = 32 * T + c;
    const int rowb = 16 * blk;
#pragma unroll 16
    for (int ks = 0; ks < 128; ++ks) {
        const int pos = ks >> 2, dsub = (ks & 3) * 16;
        int row = rowb + pos; row = row > SEQ - 1 ? SEQ - 1 : row;
        const u32x4 bw = *(const u32x4*)(F.PA + (size_t)row * PAC + col0 + dsub + hg * 8);
        const f32x4 p0 = *(const LAS f32x4*)(pel + ks * 16 + hg * 8), p1 = *(const LAS f32x4*)(pel + ks * 16 + hg * 8 + 4);
        u32x4 bs; bs.x = cvt_pk_bf16(bflo(bw.x) + p0[0], bfhi(bw.x) + p0[1]); bs.y = cvt_pk_bf16(bflo(bw.y) + p0[2], bfhi(bw.y) + p0[3]);
        bs.z = cvt_pk_bf16(bflo(bw.z) + p1[0], bfhi(bw.z) + p1[1]); bs.w = cvt_pk_bf16(bflo(bw.w) + p1[2], bfhi(bw.w) + p1[3]);
        const bf16x8 a = W1F[ks * 64];
        acc = MFMA32(a, __builtin_bit_cast(bf16x8, bs), acc);
    }
    LAS u32x4* hid = (LAS u32x4*)F.lds;
#pragma unroll
    for (int s = 0; s < 2; ++s) {
        float hv[8];
#pragma unroll
        for (int r = 0; r < 8; ++r) hv[r] = siluf_(acc[8 * s + r]);
        u32x4 pw4; pw4.x = cvt_pk_bf16(hv[0], hv[1]); pw4.y = cvt_pk_bf16(hv[2], hv[3]); pw4.z = cvt_pk_bf16(hv[4], hv[5]); pw4.w = cvt_pk_bf16(hv[6], hv[7]);
        hid[(w * 2 + s) * 64 + lane] = pw4;
    }
    __syncthreads();
    if (w == 0) {
        f32x16 o[2];
#pragma unroll
        for (int r = 0; r < 16; ++r) { o[0][r] = 0.f; o[1][r] = 0.f; }
#pragma unroll
        for (int nt = 0; nt < 8; ++nt)
#pragma unroll
            for (int s = 0; s < 2; ++s) {
                const bf16x8 pb = __builtin_bit_cast(bf16x8, hid[(nt * 2 + s) * 64 + lane]);
#pragma unroll
                for (int dt = 0; dt < 2; ++dt) {
                    const bf16* wp = W2T + (size_t)(dt * 32 + c) * 256 + nt * 32 + 16 * s + 4 * hg;
                    const u32x2 lo = *(const u32x2*)wp, hi = *(const u32x2*)(wp + 8);
                    u32x4 aw; aw.x = lo.x; aw.y = lo.y; aw.z = hi.x; aw.w = hi.y;
                    o[dt] = MFMA32(__builtin_bit_cast(bf16x8, aw), pb, o[dt]);
                }
            }
        if (kv == 0) {
            const float* g = P.nsa_k_g + layer * 192;
            float ss = 0.f;
#pragma unroll
            for (int dt = 0; dt < 2; ++dt)
#pragma unroll
                for (int r = 0; r < 16; ++r) ss += o[dt][r] * o[dt][r];
            ss += shx(ss, 32, lane);
            const float rs = rsqrtf(ss * (1.f / 64.f) + RMS_EPS);
#pragma unroll
            for (int dt = 0; dt < 2; ++dt)
#pragma unroll
                for (int r = 0; r < 16; ++r) o[dt][r] = o[dt][r] * rs * g[dt * 32 + crow(r, hg)];
            const float pos = (float)(16 * blk + 31);
#pragma unroll
            for (int r = 0; r < 4; ++r) {
                float c0, s0, c1, s1; rope_sincos(pos, r, c0, s0); rope_sincos(pos, r + 4, c1, s1);
                const float cs = hg ? c1 : c0, sn = hg ? s1 : s0;
                const float a = o[0][r], b = o[0][r + 4]; o[0][r] = a * cs - b * sn; o[0][r + 4] = b * cs + a * sn;
            }
            bf16* KC = (bf16*)(F.ws + WS_KCMP);
#pragma unroll
            for (int dt = 0; dt < 2; ++dt)
#pragma unroll
                for (int gq = 0; gq < 4; ++gq) {
                    const int ks = dt * 2 + (gq >> 1), hgp = gq & 1;
                    u32x2 wv; wv.x = cvt_pk_bf16(o[dt][4 * gq], o[dt][4 * gq + 1]); wv.y = cvt_pk_bf16(o[dt][4 * gq + 2], o[dt][4 * gq + 3]);
                    *(u32x2*)(KC + ((size_t)(T * 4 + ks) * 64 + hgp * 32 + c) * 8 + 4 * hg) = wv;
                }
        } else {
            bf16* VC = (bf16*)(F.ws + WS_VCMP);
            const int s = c >> 4, hgp = (c >> 2) & 1, j = ((c >> 3) & 1) * 4 + (c & 3);
#pragma unroll
            for (int dt = 0; dt < 2; ++dt)
#pragma unroll
                for (int r = 0; r < 16; ++r)
                    VC[((size_t)((T * 2 + dt) * 2 + s) * 64 + hgp * 32 + crow(r, hg)) * 8 + j] = f2bf(o[dt][r]);
        }
    }
    __syncthreads();
}
#ifdef PROBE_P2PART
#define P2T(i) do { if (PROBE_P2PART == (i)) { const unsigned long long _t = __builtin_amdgcn_s_memrealtime(); if ((F.gw >> 3) == PROBE_P2BLK && F.tid == 0) p2acc += (long long)(_t); } } while (0)
#define P2T0(i) do { if (PROBE_P2PART == (i)) { const unsigned long long _t = __builtin_amdgcn_s_memrealtime(); if ((F.gw >> 3) == PROBE_P2BLK && F.tid == 0) p2acc -= (long long)(_t); } } while (0)
#else
#define P2T(i) do {} while (0)
#define P2T0(i) do {} while (0)
#endif
__device__ __forceinline__ void phase2(const Params& P, const Frame& F, int layer, long long& p2acc) {
    const int G = F.NGW >> 3, bxv = F.gw >> 3;
    const bool split = G >= 128;
    if (bxv < 64) { p2_compress(P, F, layer, bxv); if (split) return; }
    if (!split && G < 64) { for (int u = bxv + G; u < 64; u += G) p2_compress(P, F, layer, u); }
    const int vgw = split ? F.gw - 512 : F.gw, VN = split ? F.NGW - 512 : F.NGW, vbx = split ? bxv - 64 : bxv, VG = split ? G - 64 : G;
    for (int it = vgw; it < 6 * 256; it += VN) {
        const int h = it >> 8, ch = it & 255, t = ch * 64 + F.lane;
        const float z = bf2f(F.PA[(size_t)t * PAC + C_FF + h]) + P.b_f[layer * 6 + h];
        float v = (fminf(z, 0.f) - log1pf(__expf(-fabsf(z)))) * LOG2E;
#pragma unroll
        for (int o = 1; o < 64; o <<= 1) { const float y = shfrom(v, (F.lane - o) & 63); if (F.lane >= o) v += y; }
        ((float*)(F.ws + WS_CS))[h * SEQ + t] = v;
        if (F.lane == 63) ((float*)(F.ws + WS_CSTOT))[h * 256 + ch] = v;
    }
    for (int u = vbx; u < 192; u += VG) p2_mk_unit(P, F, layer, u);
    for (int it = vgw; it < SEQ * 24 / 64; it += VN) p2_normrow(P, F, layer, it * 64 + F.lane);
    for (int it = vgw; it < 14 * 131072 / 64; it += 4 * VN) p2_vfrag4(F, (size_t)it * 64 + F.lane, (size_t)VN * 64, (size_t)14 * 131072);
    (void)p2acc;
}

__device__ __forceinline__ int list_off(int j) { return 256 * (63 * j - (j * (j - 1)) / 2); }
constexpr int LIST_HEAD = 256 * 2016;
__device__ __forceinline__ void p3_unit(const Params& P, const Frame& F, int layer, int kind, int uidx) {
    if (kind == 0) for (int it = uidx * 8 + F.wave; it < uidx * 8 + 8; it += 8) {
        const int h = it >> 8, ch = it & 255;
        const float* tot = (const float*)(F.ws + WS_CSTOT) + h * 256;
        float s = 0.f;
        for (int cc = F.lane; cc < ch; cc += 64) s += tot[cc];
        s = wave_sum(s, F.lane);
        float* cs = (float*)(F.ws + WS_CS) + h * SEQ + ch * 64 + F.lane;
        *cs = *cs + s;
    }
    unsigned* cnt = (unsigned*)(F.ws + WS_CTL) + 1024 + 16384 * layer;
    unsigned short* LIST = (unsigned short*)(F.ws + WS_LIST);
    LAS float* kml = (LAS float*)F.lds;
    if (kind == 1) for (int u = uidx; u < uidx + 1; ++u) {
        const int h = u >> 5, t = (u & 31) * 512 + F.tid, cur = t >> 8, nb = (((u & 31) * 512 + 511) >> 8);
        const float* km = (const float*)(F.ws + WS_KMEAN) + (size_t)h * 64 * 64;
        LAS unsigned* lcnt = (LAS unsigned*)(F.lds + 32768); LAS unsigned* lbase = lcnt + 64;
        for (int i = F.tid; i < nb * 16; i += 512) ((LAS f32x4*)kml)[i] = ((const f32x4*)km)[i];
        if (F.tid < 64) lcnt[F.tid] = 0u;
        __syncthreads();
        int i1 = -1, i2 = -1, i3 = -1; unsigned p1 = 0, p2 = 0, p3 = 0;
        if (cur > 0) {
            const bf16* qrow = F.PA + (size_t)t * PAC + C_MQ + h * 64;
            float qv[64];
#pragma unroll
            for (int j = 0; j < 8; ++j) { const u32x4 w = ((const u32x4*)qrow)[j];
                qv[8 * j + 0] = bflo(w.x); qv[8 * j + 1] = bfhi(w.x); qv[8 * j + 2] = bflo(w.y); qv[8 * j + 3] = bfhi(w.y);
                qv[8 * j + 4] = bflo(w.z); qv[8 * j + 5] = bfhi(w.z); qv[8 * j + 6] = bflo(w.w); qv[8 * j + 7] = bfhi(w.w); }
            float v1 = -3e38f, v2 = -3e38f, v3 = -3e38f;
            for (int j = 0; j < cur; ++j) {
                float g0 = 0.f, g1 = 0.f;
#pragma unroll
                for (int d4 = 0; d4 < 16; ++d4) { const f32x4 k4 = ((const LAS f32x4*)kml)[j * 16 + d4];
                    g0 += qv[4 * d4] * k4[0]; g1 += qv[4 * d4 + 1] * k4[1]; g0 += qv[4 * d4 + 2] * k4[2]; g1 += qv[4 * d4 + 3] * k4[3]; }
                const float g = g0 + g1;
                if (g > v3) { if (g > v2) { v3 = v2; i3 = i2; if (g > v1) { v2 = v1; i2 = i1; v1 = g; i1 = j; } else { v2 = g; i2 = j; } } else { v3 = g; i3 = j; } }
            }
            if (i1 >= 0) p1 = __hip_atomic_fetch_add(lcnt + i1, 1u, __ATOMIC_RELAXED, __HIP_MEMORY_SCOPE_WORKGROUP);
            if (i2 >= 0) p2 = __hip_atomic_fetch_add(lcnt + i2, 1u, __ATOMIC_RELAXED, __HIP_MEMORY_SCOPE_WORKGROUP);
            if (i3 >= 0) p3 = __hip_atomic_fetch_add(lcnt + i3, 1u, __ATOMIC_RELAXED, __HIP_MEMORY_SCOPE_WORKGROUP);
        }
        __syncthreads();
        if (F.tid < 64) { const unsigned c = lcnt[F.tid]; lbase[F.tid] = c ? __hip_atomic_fetch_add(cnt + (h * 64 + F.tid) * 32, c, __ATOMIC_RELAXED, __HIP_MEMORY_SCOPE_AGENT) : 0u; }
        __syncthreads();
        if (i1 >= 0) LIST[(size_t)h * LIST_HEAD + list_off(i1) + lbase[i1] + p1] = (unsigned short)((t << 2) | 0);
        if (i2 >= 0) LIST[(size_t)h * LIST_HEAD + list_off(i2) + lbase[i2] + p2] = (unsigned short)((t << 2) | 1);
        if (i3 >= 0) LIST[(size_t)h * LIST_HEAD + list_off(i3) + lbase[i3] + p3] = (unsigned short)((t << 2) | 2);
        __syncthreads();
    }
}

constexpr int RING_OFF = 65536;
__device__ __forceinline__ f32x16 qk_lds(LAS unsigned char* buf, const bf16x8 (&qf)[4], int lane, float init = 0.f) {
    const LAS bf16x8* p = (const LAS bf16x8*)buf + lane;
    f32x16 s;
#pragma unroll
    for (int r = 0; r < 16; ++r) s[r] = init;
    const bf16x8 k0 = p[0], k1 = p[64], k2 = p[128], k3 = p[192];
    __builtin_amdgcn_s_setprio(1);
    s = MFMA32(k0, qf[0], s); s = MFMA32(k1, qf[1], s); s = MFMA32(k2, qf[2], s); s = MFMA32(k3, qf[3], s);
    __builtin_amdgcn_s_setprio(0);
    return s;
}
__device__ __forceinline__ void pv_lds(LAS unsigned char* buf, const float (&e)[16], f32x16 (&o)[2], int lane) {
    const LAS bf16x8* p = (const LAS bf16x8*)(buf + 4096) + lane;
    u32x4 w0, w1;
    w0.x = cvt_pk_bf16(e[0], e[1]); w0.y = cvt_pk_bf16(e[2], e[3]); w0.z = cvt_pk_bf16(e[4], e[5]); w0.w = cvt_pk_bf16(e[6], e[7]);
    w1.x = cvt_pk_bf16(e[8], e[9]); w1.y = cvt_pk_bf16(e[10], e[11]); w1.z = cvt_pk_bf16(e[12], e[13]); w1.w = cvt_pk_bf16(e[14], e[15]);
    const bf16x8 pb0 = __builtin_bit_cast(bf16x8, w0), pb1 = __builtin_bit_cast(bf16x8, w1);
    const bf16x8 v0 = p[0], v1 = p[64], v2 = p[128], v3 = p[192];
    __builtin_amdgcn_s_setprio(1);
    o[0] = MFMA32(v0, pb0, o[0]); o[1] = MFMA32(v2, pb0, o[1]); o[0] = MFMA32(v1, pb1, o[0]); o[1] = MFMA32(v3, pb1, o[1]);
    __builtin_amdgcn_s_setprio(0);
}
__device__ __forceinline__ float gain_bound(const float* gq, const float* gk, int lane) {
    const float a = wave_max(fabsf(gq[lane]), lane), b = wave_max(fabsf(gk[lane]), lane);
    return (8.f * a * b * 1.02f + 0.05f) * LOG2E;
}
__device__ __forceinline__ void write_gated(const Frame& F, const f32x16 (&o)[2], float scale, int t, int ocol, int zcol, int hg) {
    bf16* rowp = F.PA + (size_t)t * PAC;
#pragma unroll
    for (int dt = 0; dt < 2; ++dt)
#pragma unroll
        for (int g = 0; g < 4; ++g) {
            const int d0 = dt * 32 + 8 * g + 4 * hg;
            const u32x2 z = *(const u32x2*)(rowp + zcol + d0);
            u32x2 w;
            w.x = cvt_pk_bf16(o[dt][4 * g] * scale * siluf_(bflo(z.x)), o[dt][4 * g + 1] * scale * siluf_(bfhi(z.x)));
            w.y = cvt_pk_bf16(o[dt][4 * g + 2] * scale * siluf_(bflo(z.y)), o[dt][4 * g + 3] * scale * siluf_(bfhi(z.y)));
            *(u32x2*)(rowp + ocol + d0) = w;
        }
}
#define ZERO_O(o) do { _Pragma("unroll") for (int _r = 0; _r < 16; ++_r) { o[0][_r] = 0.f; o[1][_r] = 0.f; } } while (0)
__device__ __forceinline__ void glds16(const void* gsrc, unsigned lds_dst) { unsigned keep;
    asm volatile("s_mov_b32 %0, m0\n\ts_mov_b32 m0, %2\n\ts_nop 0\n\tglobal_load_lds_dwordx4 %1, off\n\ts_mov_b32 m0, %0" : "=&s"(keep) : "v"(gsrc), "s"(lds_dst) : "memory"); }
__device__ __forceinline__ unsigned lds_addr(LAS unsigned char* p) { return (unsigned)(size_t)p; }
#define SBAR() do { asm volatile("" ::: "memory"); __builtin_amdgcn_s_barrier(); asm volatile("" ::: "memory"); } while (0)
#define VMW(n) asm volatile("s_waitcnt vmcnt(" #n ")" ::: "memory")
#define DMA2(p) do { _Pragma("unroll") for (int _q = 0; _q < 2; ++_q) \
    glds16(_src + (ptrdiff_t)(2 * (p) + _q) * _st, (unsigned)__builtin_amdgcn_readfirstlane(_ringa + (unsigned)((((p) & 3) * 2 + _q) * 8192) + _wo)); } while (0)
#define STREAM_BEGIN(KFp, VFp, TFIRST, STEP, NTILES) { \
    const int _nt = (NTILES), _n = (_nt + 1) >> 1; \
    const char* _src = (const char*)((F.wave < 4) ? (KFp) : (VFp)) + (ptrdiff_t)(TFIRST) * 4096 + (F.wave & 3) * 1024 + F.lane * 16; \
    const ptrdiff_t _st = (ptrdiff_t)(STEP) * 4096; \
    LAS unsigned char* _ring = F.lds + RING_OFF; const unsigned _wo = (unsigned)F.wave * 1024u; const unsigned _ringa = lds_addr(_ring); \
    asm volatile("s_waitcnt vmcnt(0) lgkmcnt(0)" ::: "memory"); SBAR(); \
    if (_n > 0) DMA2(0); if (_n > 1) DMA2(1); if (_n > 2) DMA2(2); \
    for (int _i = 0; _i < _n; ++_i) { \
        if (_i + 2 < _n) VMW(4); else if (_i + 1 < _n) VMW(2); else VMW(0); \
        asm volatile("s_waitcnt lgkmcnt(0)" ::: "memory"); SBAR(); \
        if (_i + 3 < _n) DMA2(_i + 3); \
        _Pragma("unroll") for (int _s = 0; _s < 2; ++_s) { \
            const int T = (TFIRST) + (2 * _i + _s) * (STEP); LAS unsigned char* _buf = _ring + ((_i & 3) * 2 + _s) * 8192; \
            if (2 * _i + _s < _nt) {
#define STREAM_END } } } asm volatile("s_waitcnt vmcnt(0) lgkmcnt(0)" ::: "memory"); SBAR(); }
#define STREAM2_BEGIN(KFp, VFp, TFIRST, STEP, NTILES) { \
    const int _nt = (NTILES), _n = (_nt + 1) >> 1; \
    const char* _src = (const char*)((F.wave < 4) ? (KFp) : (VFp)) + (ptrdiff_t)(TFIRST) * 4096 + (F.wave & 3) * 1024 + F.lane * 16; \
    const ptrdiff_t _st = (ptrdiff_t)(STEP) * 4096; \
    LAS unsigned char* _ring = F.lds + RING_OFF; const unsigned _wo = (unsigned)F.wave * 1024u; const unsigned _ringa = lds_addr(_ring); \
    asm volatile("s_waitcnt vmcnt(0) lgkmcnt(0)" ::: "memory"); SBAR(); \
    if (_n > 0) DMA2(0); if (_n > 1) DMA2(1); if (_n > 2) DMA2(2); \
    for (int _i = 0; _i < _n; ++_i) { \
        if (_i + 2 < _n) VMW(4); else if (_i + 1 < _n) VMW(2); else VMW(0); \
        asm volatile("s_waitcnt lgkmcnt(0)" ::: "memory"); SBAR(); \
        if (_i + 3 < _n) DMA2(_i + 3); \
        const int T0 = (TFIRST) + (2 * _i) * (STEP), T1 = T0 + (STEP); const bool _v0 = true, _v1 = (2 * _i + 1 < _nt); \
        LAS unsigned char* _b0 = _ring + ((_i & 3) * 2) * 8192; LAS unsigned char* _b1 = _b0 + 8192;
#define STREAM2_END } asm volatile("s_waitcnt vmcnt(0) lgkmcnt(0)" ::: "memory"); SBAR(); }
template <class EF>
__device__ __forceinline__ void do_pair(bool ok0, bool ok1, LAS unsigned char* b0, LAS unsigned char* b1, int T0, int T1, const bf16x8 (&qf)[4], f32x16 (&o)[2], float& l, int lane, float nsh, EF ef) {
    if (ok0 && ok1) {
        const f32x16 s0 = qk_lds(b0, qf, lane, nsh), s1 = qk_lds(b1, qf, lane, nsh);
        float e0[16], e1[16];
#pragma unroll
        for (int r = 0; r < 16; ++r) { e0[r] = ef(T0, r, s0[r]); e1[r] = ef(T1, r, s1[r]); l += e0[r] + e1[r]; }
        pv_lds(b0, e0, o, lane); pv_lds(b1, e1, o, lane);
    } else if (ok0 || ok1) {
        LAS unsigned char* b = ok0 ? b0 : b1; const int T = ok0 ? T0 : T1;
        const f32x16 s = qk_lds(b, qf, lane, nsh);
        float e[16];
#pragma unroll
        for (int r = 0; r < 16; ++r) { e[r] = ef(T, r, s[r]); l += e[r]; }
        pv_lds(b, e, o, lane);
    }
}

__device__ __forceinline__ int first_keep(const float* cs, float cs0, float lim, int Tmax, int lane) {
    const int c1 = lane * 8;
    const bool k1 = c1 >= Tmax ? true : (cs0 - cs[32 * c1 + 31] >= lim);
    const unsigned long long b1 = __ballot(k1);
    const int f1 = b1 ? __builtin_ctzll(b1) : 64;
    if (f1 == 0) return 0;
    const int base = 8 * (f1 - 1) + 1, c2 = base + lane;
    const bool k2 = lane < 8 ? (c2 >= Tmax ? true : (cs0 - cs[32 * c2 + 31] >= lim)) : false;
    const unsigned long long b2 = __ballot(k2);
    const int r = base + (b2 ? __builtin_ctzll(b2) : 7);
    return r < Tmax ? r : Tmax;
}
__device__ __forceinline__ void wg_fox(const Params& P, const Frame& F, int layer, int h, int qb) {
    const int lane = F.lane, c = lane & 31, hg = lane >> 5, w = F.wave, t0 = qb * 256 + 32 * w, t = t0 + c;
    const float SH = gain_bound(P.fox_qk_g + layer * 128, P.fox_qk_g + layer * 128 + 64, lane);
    const float* cs = (const float*)(F.ws + WS_CS) + (size_t)h * SEQ;
    const bf16* qrow = F.PA + (size_t)t * PAC + C_FQ + h * 64;
    bf16x8 qf[4];
#pragma unroll
    for (int ks = 0; ks < 4; ++ks) qf[ks] = *(const bf16x8*)(qrow + ks * 16 + hg * 8);
    const float cq = cs[t];
    const float lim = -(2.f * SH + 40.f);
    const int Thw = qb * 8 + w, THI = qb * 8 + 7;
    int low = first_keep(cs, cs[t0], lim, Thw, lane), LO = first_keep(cs, cs[qb * 256], lim, qb * 8, lane);
    low = __builtin_amdgcn_readfirstlane(low); LO = __builtin_amdgcn_readfirstlane(LO);
    const bf16* KF = (const bf16*)(F.ws + WS_KF) + (size_t)(8 + h) * STREAM_ELEMS;
    const bf16* VF = (const bf16*)(F.ws + WS_VF) + (size_t)(8 + h) * STREAM_ELEMS;
    f32x16 o[2]; ZERO_O(o); float l = 0.f;
    const int LOp = LO > 0 ? LO - 1 : 0, kbase = 32 * LOp, ncs = (THI - LOp + 1) * 32;
    LAS float* csl = (LAS float*)F.lds;
    for (int i = F.tid; i < ncs; i += 512) csl[i] = cs[kbase + i];
    STREAM2_BEGIN(KF, VF, THI, -1, THI - LO + 1)
        do_pair(_v0 && T0 <= Thw && T0 >= low, _v1 && T1 <= Thw && T1 >= low, _b0, _b1, T0, T1, qf, o, l, lane, -SH,
                [=](int T, int r, float sv) { const int key = 32 * T + crow(r, hg); const float ck = csl[key - kbase];
                    return key <= t ? __builtin_amdgcn_exp2f(sv + (cq - ck)) : 0.f; });
    STREAM2_END
    l += shx(l, 32, lane);
    write_gated(F, o, l > 0.f ? 1.f / l : 0.f, t, C_OF + h * 64, C_FZ + h * 64, hg);
}

__device__ __forceinline__ void moba_load_block(const Frame& F, int h, int j) {
    const bf16* src = (const bf16*)(F.ws + (F.tid < 256 ? WS_KF : WS_VF)) + (size_t)h * STREAM_ELEMS + (size_t)(j * 8) * 2048 + (F.tid & 255) * 8;
    u32x4 r[8];
#pragma unroll
    for (int tt = 0; tt < 8; ++tt) r[tt] = *(const u32x4*)(src + tt * 2048);
#pragma unroll
    for (int tt = 0; tt < 8; ++tt) *(LAS u32x4*)(F.lds + RING_OFF + tt * 8192 + F.tid * 16) = r[tt];
    __syncthreads();
}
__device__ __forceinline__ bf16* moba_part(const Frame& F, int h, int t, int slot) {
    return slot == 0 ? F.PA + (size_t)t * PAC + C_FK + h * 64 : (slot == 1 ? F.PA + (size_t)t * PAC + C_FV + h * 64 : (bf16*)(F.ws + WS_P2) + ((size_t)h * SEQ + t) * 64);
}
__device__ __forceinline__ void wg_moba_own(const Params& P, const Frame& F, int layer, int h, int blk) {
    const int lane = F.lane, c = lane & 31, hg = lane >> 5, w = F.wave, t0 = blk * 256 + 32 * w, t = t0 + c;
    const float SH = gain_bound(P.moba_qk_g + layer * 128, P.moba_qk_g + layer * 128 + 64, lane);
    const bf16* qrow = F.PA + (size_t)t * PAC + C_MQ + h * 64;
    bf16x8 qf[4];
#pragma unroll
    for (int ks = 0; ks < 4; ++ks) qf[ks] = *(const bf16x8*)(qrow + ks * 16 + hg * 8);
    moba_load_block(F, h, blk);
    f32x16 o[2]; ZERO_O(o); float l = 0.f;
    for (int tp = 0; 2 * tp <= w; ++tp) {
        LAS unsigned char* b0 = F.lds + RING_OFF + (2 * tp) * 8192;
        do_pair(true, 2 * tp + 1 <= w, b0, b0 + 8192, blk * 8 + 2 * tp, blk * 8 + 2 * tp + 1, qf, o, l, lane, -SH,
                [=](int T, int r, float sv) { const int key = 32 * T + crow(r, hg); return key <= t ? __builtin_amdgcn_exp2f(sv) : 0.f; });
    }
    l += shx(l, 32, lane);
    bf16* rowp = F.PA + (size_t)t * PAC + C_OM + h * 64;
#pragma unroll
    for (int dt = 0; dt < 2; ++dt)
#pragma unroll
        for (int g = 0; g < 4; ++g) { u32x2 wv; wv.x = cvt_pk_bf16(o[dt][4 * g], o[dt][4 * g + 1]); wv.y = cvt_pk_bf16(o[dt][4 * g + 2], o[dt][4 * g + 3]);
            *(u32x2*)(rowp + dt * 32 + 8 * g + 4 * hg) = wv; }
    if (hg == 0) ((float*)(F.ws + WS_LOWN))[h * SEQ + t] = l;
    __syncthreads();
}
__device__ __forceinline__ void wg_moba_sel(const Params& P, const Frame& F, int layer, int h, int j) {
    const int lane = F.lane, c = lane & 31, hg = lane >> 5, w = F.wave;
    const int n = (int)((const unsigned*)(F.ws + WS_CTL))[1024 + 16384 * layer + (h * 64 + j) * 32];
    if (n == 0) return;
    const float SH = gain_bound(P.moba_qk_g + layer * 128, P.moba_qk_g + layer * 128 + 64, lane);
    moba_load_block(F, h, j);
    const unsigned short* list = (const unsigned short*)(F.ws + WS_LIST) + (size_t)h * LIST_HEAD + list_off(j);
    float* LPART = (float*)(F.ws + WS_LPART);
    bool valid = false; unsigned ent = 0u; bf16x8 qf[4];
    if (w * 32 < n) { const int i = w * 32 + c; valid = i < n; ent = list[valid ? i : w * 32];
        const bf16* qrow = F.PA + (size_t)(ent >> 2) * PAC + C_MQ + h * 64;
#pragma unroll
        for (int ks = 0; ks < 4; ++ks) qf[ks] = *(const bf16x8*)(qrow + ks * 16 + hg * 8); }
    for (int cb = w * 32; cb < n; cb += 256) {
        const int cbn = cb + 256; bool validn = false; unsigned entn = 0u; bf16x8 qfn[4];
        if (cbn < n) { const int in = cbn + c; validn = in < n; entn = list[validn ? in : cbn];
            const bf16* qrn = F.PA + (size_t)(entn >> 2) * PAC + C_MQ + h * 64;
#pragma unroll
            for (int ks = 0; ks < 4; ++ks) qfn[ks] = *(const bf16x8*)(qrn + ks * 16 + hg * 8); }
        const int t = (int)(ent >> 2), slot = (int)(ent & 3u);
        f32x16 o[2]; ZERO_O(o); float l = 0.f;
        for (int tp = 0; tp < 4; ++tp) {
            LAS unsigned char* b0 = F.lds + RING_OFF + (2 * tp) * 8192;
            do_pair(true, true, b0, b0 + 8192, 0, 0, qf, o, l, lane, -SH, [=](int, int, float sv) { return __builtin_amdgcn_exp2f(sv); });
        }
        l += shx(l, 32, lane);
        if (valid) {
            const size_t rec = ((size_t)h * SEQ + t) * 3 + slot;
            bf16* pp = moba_part(F, h, t, slot);
#pragma unroll
            for (int dt = 0; dt < 2; ++dt)
#pragma unroll
                for (int g = 0; g < 4; ++g) { u32x2 wv; wv.x = cvt_pk_bf16(o[dt][4 * g], o[dt][4 * g + 1]); wv.y = cvt_pk_bf16(o[dt][4 * g + 2], o[dt][4 * g + 3]);
                    *(u32x2*)(pp + dt * 32 + 8 * g + 4 * hg) = wv; }
            if (hg == 0) LPART[rec] = l;
        }
        valid = validn; ent = entn;
#pragma unroll
        for (int ks = 0; ks < 4; ++ks) qf[ks] = qfn[ks];
    }
    __syncthreads();
}

__device__ __forceinline__ void wg_nsa(const Params& P, const Frame& F, int layer, int qb) {
    const int lane = F.lane, c = lane & 31, hg = lane >> 5, w = F.wave, qi = c >> 2, h = c & 3, t0 = qb * 64 + 8 * w, t = t0 + qi, cur = qb;
    const float* kg = P.nsa_k_g + layer * 192; const float* qg = P.nsa_q_g + layer * 64;
    const float SHc = gain_bound(qg, kg, lane), SHs = gain_bound(qg, kg + 64, lane), SHw = gain_bound(qg, kg + 128, lane);
    const bf16* prow = F.PA + (size_t)t * PAC;
    bf16x8 qf[4];
#pragma unroll
    for (int ks = 0; ks < 4; ++ks) qf[ks] = *(const bf16x8*)(prow + C_NQ + h * 64 + ks * 16 + hg * 8);
    const float g0 = sigmoidf_(bf2f(prow[C_NG + h * 3 + 0])), g1 = sigmoidf_(bf2f(prow[C_NG + h * 3 + 1])), g2 = sigmoidf_(bf2f(prow[C_NG + h * 3 + 2]));
    LAS float* imp = (LAS float*)(F.lds + w * 8192);
    f32x16 accF[2]; ZERO_O(accF);
    f32x16 o[2]; float l;
    const int ntw = (t0 + 7 >= 31) ? (((t0 + 7 - 31) >> 4) >> 5) + 1 : 0;
    const int NT = (qb * 64 + 63 >= 31) ? (((qb * 64 + 63 - 31) >> 4) >> 5) + 1 : 0;
    const bf16* KC = (const bf16*)(F.ws + WS_KCMP); const bf16* VC = (const bf16*)(F.ws + WS_VCMP);
    ZERO_O(o); l = 0.f;
    STREAM2_BEGIN(KC, VC, 0, 1, NT)
        do_pair(_v0 && T0 < ntw, _v1 && T1 < ntw, _b0, _b1, T0, T1, qf, o, l, lane, -SHc,
                [=](int T, int r, float sv) { const int n = 32 * T + crow(r, hg); return (16 * n + 31 <= t) ? __builtin_amdgcn_exp2f(sv) : 0.f; });
    STREAM2_END
    l += shx(l, 32, lane);
    const float invc = l > 0.f ? 1.f / l : 0.f;
    {
        const float sc = g0 * invc;
#pragma unroll
        for (int r = 0; r < 16; ++r) { accF[0][r] += sc * o[0][r]; accF[1][r] += sc * o[1][r]; }
    }
    {
        float prevEx = 0.f;
        STREAM_BEGIN(KC, VC, 0, 1, NT)
            if (T < ntw) {
                const f32x16 s = qk_lds(_buf, qf, lane);
#pragma unroll
                for (int g = 0; g < 4; ++g) {
                    float s4 = 0.f, ed = 0.f;
#pragma unroll
                    for (int k = 0; k < 4; ++k) { const int r = 4 * g + k; const int n = 32 * T + crow(r, hg);
                        const float p = (16 * n + 31 <= t) ? __builtin_amdgcn_exp2f(s[r] - SHc) * invc : 0.f; s4 += p; if (k == 3) ed = p; }
                    s4 += dpp_x1(s4); s4 += dpp_x2(s4); ed += dpp_x1(ed); ed += dpp_x2(ed);
                    const float Ex = shx(ed, 32, lane);
                    const float Sp = s4 + (hg ? Ex : prevEx); prevEx = Ex;
                    if (h == 0) imp[qi * 256 + 8 * T + 2 * g + hg] = Sp;
                }
            }
        STREAM_END
    }
    unsigned long long my0 = 0ull, my1 = 0ull, my2 = 0ull, my3 = 0ull, un0 = 0ull, un1 = 0ull, un2 = 0ull, un3 = 0ull;
    {
        const int qs = lane >> 3, sub = lane & 7;
        float val[32];
#pragma unroll
        for (int k = 0; k < 32; ++k) { const int m = sub + 8 * k;
            const float iv = imp[qs * 256 + m];
            val[k] = (m > cur) ? -3e38f : ((m == 0 || m == cur || m == cur - 1) ? 3e38f : iv); }
        const int nsel = cur + 1 < 16 ? cur + 1 : 16;
        for (int rd = 0; rd < nsel; ++rd) {
            float bv = val[0]; int bk = 0;
#pragma unroll
            for (int k = 1; k < 32; ++k) if (val[k] > bv) { bv = val[k]; bk = k; }
            int bm = sub + 8 * bk;
#pragma unroll
            for (int of = 1; of < 8; of <<= 1) { const float ov = shx(bv, of, lane); const int om = shxi(bm, of, lane);
                if (ov > bv || (ov == bv && om < bm)) { bv = ov; bm = om; } }
#pragma unroll
            for (int k = 0; k < 32; ++k) if (sub + 8 * k == bm) val[k] = -3e38f;
            const int wa = shfromi(bm, (c >> 2) * 8);
            { const unsigned long long bit = 1ull << (wa & 63); const int kk = wa >> 6;
              my0 |= kk == 0 ? bit : 0ull; my1 |= kk == 1 ? bit : 0ull; my2 |= kk == 2 ? bit : 0ull; my3 |= kk == 3 ? bit : 0ull; }
#pragma unroll
            for (int q = 0; q < 8; ++q) { const int wq = __builtin_amdgcn_readlane(bm, q * 8); const unsigned long long bit = 1ull << (wq & 63); const int kk = wq >> 6;
                un0 |= kk == 0 ? bit : 0ull; un1 |= kk == 1 ? bit : 0ull; un2 |= kk == 2 ? bit : 0ull; un3 |= kk == 3 ? bit : 0ull; }
        }
    }
    const bf16* KS = (const bf16*)(F.ws + WS_KF) + (size_t)6 * STREAM_ELEMS; const bf16* VS = (const bf16*)(F.ws + WS_VF) + (size_t)6 * STREAM_ELEMS;
    ZERO_O(o); l = 0.f;
    {
        const int NG = (cur + 8) >> 3;
        const char* srcb = (const char*)((w < 4) ? KS : VS) + (w & 3) * 1024 + lane * 16;
        LAS unsigned char* ring0 = F.lds; const unsigned wo = (unsigned)w * 1024u; const unsigned ring0a = lds_addr(ring0);
#define DMAG(gi) do { _Pragma("unroll") for (int _tt = 0; _tt < 16; ++_tt) \
        glds16(srcb + (ptrdiff_t)((gi) * 16 + _tt) * 4096, (unsigned)__builtin_amdgcn_readfirstlane(ring0a + (unsigned)(_tt * 8192) + wo)); } while (0)
        asm volatile("s_waitcnt vmcnt(0) lgkmcnt(0)" ::: "memory"); SBAR();
        for (int gi = 0; gi < NG; ++gi) {
            DMAG(gi);
            VMW(0);
            SBAR();
#pragma unroll
            for (int bb = 0; bb < 8; ++bb) {
                const int m = gi * 8 + bb, kk = m >> 6, b = m & 63;
                const unsigned long long uw = kk == 0 ? un0 : (kk == 1 ? un1 : (kk == 2 ? un2 : un3));
                if (m < 256 && ((uw >> b) & 1ull)) {
                    const unsigned long long mw = kk == 0 ? my0 : (kk == 1 ? my1 : (kk == 2 ? my2 : my3));
                    const bool flag = (mw >> b) & 1ull;
                    {
                        LAS unsigned char* b0 = ring0 + (bb * 2) * 8192; LAS unsigned char* b1 = b0 + 8192;
                        const f32x16 s0 = qk_lds(b0, qf, lane, -SHs), s1 = qk_lds(b1, qf, lane, -SHs);
                        float e0[16], e1[16];
                        if (m == cur) {
#pragma unroll
                            for (int r = 0; r < 16; ++r) { const int key = 64 * m + crow(r, hg);
                                e0[r] = (flag && key <= t) ? __builtin_amdgcn_exp2f(s0[r]) : 0.f; e1[r] = (flag && key + 32 <= t) ? __builtin_amdgcn_exp2f(s1[r]) : 0.f; l += e0[r] + e1[r]; }
                        } else {
                            const float fl = flag ? 1.f : 0.f;
#pragma unroll
                            for (int r = 0; r < 16; ++r) { e0[r] = fl * __builtin_amdgcn_exp2f(s0[r]); e1[r] = fl * __builtin_amdgcn_exp2f(s1[r]); l += e0[r] + e1[r]; }
                        }
                        pv_lds(b0, e0, o, lane); pv_lds(b1, e1, o, lane);
                    }
                }
            }
            asm volatile("s_waitcnt lgkmcnt(0)" ::: "memory"); SBAR();
        }
#undef DMAG
    }
    l += shx(l, 32, lane);
    {
        const float sc = l > 0.f ? g1 / l : 0.f;
#pragma unroll
        for (int r = 0; r < 16; ++r) { accF[0][r] += sc * o[0][r]; accF[1][r] += sc * o[1][r]; }
    }
    const bf16* KW = (const bf16*)(F.ws + WS_KF) + (size_t)7 * STREAM_ELEMS; const bf16* VW = (const bf16*)(F.ws + WS_VF) + (size_t)7 * STREAM_ELEMS;
    ZERO_O(o); l = 0.f;
    const int Tlw = (t0 - 511 > 0 ? t0 - 511 : 0) >> 5, Thw = (t0 + 7) >> 5;
    const int TLO = (qb * 64 - 511 > 0 ? qb * 64 - 511 : 0) >> 5, THI = (qb * 64 + 63) >> 5;
    STREAM2_BEGIN(KW, VW, TLO, 1, THI - TLO + 1)
        do_pair(_v0 && T0 >= Tlw && T0 <= Thw, _v1 && T1 >= Tlw && T1 <= Thw, _b0, _b1, T0, T1, qf, o, l, lane, -SHw,
                [=](int T, int r, float sv) { const int key = 32 * T + crow(r, hg); return (key <= t && key >= t - 511) ? __builtin_amdgcn_exp2f(sv) : 0.f; });
    STREAM2_END
    l += shx(l, 32, lane);
    {
        const float sc = l > 0.f ? g2 / l : 0.f;
#pragma unroll
        for (int r = 0; r < 16; ++r) { accF[0][r] += sc * o[0][r]; accF[1][r] += sc * o[1][r]; }
    }
    write_gated(F, accF, 1.f, t, C_ON + h * 64, C_NZ + h * 64, hg);
}

__device__ __forceinline__ void phase4a(const Params& P, const Frame& F0, int layer, int rep) {
    unsigned* ctr = (unsigned*)(F0.ws + WS_CTL) + 16 * layer + 8 * rep;
    constexpr int N_P3 = 384, N_NSA = 256, N_FOX = 384, N_SEL = 384, N_OWN = 384, N_ALL = N_P3 + N_NSA + N_FOX + N_SEL + N_OWN;
    unsigned* p3done = (unsigned*)(F0.ws + WS_CTL) + 16 * layer + 4;
    volatile LAS unsigned* ubox = (volatile LAS unsigned*)(F0.lds + 131072);
    for (;;) {
        Frame F = F0;
        { unsigned char* wp = F0.ws; asm volatile("" : "+s"(wp)); int tv = F0.tid; asm volatile("" : "+v"(tv)); F.ws = wp; F.PA = (bf16*)(wp + WS_PA); F.tid = tv; F.lane = tv & 63; }
        if (F.tid == 0) *ubox = __hip_atomic_fetch_add(ctr, 1u, __ATOMIC_RELAXED, __HIP_MEMORY_SCOPE_AGENT);
        __syncthreads();
        const unsigned u = __builtin_amdgcn_readfirstlane(*ubox);
        __syncthreads();
        if (u >= (unsigned)N_ALL) break;
#ifndef PROBE_ONLY
#define PROBE_ONLY -1
#endif
        if (u < (unsigned)N_P3) {
            p3_unit(P, F, layer, u < 192u ? 0 : 1, u < 192u ? (int)u : (int)u - 192);
            asm volatile("s_waitcnt vmcnt(0)" ::: "memory");
            __syncthreads();
            if (F.tid == 0) { __builtin_amdgcn_fence(__ATOMIC_RELEASE, "agent"); asm volatile("s_waitcnt vmcnt(0)" ::: "memory");
                __hip_atomic_fetch_add(p3done, 1u, __ATOMIC_RELAXED, __HIP_MEMORY_SCOPE_AGENT); }
            continue;
        }
        const unsigned u2 = u - N_P3;
        if (u2 >= (unsigned)N_NSA && u2 < (unsigned)(N_NSA + N_FOX + N_SEL)) {
            if (F.tid == 0) { unsigned sp = 0; while (__hip_atomic_load(p3done, __ATOMIC_RELAXED, __HIP_MEMORY_SCOPE_AGENT) < (unsigned)N_P3 && ++sp < (1u << 24)) __builtin_amdgcn_s_sleep(2);
                __builtin_amdgcn_fence(__ATOMIC_ACQUIRE, "agent"); asm volatile("s_waitcnt vmcnt(0)" ::: "memory"); }
            __syncthreads();
        }
        if (u2 < (unsigned)N_NSA) { wg_nsa(P, F, layer, 255 - (int)u2); }
        else if (u2 < (unsigned)(N_NSA + N_FOX)) { const unsigned v = u2 - N_NSA; wg_fox(P, F, layer, (int)(v % 6), 63 - (int)(v / 6)); }
        else if (u2 < (unsigned)(N_NSA + N_FOX + N_SEL)) { const unsigned v = u2 - (N_NSA + N_FOX); wg_moba_sel(P, F, layer, (int)(v % 6), (int)(v / 6)); }
        else { const unsigned v = u2 - (N_NSA + N_FOX + N_SEL); wg_moba_own(P, F, layer, (int)(v % 6), 63 - (int)(v / 6)); }
    }
}

__device__ __forceinline__ void phase4b(const Params& P, const Frame& F, int layer, const float* xin) {
    const float* LPART = (const float*)(F.ws + WS_LPART); const float* LOWN = (const float*)(F.ws + WS_LOWN);
    for (int it = F.gw; it < SEQ * 48 / 64; it += F.NGW) {
        const int idx = it * 64 + F.lane, t = idx / 48, r = idx - t * 48, h = r >> 3, d8 = (r & 7) * 8, cur = t >> 8;
        bf16* op = F.PA + (size_t)t * PAC + C_OM + h * 64 + d8;
        const u32x4 ow = *(const u32x4*)op;
        float v[8] = {bflo(ow.x), bfhi(ow.x), bflo(ow.y), bfhi(ow.y), bflo(ow.z), bfhi(ow.z), bflo(ow.w), bfhi(ow.w)};
        float l = LOWN[h * SEQ + t];
        const size_t rec = ((size_t)h * SEQ + t) * 3;
#pragma unroll
        for (int s = 0; s < 3; ++s) if (s < cur) {
            const u32x4 pw = *(const u32x4*)(moba_part(F, h, t, s) + d8);
            v[0] += bflo(pw.x); v[1] += bfhi(pw.x); v[2] += bflo(pw.y); v[3] += bfhi(pw.y); v[4] += bflo(pw.z); v[5] += bfhi(pw.z); v[6] += bflo(pw.w); v[7] += bfhi(pw.w);
            l += LPART[rec + s];
        }
        const float inv = l > 0.f ? 1.f / l : 0.f;
        const u32x4 z = *(const u32x4*)(F.PA + (size_t)t * PAC + C_MZ + h * 64 + d8);
        u32x4 wv;
        wv.x = cvt_pk_bf16(v[0] * inv * siluf_(bflo(z.x)), v[1] * inv * siluf_(bfhi(z.x))); wv.y = cvt_pk_bf16(v[2] * inv * siluf_(bflo(z.y)), v[3] * inv * siluf_(bfhi(z.y)));
        wv.z = cvt_pk_bf16(v[4] * inv * siluf_(bflo(z.z)), v[5] * inv * siluf_(bfhi(z.z))); wv.w = cvt_pk_bf16(v[6] * inv * siluf_(bflo(z.w)), v[7] * inv * siluf_(bfhi(z.w)));
        *(u32x4*)op = wv;
    }
    (void)xin;
}


#define XB_TMO      128
#define XB_XCNT(j)  (256  + 64 * (j))
#define XB_XSUB(j)  (1280 + 64 * (j))
#define XB_XGEN(j)  (2304 + 64 * (j))
#define XB_TOP      3328
#define XB_TOPGEN   3392
#define XCD_BAR_WORDS 3456
#define XB_SPIN_CAP (1u << 22)
__device__ __forceinline__ unsigned xb_ld(unsigned* p)              { return __hip_atomic_load(p, __ATOMIC_RELAXED, __HIP_MEMORY_SCOPE_AGENT); }
__device__ __forceinline__ unsigned xb_add(unsigned* p, unsigned v) { return __hip_atomic_fetch_add(p, v, __ATOMIC_RELAXED, __HIP_MEMORY_SCOPE_AGENT); }
__device__ __forceinline__ unsigned xb_xcc_id() { return (unsigned)__builtin_amdgcn_s_getreg((3 << 11) | 20) & 0xFu; }
#define XB_SPIN(cond, bar) do { unsigned _sp = 0; while (cond) { __builtin_amdgcn_s_sleep(1); \
    if ((++_sp & 255u) == 0u) { if (xb_ld(&(bar)[XB_TMO])) break; if (_sp > XB_SPIN_CAP) { atomicAdd(&(bar)[XB_TMO], 1u); break; } } } } while (0)
struct XcdBarrier { unsigned* bar; unsigned x; volatile LAS unsigned* st; };
__device__ __forceinline__ XcdBarrier xcd_barrier_post(unsigned* bar, volatile LAS unsigned* st) {
    XcdBarrier b; b.bar = bar; b.x = xb_xcc_id(); b.st = st;
    if (threadIdx.x == 0) (void)xb_add(&bar[XB_XCNT(b.x)], 1u);
    return b;
}
__device__ __forceinline__ void xcd_barrier_complete(unsigned* bar, unsigned x, unsigned& nloc, unsigned& nx) {
    const unsigned G = gridDim.x * gridDim.y * gridDim.z;
    unsigned sum, cnt, mine, sp = 0u;
    for (;;) {
        sum = 0u; cnt = 0u; mine = 0u;
#pragma unroll
        for (unsigned j = 0; j < 16; ++j) { const unsigned c = xb_ld(&bar[XB_XCNT(j)]); sum += c; cnt += (c > 0u) ? 1u : 0u; mine = (j == x) ? c : mine; }
        if (sum == G) break;
        __builtin_amdgcn_s_sleep(1);
        if ((++sp & 255u) == 0u) { if (xb_ld(&bar[XB_TMO])) break; if (sp > XB_SPIN_CAP) { atomicAdd(&bar[XB_TMO], 1u); break; } }
    }
    nloc = mine > 0u ? mine : 1u; nx = cnt > 0u ? cnt : 1u;
}
__device__ __forceinline__ void xcd_barrier(const XcdBarrier& b) {
    asm volatile("s_waitcnt vmcnt(0)" ::: "memory");
    __syncthreads();
    if (threadIdx.x == 0) {
        unsigned* bar = b.bar;
        __builtin_amdgcn_s_waitcnt(0);
        unsigned nloc = b.st[0], nx = b.st[1];
        if (nloc == 0u) { xcd_barrier_complete(bar, b.x, nloc, nx); b.st[0] = nloc; b.st[1] = nx; }
        const unsigned old = xb_add(&bar[XB_XSUB(b.x)], 1u);
        const unsigned gen = old / nloc;
        if (old + 1u == (gen + 1u) * nloc) {
            __builtin_amdgcn_fence(__ATOMIC_RELEASE, "agent");
            asm volatile("s_waitcnt vmcnt(0)" ::: "memory");
            const unsigned og = xb_add(&bar[XB_TOP], 1u);
            const unsigned tg = og / nx;
            if (og + 1u == (tg + 1u) * nx) xb_add(&bar[XB_TOPGEN], 1u);
            else XB_SPIN(xb_ld(&bar[XB_TOPGEN]) == tg, bar);
            __builtin_amdgcn_fence(__ATOMIC_ACQUIRE, "agent");
            xb_add(&bar[XB_XGEN(b.x)], 1u);
            asm volatile("s_waitcnt vmcnt(0)" ::: "memory");
        } else {
            XB_SPIN(xb_ld(&bar[XB_XGEN(b.x)]) == gen, bar);
            __builtin_amdgcn_fence(__ATOMIC_ACQUIRE, "agent");
            asm volatile("s_waitcnt vmcnt(0)" ::: "memory");
        }
    }
    __syncthreads();
}

__global__ void __launch_bounds__(512, 2) fwd_kernel(Params P) {
    extern __shared__ __attribute__((aligned(16))) unsigned char lds_raw[];
    cg::grid_group grid = cg::this_grid();
    const int G = gridDim.x, bx = blockIdx.x;
    volatile LAS unsigned* bst = (volatile LAS unsigned*)((LAS unsigned char*)lds_raw + 131072 + 64);
    if (threadIdx.x == 0) { bst[0] = 0u; bst[1] = 0u; }
    __syncthreads();
    XcdBarrier gbar; gbar.bar = (unsigned*)(P.ws + WS_BAR); gbar.x = 0; gbar.st = bst;
    if (P.ph_hi - P.ph_lo > 1) gbar = xcd_barrier_post((unsigned*)(P.ws + WS_BAR), bst);
#ifdef PROBE_TS
    unsigned long long ts_acc = 0ull;
#endif
    long long p2acc = 0;
#ifdef PROBE_SYNC
    { const unsigned long long t0 = __builtin_amdgcn_s_memrealtime();
      for (int i = 0; i < 20; ++i) grid.sync();
      p2acc += (long long)(__builtin_amdgcn_s_memrealtime() - t0); }
#endif
    for (int ph = P.ph_lo; ph < P.ph_hi; ++ph) {
#ifdef PROBE_TS
        const unsigned long long ts0 = __builtin_amdgcn_s_memrealtime();
#endif
        unsigned char* wsb = P.ws; asm volatile("" : "+s"(wsb));
        int tidv = threadIdx.x; asm volatile("" : "+v"(tidv));
        Frame F;
        F.lds = (LAS unsigned char*)lds_raw;
        F.tid = tidv; F.lane = F.tid & 63; F.wave = __builtin_amdgcn_readfirstlane(F.tid >> 6);
        F.gw = bx * 8 + F.wave; F.NGW = G * 8;
        F.ws = wsb; F.PA = (bf16*)(wsb + WS_PA);
        const int layer = ph / NPH, k = ph - layer * NPH;
        const float* xin = layer == 0 ? P.x : P.out;
        if (k == 0) phase0(P, F, layer, xin);
        else if (k == 1) {
            pg8::Gemm g{(const bf16*)(wsb + WS_H), (const bf16*)(wsb + WS_WA), SEQ, PAC, DM, DM}; pg8::StaticOrder S; S.init(SEQ, PAC, G, bx); pg8::EpiBf16 E{F.PA, PAC};
            pg8::gemm_phase<pg8::EpiBf16, pg8::StaticOrder>(F.lds, g, S, E, F.tid);
        }
        else if (k == 5) {
            pg8::StaticOrder SM; SM.init(SEQ, DM, G, bx); pg8::Unit mu;
            for (int j = 0; SM.next(j, mu); ++j) {
                { unsigned char* wl = wsb; asm volatile("" : "+s"(wl)); int tl = tidv; asm volatile("" : "+v"(tl));
                  pg8::Gemm g{(const bf16*)(wl + WS_H), (const bf16*)(wl + WS_WG), SEQ, NGL, DM, DM}; pg8::FixedUnits S{mu, 3, 4}; pg8::EpiBf16 E{(bf16*)(wl + WS_PA) + C_GL, PAC};
                  pg8::gemm_phase<pg8::EpiBf16, pg8::FixedUnits>(F.lds, g, S, E, tl); }
                for (int b = 0; b < 3; ++b) {
                    unsigned char* wl = wsb; asm volatile("" : "+s"(wl)); int tl = tidv; asm volatile("" : "+v"(tl));
                    bf16* PAl = (bf16*)(wl + WS_PA);
                    const int Kb = b == 1 ? 256 : 384;
                    const bf16* A = PAl + (b == 0 ? C_OM : (b == 1 ? C_ON : C_OF));
                    const bf16* Bt = (const bf16*)(wl + (b == 0 ? WS_WUPM : (b == 1 ? WS_WUPN : WS_WUPF)));
                    pg8::Gemm g{A, Bt, SEQ, DM, Kb, PAC}; pg8::FixedUnits S{mu, 1, 0};
                    pg8::EpiMerge E{(bf16*)(wl + WS_MG), PAl + C_GL + b * 1024, P.b_gate + layer * 3072 + b * 1024, b == 0 ? 1 : 0};
                    pg8::gemm_phase<pg8::EpiMerge, pg8::FixedUnits>(F.lds, g, S, E, tl);
                }
            }
        }
        else if (k == 2) phase2(P, F, layer, p2acc);
        else if (k == 3) {
#ifdef PROBE_P4X2
            for (int rep = 0; rep < 2; ++rep) { if (rep) grid.sync(); phase4a(P, F, layer, rep); }
#else
            phase4a(P, F, layer, 0);
#endif
        }
        else if (k == 4) phase4b(P, F, layer, xin);
        else {
            pg8::Gemm g{(const bf16*)(wsb + WS_MG), (const bf16*)(wsb + WS_WO), SEQ, DM, DM, DM}; pg8::StaticOrder S; S.init(SEQ, DM, G, bx);
            pg8::EpiOut E{xin, P.out};
            pg8::gemm_phase<pg8::EpiOut, pg8::StaticOrder>(F.lds, g, S, E, F.tid);
        }
        if (ph + 1 < P.ph_hi) { if (P.ph_hi < 0) grid.sync(); else xcd_barrier(gbar); }
#ifdef PROBE_TS
        if ((ph % NPH) == PROBE_TS) ts_acc += __builtin_amdgcn_s_memrealtime() - ts0;
        if (ph + 1 == P.ph_hi && bx == 0 && tidv == 0) { __threadfence(); P.out[0] += (float)ts_acc * 1e-3f; }
#endif
#ifdef PROBE_SYNC
        if (ph + 1 == P.ph_hi && bx == 0 && tidv == 0) { __threadfence(); P.out[0] += (float)p2acc * 1e-3f; }
#endif
#ifdef PROBE_P2PART
        if (ph + 1 == P.ph_hi && bx == PROBE_P2BLK && tidv == 0) { __threadfence(); P.out[0] += (float)p2acc * 1e-3f; }
#endif
    }
}

extern "C" void kernel_launch(void* const* d_in, const int* in_sizes, int n_in, void* d_out, int out_size, void* d_ws, size_t ws_size, hipStream_t stream) {
    static int grid = 0;
    if (grid == 0) {
        if (n_in != 16 || out_size != SEQ * DM || ws_size < WS_END) { fprintf(stderr, "kernel_launch: unexpected problem shape (n_in %d out %d ws %zu)\n", n_in, out_size, ws_size); grid = -1; return; }
        int dev = 0, cus = 0, per_cu = 0;
        hipGetDevice(&dev);
        hipDeviceGetAttribute(&cus, hipDeviceAttributeMultiprocessorCount, dev);
        hipFuncSetAttribute((const void*)fwd_kernel, hipFuncAttributeMaxDynamicSharedMemorySize, LDS_BYTES);
        hipOccupancyMaxActiveBlocksPerMultiprocessor(&per_cu, (const void*)fwd_kernel, 512, LDS_BYTES);
        if (per_cu < 1) { fprintf(stderr, "kernel_launch: occupancy query says %d blocks per CU\n", per_cu); per_cu = 1; }
        (void)hipGetLastError();
        grid = cus * per_cu;
    }
    if (grid < 0) return;
    Params p{};
    p.x = (const float*)d_in[0]; p.norm_g = (const float*)d_in[1]; p.w_in = (const float*)d_in[2]; p.b_f = (const float*)d_in[3]; p.b_gate = (const float*)d_in[4];
    p.moba_qk_g = (const float*)d_in[5]; p.nsa_q_g = (const float*)d_in[6]; p.nsa_k_g = (const float*)d_in[7]; p.fox_qk_g = (const float*)d_in[8];
    p.cmp_pe = (const float*)d_in[9]; p.cmp_w1 = (const float*)d_in[10]; p.cmp_w2 = (const float*)d_in[11];
    p.w_up_moba = (const float*)d_in[12]; p.w_up_nsa = (const float*)d_in[13]; p.w_up_fox = (const float*)d_in[14]; p.w_out = (const float*)d_in[15];
    p.out = (float*)d_out; p.ws = (unsigned char*)d_ws;
#if N_LAUNCH_MODE == 1
    for (int ph = 0; ph < 2 * NPH; ++ph) { p.ph_lo = ph; p.ph_hi = ph + 1; hipLaunchKernelGGL(fwd_kernel, dim3(grid), dim3(512), LDS_BYTES, stream, p); }
#else
    p.ph_lo = 0; p.ph_hi = 2 * NPH;
    if (hipMemsetAsync((char*)d_ws + WS_BAR, 0, 16384, stream) != hipSuccess) { fprintf(stderr, "kernel_launch: memset of the barrier words failed\n"); return; }
    void* args[] = {&p};
    hipError_t e = hipLaunchCooperativeKernel((const void*)fwd_kernel, dim3(grid), dim3(512), args, LDS_BYTES, stream);
    if (e != hipSuccess) fprintf(stderr, "kernel_launch: cooperative launch failed: %s (grid %d)\n", hipGetErrorString(e), grid);
#endif
}
```

```cpp
#include <hip/hip_runtime.h>
#include <hip/hip_cooperative_groups.h>
#include <cstdio>
#include <cstdint>
namespace cg = cooperative_groups;

#ifndef N_LAUNCH_MODE
#define N_LAUNCH_MODE 0
#endif

typedef unsigned short bf16;
typedef short bf16x8 __attribute__((ext_vector_type(8)));
typedef float f32x4 __attribute__((ext_vector_type(4)));
typedef float f32x16 __attribute__((ext_vector_type(16)));
typedef unsigned u32x4 __attribute__((ext_vector_type(4)));
typedef unsigned u32x2 __attribute__((ext_vector_type(2)));
#define LAS __attribute__((address_space(3)))

constexpr int SEQ = 16384, DM = 1024, INC = 7058, PAC = 4096, NGL = 3072;
constexpr float LOG2E = 1.4426950408889634f;
constexpr float C2 = 0.125f * LOG2E;
constexpr float RMS_EPS = 1e-6f;
constexpr int LDS_BYTES = 131072 + 256;
constexpr int NPH = 7;

constexpr int C_MK = 0, C_MV = 384, C_KC = 768, C_VC = 832, C_KSL = 896, C_VSL = 960, C_MQ = 1024, C_MZ = 1408, C_NQ = 1792, C_KW = 2048, C_VW = 2112,
              C_NZ = 2176, C_FQ = 2432, C_FK = 2816, C_FV = 3200, C_FZ = 3584, C_NG = 3968, C_FF = 3980, C_GL = 1024;
constexpr int C_OM = 0, C_OF = 384, C_ON = 768;

constexpr size_t MiB = 1u << 20;
constexpr size_t WS_BAR = 512 * 1024  ;
constexpr size_t WS_CTL = 0, WS_WA = 1 * MiB, WS_WG = 9 * MiB, WS_WUPM = 15 * MiB, WS_WUPN = 15 * MiB + 768 * 1024, WS_WUPF = 15 * MiB + 1280 * 1024,
                 WS_WO = 17 * MiB, WS_W1T = 19 * MiB, WS_W2T = 21 * MiB, WS_KMEAN = 21 * MiB + 128 * 1024,
                 WS_CS = 21 * MiB + 256 * 1024, WS_CSTOT = 21 * MiB + 768 * 1024, WS_KCMP = 22 * MiB, WS_VCMP = 22 * MiB + 128 * 1024,
                 WS_KF = 23 * MiB, WS_VF = 51 * MiB, WS_MG = 23 * MiB  , WS_PA = 80 * MiB,
                 WS_H = 208 * MiB  , WS_P2 = 240 * MiB  ,
                 WS_LIST = 1 * MiB  , WS_LPART = 19 * MiB, WS_LOWN = 19 * MiB + 1280 * 1024  ,
                 WS_END = 256 * MiB;
constexpr size_t STREAM_ELEMS = (size_t)SEQ * 64;

struct Params {
    const float* x; const float* norm_g; const float* w_in; const float* b_f; const float* b_gate;
    const float* moba_qk_g; const float* nsa_q_g; const float* nsa_k_g; const float* fox_qk_g;
    const float* cmp_pe; const float* cmp_w1; const float* cmp_w2; const float* w_up_moba; const float* w_up_nsa; const float* w_up_fox; const float* w_out;
    float* out; unsigned char* ws; int ph_lo, ph_hi;
};

typedef float f32x2_t __attribute__((ext_vector_type(2)));
typedef __bf16 bf16x2_t __attribute__((ext_vector_type(2)));
__device__ __forceinline__ unsigned cvt_pk_bf16(float lo, float hi) { const f32x2_t v = {lo, hi}; const bf16x2_t b = __builtin_convertvector(v, bf16x2_t); return __builtin_bit_cast(unsigned, b); }
__device__ __forceinline__ float bf2f(unsigned short b) { return __builtin_bit_cast(float, (unsigned)b << 16); }
__device__ __forceinline__ float bflo(unsigned w) { return __builtin_bit_cast(float, w << 16); }
__device__ __forceinline__ float bfhi(unsigned w) { return __builtin_bit_cast(float, w & 0xffff0000u); }
__device__ __forceinline__ unsigned short f2bf(float f) { return (unsigned short)(cvt_pk_bf16(f, 0.f) & 0xffffu); }
__device__ __forceinline__ float shx(float v, int m, int lane) { return __builtin_bit_cast(float, __builtin_amdgcn_ds_bpermute((lane ^ m) << 2, __builtin_bit_cast(int, v))); }
__device__ __forceinline__ int shxi(int v, int m, int lane) { return __builtin_amdgcn_ds_bpermute((lane ^ m) << 2, v); }
__device__ __forceinline__ float shfrom(float v, int src) { return __builtin_bit_cast(float, __builtin_amdgcn_ds_bpermute(src << 2, __builtin_bit_cast(int, v))); }
__device__ __forceinline__ int shfromi(int v, int src) { return __builtin_amdgcn_ds_bpermute(src << 2, v); }
__device__ __forceinline__ float dpp_x1(float v) { return __builtin_bit_cast(float, __builtin_amdgcn_update_dpp(0, __builtin_bit_cast(int, v), 0xB1, 0xf, 0xf, false)); }
__device__ __forceinline__ float dpp_x2(float v) { return __builtin_bit_cast(float, __builtin_amdgcn_update_dpp(0, __builtin_bit_cast(int, v), 0x4E, 0xf, 0xf, false)); }
__device__ __forceinline__ float wave_sum(float v, int lane) {
#pragma unroll
    for (int o = 1; o < 64; o <<= 1) v += shx(v, o, lane);
    return v;
}
__device__ __forceinline__ float wave_max(float v, int lane) {
#pragma unroll
    for (int o = 1; o < 64; o <<= 1) v = fmaxf(v, shx(v, o, lane));
    return v;
}
__device__ __forceinline__ int crow(int r, int hi) { return (r & 3) + 8 * (r >> 2) + 4 * hi; }
__device__ __forceinline__ float sigmoidf_(float z) { return __builtin_amdgcn_rcpf(1.f + __builtin_amdgcn_exp2f(-LOG2E * z)); }
__device__ __forceinline__ float siluf_(float z) { return z * __builtin_amdgcn_rcpf(1.f + __builtin_amdgcn_exp2f(-LOG2E * z)); }
#define MFMA32(a, b, c) __builtin_amdgcn_mfma_f32_32x32x16_bf16((a), (b), (c), 0, 0, 0)
#define LDS_FENCE() asm volatile("s_waitcnt lgkmcnt(0)" ::: "memory")

namespace pg8 {
typedef unsigned short bf16_t;
constexpr int BM = 256, BK = 64, HALF = 128, HTB = HALF * BK * 2, NXCD = 8, WGM = 8;
__host__ __device__ __forceinline__ int lds_byte(int r, int c) { const int st = (r >> 4) * 2 + (c >> 5), rr = r & 15, cc = c & 31, ob = rr * 64 + cc * 2; return st * 1024 + (ob ^ (((ob >> 9) & 1) << 5)); }
__host__ __device__ __forceinline__ void stage_rc(int b, int& R, int& C) { const int st = b / 1024, sb = b % 1024, swz = sb ^ (((sb >> 9) & 1) << 5); R = (st >> 1) * 16 + swz / 64; C = (st & 1) * 32 + (swz % 64) / 2; }
__host__ __device__ __forceinline__ int perm32(int rho) { const int n = rho >> 4, i = rho & 15; return 8 * (i >> 2) + 4 * n + (i & 3); }
struct Unit { int pm, pn; };
struct Gemm { const bf16_t* A; const bf16_t* Bt; int M, N, K, lda; };
struct StaticOrder {
    int nM, nN, nwg, G, c;
    __device__ void init(int M, int N, int G_, int c_) { nM = M / BM; nN = N / BM; nwg = nM * nN; G = G_; c = c_; }
    __device__ bool next(int i, Unit& u) const {
        const long L = (long)i * G + c; if (L >= nwg) return false;
        int wgid = (int)L; { const int q = nwg / NXCD, r = nwg % NXCD, xcd = wgid % NXCD, off = wgid / NXCD; wgid = (xcd < r ? xcd * (q + 1) : r * (q + 1) + (xcd - r) * q) + off; }
        const int nig = WGM * nN, gid = wgid / nig, fm = gid * WGM, gsz = (nM - fm) < WGM ? (nM - fm) : WGM;
        u.pm = fm + ((wgid % nig) % gsz); u.pn = (wgid % nig) / gsz; return true;
    }
};
struct FixedUnits {
    Unit u0; int n, stride;
    __device__ bool next(int i, Unit& o) const { if (i >= n) return false; o.pm = u0.pm; o.pn = u0.pn + i * stride; return true; }
};
struct EpiBf16 {
    bf16_t* O; int ldc;
    __device__ __forceinline__ void operator()(const f32x4 (&acc)[2][2][4][2], const Unit& u, int wr, int wc, int fr, int fq) const {
        const int row0 = u.pm * BM + wr * 64 + fr, col0 = u.pn * BM + wc * 32 + 8 * fq;
#pragma unroll
        for (int ai = 0; ai < 2; ++ai)
#pragma unroll
            for (int m = 0; m < 4; ++m) { bf16_t* rowp = O + (size_t)(row0 + ai * HALF + m * 16) * ldc + col0;
#pragma unroll
                for (int bj = 0; bj < 2; ++bj) { const f32x4 v0 = acc[ai][bj][m][0], v1 = acc[ai][bj][m][1];
                    u32x4 w; w.x = cvt_pk_bf16(v0[0], v0[1]); w.y = cvt_pk_bf16(v0[2], v0[3]); w.z = cvt_pk_bf16(v1[0], v1[1]); w.w = cvt_pk_bf16(v1[2], v1[3]);
                    *(u32x4*)(rowp + bj * HALF) = w; } }
    }
};
struct EpiMerge {
    bf16_t* Mg; const bf16_t* gl; const float* bg; int first;
    __device__ __forceinline__ void operator()(const f32x4 (&acc)[2][2][4][2], const Unit& u, int wr, int wc, int fr, int fq) const {
        const int row0 = u.pm * BM + wr * 64 + fr, col0 = u.pn * BM + wc * 32 + 8 * fq;
#pragma unroll
        for (int bj = 0; bj < 2; ++bj) {
            const int col = col0 + bj * HALF;
            const f32x4 b0 = *(const f32x4*)(bg + col), b1 = *(const f32x4*)(bg + col + 4);
#pragma unroll
            for (int ai = 0; ai < 2; ++ai)
#pragma unroll
                for (int m = 0; m < 4; ++m) {
                    const size_t row = (size_t)(row0 + ai * HALF + m * 16);
                    const u32x4 g = *(const u32x4*)(gl + row * PAC + col);
                    const f32x4 a0 = acc[ai][bj][m][0], a1 = acc[ai][bj][m][1];
                    float v[8];
                    v[0] = a0[0] * sigmoidf_(bflo(g.x) + b0[0]); v[1] = a0[1] * sigmoidf_(bfhi(g.x) + b0[1]);
                    v[2] = a0[2] * sigmoidf_(bflo(g.y) + b0[2]); v[3] = a0[3] * sigmoidf_(bfhi(g.y) + b0[3]);
                    v[4] = a1[0] * sigmoidf_(bflo(g.z) + b1[0]); v[5] = a1[1] * sigmoidf_(bfhi(g.z) + b1[1]);
                    v[6] = a1[2] * sigmoidf_(bflo(g.w) + b1[2]); v[7] = a1[3] * sigmoidf_(bfhi(g.w) + b1[3]);
                    bf16_t* mp = Mg + row * DM + col;
                    if (!first) { const u32x4 p = *(const u32x4*)mp;
                        v[0] += bflo(p.x); v[1] += bfhi(p.x); v[2] += bflo(p.y); v[3] += bfhi(p.y); v[4] += bflo(p.z); v[5] += bfhi(p.z); v[6] += bflo(p.w); v[7] += bfhi(p.w); }
                    u32x4 w; w.x = cvt_pk_bf16(v[0], v[1]); w.y = cvt_pk_bf16(v[2], v[3]); w.z = cvt_pk_bf16(v[4], v[5]); w.w = cvt_pk_bf16(v[6], v[7]);
                    *(u32x4*)mp = w;
                }
        }
    }
};
struct EpiOut {
    const float* xin; float* out;
    __device__ __forceinline__ void operator()(const f32x4 (&acc)[2][2][4][2], const Unit& u, int wr, int wc, int fr, int fq) const {
        const int row0 = u.pm * BM + wr * 64 + fr, col0 = u.pn * BM + wc * 32 + 8 * fq;
#pragma unroll
        for (int ai = 0; ai < 2; ++ai)
#pragma unroll
            for (int m = 0; m < 4; ++m)
#pragma unroll
                for (int bj = 0; bj < 2; ++bj) {
                    const size_t off = (size_t)(row0 + ai * HALF + m * 16) * DM + col0 + bj * HALF;
                    const f32x4 x0 = *(const f32x4*)(xin + off), x1 = *(const f32x4*)(xin + off + 4);
                    *(f32x4*)(out + off) = x0 + acc[ai][bj][m][0]; *(f32x4*)(out + off + 4) = x1 + acc[ai][bj][m][1];
                }
    }
};

template <class Epi, class Sched>
__device__ __forceinline__ void gemm_phase(LAS unsigned char* lds, const Gemm g, const Sched& S, const Epi& E, const int tid) {
    const int wid = __builtin_amdgcn_readfirstlane(tid >> 6), lane = tid & 63, wr = wid >> 2, wc = wid & 3, fr = lane & 15, fq = lane >> 4;
    const int K = g.K, nt = K / BK, lda = g.lda;
    unsigned voffA[2], voffB[2];
#pragma unroll
    for (int i = 0; i < 2; ++i) { int R, C; stage_rc(tid * 16 + i * 8192, R, C); const int Rb = (R & ~31) + perm32(R & 31);
        voffA[i] = (unsigned)(R * lda + C) * 2u; voffB[i] = (unsigned)(Rb * K + C) * 2u; }
    const size_t kstep = (size_t)(BK * 2);
    const size_t hstepA = (size_t)HALF * lda * 2, hstepB = (size_t)HALF * K * 2;
    const size_t tstepA = 2 * hstepA, tstepB = 2 * hstepB;
    const unsigned ldsw = (unsigned)wid * 1024u;
    const int aoff = lds_byte(wr * 64 + fr, fq * 8), boff = lds_byte(wc * 32 + fr, fq * 8);
#define PG8_SA(b, h) (((b) * 2 + (h)) * HTB)
#define PG8_SB(b, h) ((4 + (b) * 2 + (h)) * HTB)
#define PG8_STAGE(bufoff, gbase, voff) do { _Pragma("unroll") for (int _i = 0; _i < 2; ++_i) \
        __builtin_amdgcn_global_load_lds((const unsigned*)((const char*)(gbase) + (voff)[_i]), (LAS unsigned*)(lds + (bufoff) + ldsw + _i * 8192), 16, 0, 0); } while (0)
#define PG8_LDA(dst, b, h) do { _Pragma("unroll") for (int m = 0; m < 4; ++m) _Pragma("unroll") for (int k = 0; k < 2; ++k) dst[m][k] = *(const LAS bf16x8*)(lds + PG8_SA(b, h) + aoff + m * 2048 + k * 1024); } while (0)
#define PG8_LDB(dst, b, h) do { _Pragma("unroll") for (int n = 0; n < 2; ++n) _Pragma("unroll") for (int k = 0; k < 2; ++k) dst[n][k] = *(const LAS bf16x8*)(lds + PG8_SB(b, h) + boff + n * 2048 + k * 1024); } while (0)
#define PG8_MMA(ai, bj, At, Bt) do { __builtin_amdgcn_s_setprio(1); _Pragma("unroll") for (int m = 0; m < 4; ++m) _Pragma("unroll") for (int n = 0; n < 2; ++n) _Pragma("unroll") for (int k = 0; k < 2; ++k) \
        acc[ai][bj][m][n] = __builtin_amdgcn_mfma_f32_16x16x32_bf16(Bt[n][k], At[m][k], acc[ai][bj][m][n], 0, 0, 0); __builtin_amdgcn_s_setprio(0); } while (0)
#define PG8_WAIT_V(n) asm volatile("s_waitcnt vmcnt(" #n ")" ::: "memory")
#define PG8_WAIT_L(n) asm volatile("s_waitcnt lgkmcnt(" #n ")" ::: "memory")
#define PG8_BAR __builtin_amdgcn_s_barrier()
#define PG8_SCHED __builtin_amdgcn_sched_barrier(0)
    Unit cur, nxt; int ui = 0;
    if (!S.next(0, cur)) return;
    f32x4 acc[2][2][4][2];
#pragma unroll
    for (int a = 0; a < 2; ++a)
#pragma unroll
        for (int b = 0; b < 2; ++b)
#pragma unroll
            for (int m = 0; m < 4; ++m)
#pragma unroll
                for (int n = 0; n < 2; ++n) acc[a][b][m][n] = (f32x4){0.f, 0.f, 0.f, 0.f};
    bf16x8 At[4][2], B0[2][2], B1[2][2];
    const char* cA = (const char*)g.A + (size_t)cur.pm * tstepA; const char* cB = (const char*)g.Bt + (size_t)cur.pn * tstepB;
    PG8_STAGE(PG8_SB(0, 0), cB, voffB); PG8_STAGE(PG8_SB(0, 1), cB + hstepB, voffB); PG8_STAGE(PG8_SA(0, 0), cA, voffA); PG8_STAGE(PG8_SA(0, 1), cA + hstepA, voffA);
    if (wr == 1) PG8_BAR;
    PG8_WAIT_V(2); PG8_BAR;
    PG8_STAGE(PG8_SB(1, 0), cB + kstep, voffB); PG8_STAGE(PG8_SA(1, 0), cA + kstep, voffA); PG8_STAGE(PG8_SB(1, 1), cB + hstepB + kstep, voffB);
    PG8_WAIT_V(6); PG8_BAR;
    for (;;) {
        const bool has_next = S.next(ui + 1, nxt);
        const char* nA = has_next ? (const char*)g.A + (size_t)nxt.pm * tstepA : cA; const char* nB = has_next ? (const char*)g.Bt + (size_t)nxt.pn * tstepB : cB;
        for (int t = 0; t < nt; t += 2) {
            const bool last = (t == nt - 2);
            const char* a1 = cA + (size_t)(t + 1) * kstep;
            const char* a2 = last ? nA : cA + (size_t)(t + 2) * kstep; const char* b2 = last ? nB : cB + (size_t)(t + 2) * kstep;
            const char* a3 = a2 + kstep; const char* b3 = b2 + kstep;
            PG8_LDB(B0, 0, 0); PG8_LDB(B1, 0, 1); PG8_SCHED; PG8_LDA(At, 0, 0); PG8_STAGE(PG8_SA(1, 1), a1 + hstepA, voffA);
            PG8_WAIT_V(8); PG8_WAIT_L(0); PG8_BAR; PG8_MMA(0, 0, At, B0); PG8_MMA(0, 1, At, B1); PG8_BAR; PG8_SCHED;
            PG8_LDA(At, 0, 1); PG8_STAGE(PG8_SB(0, 0), b2, voffB); PG8_STAGE(PG8_SB(0, 1), b2 + hstepB, voffB); PG8_STAGE(PG8_SA(0, 0), a2, voffA);
            PG8_WAIT_V(8); PG8_WAIT_L(0); PG8_BAR; PG8_MMA(1, 0, At, B0); PG8_MMA(1, 1, At, B1); PG8_BAR; PG8_SCHED;
            PG8_LDB(B0, 1, 0); PG8_LDB(B1, 1, 1); PG8_SCHED; PG8_LDA(At, 1, 0); PG8_STAGE(PG8_SA(0, 1), a2 + hstepA, voffA);
            PG8_WAIT_V(8); PG8_WAIT_L(0); PG8_BAR; PG8_MMA(0, 0, At, B0); PG8_MMA(0, 1, At, B1); PG8_BAR; PG8_SCHED;
            PG8_LDA(At, 1, 1); PG8_STAGE(PG8_SB(1, 0), b3, voffB); PG8_STAGE(PG8_SB(1, 1), b3 + hstepB, voffB); PG8_STAGE(PG8_SA(1, 0), a3, voffA);
            PG8_WAIT_V(8); PG8_WAIT_L(0); PG8_BAR; PG8_MMA(1, 0, At, B0); PG8_MMA(1, 1, At, B1); PG8_BAR; PG8_SCHED;
        }
        if (wr == 0) PG8_BAR;
        E(acc, cur, wr, wc, fr, fq);
        if (!has_next) break;
#pragma unroll
        for (int a = 0; a < 2; ++a)
#pragma unroll
            for (int b = 0; b < 2; ++b)
#pragma unroll
                for (int m = 0; m < 4; ++m)
#pragma unroll
                    for (int n = 0; n < 2; ++n) acc[a][b][m][n] = (f32x4){0.f, 0.f, 0.f, 0.f};
        cur = nxt; cA = nA; cB = nB; ++ui;
        if (wr == 1) PG8_BAR;
    }
    PG8_WAIT_V(0);
    PG8_BAR;
#undef PG8_SA
#undef PG8_SB
#undef PG8_STAGE
#undef PG8_LDA
#undef PG8_LDB
#undef PG8_MMA
#undef PG8_WAIT_V
#undef PG8_WAIT_L
#undef PG8_BAR
#undef PG8_SCHED
}
}

struct Frame { LAS unsigned char* lds; int tid, lane, wave, gw, NGW; unsigned char* ws; bf16* PA; };

__device__ __forceinline__ int srcA(int n) {
    if (n < 384) return 384 + n;
    if (n < 768) return 768 + (n - 384);
    if (n < 1024) return 1792 + (n - 768);
    if (n < 1408) return n - 1024;
    if (n < 1792) return 1152 + (n - 1408);
    if (n < 2048) return 1536 + (n - 1792);
    if (n < 2176) return 2048 + (n - 2048);
    if (n < 2432) return 2188 + (n - 2176);
    if (n < 3584) return 2444 + (n - 2432);
    if (n < 3968) return 3602 + (n - 3584);
    if (n < 3980) return 2176 + (n - 3968);
    if (n < 3986) return 3596 + (n - 3980);
    return -1;
}
__device__ __forceinline__ void tr_item(const float* W, int ldw, bf16* WT, int Kd, int k0, int n0, int mode, int off, LAS float* scr, int lane) {
    const int nn = n0 + (lane & 31);
    const int sc = mode == 0 ? srcA(nn) : nn + off;
#pragma unroll 16
    for (int i = 0; i < 32; ++i) { const int kk = 2 * i + (lane >> 5); scr[kk * 33 + (lane & 31)] = sc >= 0 ? W[(size_t)(k0 + kk) * ldw + sc] : 0.f; }
    LDS_FENCE();
    const int c = lane & 7;
#pragma unroll
    for (int j = 0; j < 4; ++j) { const int n = (lane >> 3) + 8 * j; const LAS float* s = scr + (8 * c) * 33 + n;
        u32x4 o; o.x = cvt_pk_bf16(s[0 * 33], s[1 * 33]); o.y = cvt_pk_bf16(s[2 * 33], s[3 * 33]); o.z = cvt_pk_bf16(s[4 * 33], s[5 * 33]); o.w = cvt_pk_bf16(s[6 * 33], s[7 * 33]);
        if (mode == 2) { const int nn2 = n0 + n, kk2 = k0 + 8 * c;
            *(u32x4*)(WT + ((size_t)((nn2 >> 5) * (Kd >> 4) + (kk2 >> 4)) * 64 + ((kk2 >> 3) & 1) * 32 + (nn2 & 31)) * 8) = o; }
        else *(u32x4*)(WT + (size_t)(n0 + n) * Kd + k0 + 8 * c) = o; }
    LDS_FENCE();
}
__device__ __forceinline__ void rms_rows(const Params& P, const Frame& F, int layer, const float* xin, bf16* H) {
    const float* g = P.norm_g + layer * DM;
    for (int m0 = F.gw; m0 < SEQ; m0 += 2 * F.NGW) {
        const int m1 = m0 + F.NGW < SEQ ? m0 + F.NGW : m0;
        const f32x4* xr0 = (const f32x4*)(xin + (size_t)m0 * DM) + F.lane; const f32x4* xr1 = (const f32x4*)(xin + (size_t)m1 * DM) + F.lane;
        f32x4 v0[4], v1[4]; float s0 = 0.f, s1 = 0.f;
#pragma unroll
        for (int j = 0; j < 4; ++j) { v0[j] = xr0[64 * j]; v1[j] = xr1[64 * j]; }
#pragma unroll
        for (int j = 0; j < 4; ++j) { s0 += (v0[j].x * v0[j].x + v0[j].y * v0[j].y) + (v0[j].z * v0[j].z + v0[j].w * v0[j].w); s1 += (v1[j].x * v1[j].x + v1[j].y * v1[j].y) + (v1[j].z * v1[j].z + v1[j].w * v1[j].w); }
        const float r0 = rsqrtf(wave_sum(s0, F.lane) * (1.f / DM) + RMS_EPS), r1 = rsqrtf(wave_sum(s1, F.lane) * (1.f / DM) + RMS_EPS);
        unsigned long long* o0 = (unsigned long long*)(H + (size_t)m0 * DM) + F.lane; unsigned long long* o1 = (unsigned long long*)(H + (size_t)m1 * DM) + F.lane;
#pragma unroll
        for (int j = 0; j < 4; ++j) { const f32x4 gg = ((const f32x4*)g)[F.lane + 64 * j];
            o0[64 * j] = (unsigned long long)cvt_pk_bf16(v0[j].x * r0 * gg.x, v0[j].y * r0 * gg.y) | ((unsigned long long)cvt_pk_bf16(v0[j].z * r0 * gg.z, v0[j].w * r0 * gg.w) << 32);
            o1[64 * j] = (unsigned long long)cvt_pk_bf16(v1[j].x * r1 * gg.x, v1[j].y * r1 * gg.y) | ((unsigned long long)cvt_pk_bf16(v1[j].z * r1 * gg.z, v1[j].w * r1 * gg.w) << 32); }
    }
}
__device__ __forceinline__ void phase0(const Params& P, const Frame& F, int layer, const float* xin) {
    LAS float* scr = (LAS float*)(F.lds + F.wave * 16384);
    unsigned char* ws = F.ws;
    if (F.gw == 0) { unsigned* ctl = (unsigned*)(ws + WS_CTL);
        if (F.lane == 0) { ctl[16 * layer] = 0u; ctl[16 * layer + 8] = 0u; ctl[16 * layer + 4] = 0u; }
        for (int i = F.lane; i < 384; i += 64) ctl[1024 + 16384 * layer + i * 32] = 0u; }
    constexpr int I_A = 16 * 128, I_G = 16 * 96, I_UM = 6 * 32, I_UN = 4 * 32, I_UF = 6 * 32, I_O = 16 * 32, I_1 = 32 * 8, I_2 = 4 * 2;
    constexpr int NIT = I_A + I_G + I_UM + I_UN + I_UF + I_O + 2 * I_1 + 2 * I_2;
    const float* w_in = P.w_in + (size_t)layer * DM * INC;
    for (int it = F.gw; it < NIT; it += F.NGW) {
        int r = it;
        if (r < I_A) { tr_item(w_in, INC, (bf16*)(ws + WS_WA), 1024, 64 * (r / 128), 32 * (r % 128), 0, 0, scr, F.lane); continue; } r -= I_A;
        if (r < I_G) { tr_item(w_in, INC, (bf16*)(ws + WS_WG), 1024, 64 * (r / 96), 32 * (r % 96), 1, 3986, scr, F.lane); continue; } r -= I_G;
        if (r < I_UM) { tr_item(P.w_up_moba + (size_t)layer * 384 * 1024, 1024, (bf16*)(ws + WS_WUPM), 384, 64 * (r / 32), 32 * (r % 32), 1, 0, scr, F.lane); continue; } r -= I_UM;
        if (r < I_UN) { tr_item(P.w_up_nsa + (size_t)layer * 256 * 1024, 1024, (bf16*)(ws + WS_WUPN), 256, 64 * (r / 32), 32 * (r % 32), 1, 0, scr, F.lane); continue; } r -= I_UN;
        if (r < I_UF) { tr_item(P.w_up_fox + (size_t)layer * 384 * 1024, 1024, (bf16*)(ws + WS_WUPF), 384, 64 * (r / 32), 32 * (r % 32), 1, 0, scr, F.lane); continue; } r -= I_UF;
        if (r < I_O) { tr_item(P.w_out + (size_t)layer * 1024 * 1024, 1024, (bf16*)(ws + WS_WO), 1024, 64 * (r / 32), 32 * (r % 32), 1, 0, scr, F.lane); continue; } r -= I_O;
        if (r < 2 * I_1) { const int kv = r / I_1; r %= I_1;
            tr_item(P.cmp_w1 + (size_t)(layer * 2 + kv) * 2048 * 256, 256, (bf16*)(ws + WS_W1T) + (size_t)kv * 256 * 2048, 2048, 64 * (r / 8), 32 * (r % 8), 2, 0, scr, F.lane); continue; } r -= 2 * I_1;
        { const int kv = r / I_2; r %= I_2;
            tr_item(P.cmp_w2 + (size_t)(layer * 2 + kv) * 256 * 64, 64, (bf16*)(ws + WS_W2T) + (size_t)kv * 64 * 256, 256, 64 * (r / 2), 32 * (r % 2), 1, 0, scr, F.lane); }
    }
    rms_rows(P, F, layer, xin, (bf16*)(ws + WS_H));
}

__device__ __forceinline__ void rope_sincos(float pos, int i, float& cs, float& sn) {
    constexpr float INV[8] = {1.0f, 0.1939227432012558f, 0.03760603070259094f, 0.007292664609849453f, 0.0014142135623842478f, 0.00027424818836152554f, 5.3182957344688475e-05f, 1.0313385246263351e-05f};
    const float ang = pos * INV[i];
    double rev = (double)ang * 0.15915494309189535; rev -= floor(rev);
    const float fr = (float)rev;
    sn = __builtin_amdgcn_sinf(fr); cs = __builtin_amdgcn_cosf(fr);
}
__device__ __forceinline__ void norm_load(const bf16* rowp, const float* g, bool rope, int t, float (&v)[64]) {
    float ss = 0.f;
#pragma unroll
    for (int j = 0; j < 8; ++j) { const u32x4 w = ((const u32x4*)rowp)[j];
        v[8 * j + 0] = bflo(w.x); v[8 * j + 1] = bfhi(w.x); v[8 * j + 2] = bflo(w.y); v[8 * j + 3] = bfhi(w.y);
        v[8 * j + 4] = bflo(w.z); v[8 * j + 5] = bfhi(w.z); v[8 * j + 6] = bflo(w.w); v[8 * j + 7] = bfhi(w.w); }
#pragma unroll
    for (int d = 0; d < 64; ++d) ss += v[d] * v[d];
    const float rs = rsqrtf(ss * (1.f / 64.f) + RMS_EPS);
#pragma unroll
    for (int d = 0; d < 64; ++d) v[d] = v[d] * rs * g[d];
    if (rope) {
#pragma unroll
        for (int i = 0; i < 8; ++i) { float cs, sn; rope_sincos((float)t, i, cs, sn); const float a = v[i], b = v[i + 8]; v[i] = a * cs - b * sn; v[i + 8] = b * cs + a * sn; }
    }
}
__device__ __forceinline__ void norm_store(const Frame& F, const float (&v)[64], float osc, bf16* rowp, int kstream, int t) {
    bf16* dst = kstream < 0 ? rowp : (bf16*)(F.ws + WS_KF) + (size_t)kstream * STREAM_ELEMS + ((size_t)(t >> 5) * 256 + (t & 31)) * 8;
#pragma unroll
    for (int j = 0; j < 8; ++j) {
        u32x4 w; w.x = cvt_pk_bf16(v[8 * j] * osc, v[8 * j + 1] * osc); w.y = cvt_pk_bf16(v[8 * j + 2] * osc, v[8 * j + 3] * osc);
        w.z = cvt_pk_bf16(v[8 * j + 4] * osc, v[8 * j + 5] * osc); w.w = cvt_pk_bf16(v[8 * j + 6] * osc, v[8 * j + 7] * osc);
        bf16* p = kstream < 0 ? dst + 8 * j : dst + ((j >> 1) * 64 + (j & 1) * 32) * 8;
        *(u32x4*)p = w;
    }
}
__device__ __forceinline__ void p2_normrow(const Params& P, const Frame& F, int layer, int idx) {
    const int t = idx / 24, slot = idx - t * 24;
    int col, kstream = -1; const float* g; bool rope = true; float osc = 1.f;
    if (slot < 6) { col = C_MQ + slot * 64; g = P.moba_qk_g + layer * 128; osc = C2; }
    else if (slot < 10) { col = C_NQ + (slot - 6) * 64; g = P.nsa_q_g + layer * 64; osc = C2; }
    else if (slot == 10) { col = C_KSL; g = P.nsa_k_g + layer * 192 + 64; kstream = 6; }
    else if (slot == 11) { col = C_KW; g = P.nsa_k_g + layer * 192 + 128; kstream = 7; }
    else if (slot < 18) { col = C_FQ + (slot - 12) * 64; g = P.fox_qk_g + layer * 128; rope = false; osc = C2; }
    else { col = C_FK + (slot - 18) * 64; g = P.fox_qk_g + layer * 128 + 64; rope = false; kstream = 8 + (slot - 18); }
    bf16* rowp = F.PA + (size_t)t * PAC + col;
    float v[64];
    norm_load(rowp, g, rope, t, v);
    norm_store(F, v, osc, rowp, kstream, t);
}
__device__ __forceinline__ void p2_mk_unit(const Params& P, const Frame& F, int layer, int u) {
    const int blk = u / 3, pr = u - blk * 3, head = pr * 2 + (F.tid >> 8), t = blk * 256 + (F.tid & 255);
    bf16* rowp = F.PA + (size_t)t * PAC + C_MK + head * 64;
    float v[64];
    norm_load(rowp, P.moba_qk_g + layer * 128 + 64, true, t, v);
    norm_store(F, v, 1.f, rowp, head, t);
    float mine = 0.f;
#pragma unroll
    for (int d = 0; d < 64; ++d) { const float s = wave_sum(v[d], F.lane); mine = (F.lane == d) ? s : mine; }
    LAS float* part = (LAS float*)F.lds;
    part[F.wave * 64 + F.lane] = mine;
    __syncthreads();
    if (F.tid < 128) { const int hh = F.tid >> 6, d = F.tid & 63;
        const float s = (part[(hh * 4 + 0) * 64 + d] + part[(hh * 4 + 1) * 64 + d]) + (part[(hh * 4 + 2) * 64 + d] + part[(hh * 4 + 3) * 64 + d]);
        ((float*)(F.ws + WS_KMEAN))[((pr * 2 + hh) * 64 + blk) * 64 + d] = s * (1.f / 256.f); }
    __syncthreads();
}
__device__ __forceinline__ void p2_vfrag4(const Frame& F, size_t f0, size_t fstride, size_t fend) {
    unsigned short e[4][8]; size_t dsto[4]; bool ok[4];
#pragma unroll
    for (int q = 0; q < 4; ++q) {
        const size_t f = f0 + (size_t)q * fstride; ok[q] = f < fend; const size_t ff = ok[q] ? f : f0;
        const int st = (int)(ff >> 17); const int r = (int)(ff & 131071);
        const int T = r >> 8, dt = (r >> 7) & 1, s = (r >> 6) & 1, ln = r & 63, c = ln & 31, hg = ln >> 5;
        const int col0 = st < 6 ? C_MV + st * 64 : (st == 6 ? C_VSL : (st == 7 ? C_VW : C_FV + (st - 8) * 64));
        const bf16* src = F.PA + (size_t)(32 * T + 16 * s + 4 * hg) * PAC + col0 + dt * 32 + c;
#pragma unroll
        for (int j = 0; j < 8; ++j) e[q][j] = src[(size_t)((j & 3) + 8 * (j >> 2)) * PAC];
        dsto[q] = (size_t)st * STREAM_ELEMS + (size_t)r * 8;
    }
#pragma unroll
    for (int q = 0; q < 4; ++q) if (ok[q]) {
        u32x4 w; w.x = e[q][0] | ((unsigned)e[q][1] << 16); w.y = e[q][2] | ((unsigned)e[q][3] << 16); w.z = e[q][4] | ((unsigned)e[q][5] << 16); w.w = e[q][6] | ((unsigned)e[q][7] << 16);
        *(u32x4*)((bf16*)(F.ws + WS_VF) + dsto[q]) = w;
    }
}
__device__ __forceinline__ void p2_compress(const Params& P, const Frame& F, int layer, int item) {
    const int kv = item >> 5, T = item & 31, lane = F.lane, c = lane & 31, hg = lane >> 5, w = F.wave;
    const int col0 = C_KC + kv * 64;
    const bf16x8* W1F = (const bf16x8*)((const bf16*)(F.ws + WS_W1T) + (size_t)kv * 256 * 2048) + (size_t)w * 128 * 64 + lane;
    const bf16* W2T = (const bf16*)(F.ws + WS_W2T) + (size_t)kv * 64 * 256;
    LAS float* pel = (LAS float*)(F.lds + 16384);
    { const float* pe = P.cmp_pe + (size_t)(layer * 2 + kv) * 2048; for (int i = F.tid; i < 512; i += 512) ((LAS f32x4*)pel)[i] = ((const f32x4*)pe)[i]; }
    __syncthreads();
    f32x16 acc;
#pragma unroll
    for (int r = 0; r < 16; ++r) acc[r] = 0.f;
    const int blk = 32 * T + c;
    const int rowb = 16 * blk;
#pragma unroll 16
    for (int ks = 0; ks < 128; ++ks) {
        const int pos = ks >> 2, dsub = (ks & 3) * 16;
        int row = rowb + pos; row = row > SEQ - 1 ? SEQ - 1 : row;
        const u32x4 bw = *(const u32x4*)(F.PA + (size_t)row * PAC + col0 + dsub + hg * 8);
        const f32x4 p0 = *(const LAS f32x4*)(pel + ks * 16 + hg * 8), p1 = *(const LAS f32x4*)(pel + ks * 16 + hg * 8 + 4);
        u32x4 bs; bs.x = cvt_pk_bf16(bflo(bw.x) + p0[0], bfhi(bw.x) + p0[1]); bs.y = cvt_pk_bf16(bflo(bw.y) + p0[2], bfhi(bw.y) + p0[3]);
        bs.z = cvt_pk_bf16(bflo(bw.z) + p1[0], bfhi(bw.z) + p1[1]); bs.w = cvt_pk_bf16(bflo(bw.w) + p1[2], bfhi(bw.w) + p1[3]);
        const bf16x8 a = W1F[ks * 64];
        acc = MFMA32(a, __builtin_bit_cast(bf16x8, bs), acc);
    }
    LAS u32x4* hid = (LAS u32x4*)F.lds;
#pragma unroll
    for (int s = 0; s < 2; ++s) {
        float hv[8];
#pragma unroll
        for (int r = 0; r < 8; ++r) hv[r] = siluf_(acc[8 * s + r]);
        u32x4 pw4; pw4.x = cvt_pk_bf16(hv[0], hv[1]); pw4.y = cvt_pk_bf16(hv[2], hv[3]); pw4.z = cvt_pk_bf16(hv[4], hv[5]); pw4.w = cvt_pk_bf16(hv[6], hv[7]);
        hid[(w * 2 + s) * 64 + lane] = pw4;
    }
    __syncthreads();
    if (w == 0) {
        f32x16 o[2];
#pragma unroll
        for (int r = 0; r < 16; ++r) { o[0][r] = 0.f; o[1][r] = 0.f; }
#pragma unroll
        for (int nt = 0; nt < 8; ++nt)
#pragma unroll
            for (int s = 0; s < 2; ++s) {
                const bf16x8 pb = __builtin_bit_cast(bf16x8, hid[(nt * 2 + s) * 64 + lane]);
#pragma unroll
                for (int dt = 0; dt < 2; ++dt) {
                    const bf16* wp = W2T + (size_t)(dt * 32 + c) * 256 + nt * 32 + 16 * s + 4 * hg;
                    const u32x2 lo = *(const u32x2*)wp, hi = *(const u32x2*)(wp + 8);
                    u32x4 aw; aw.x = lo.x; aw.y = lo.y; aw.z = hi.x; aw.w = hi.y;
                    o[dt] = MFMA32(__builtin_bit_cast(bf16x8, aw), pb, o[dt]);
                }
            }
        if (kv == 0) {
            const float* g = P.nsa_k_g + layer * 192;
            float ss = 0.f;
#pragma unroll
            for (int dt = 0; dt < 2; ++dt)
#pragma unroll
                for (int r = 0; r < 16; ++r) ss += o[dt][r] * o[dt][r];
            ss += shx(ss, 32, lane);
            const float rs = rsqrtf(ss * (1.f / 64.f) + RMS_EPS);
#pragma unroll
            for (int dt = 0; dt < 2; ++dt)
#pragma unroll
                for (int r = 0; r < 16; ++r) o[dt][r] = o[dt][r] * rs * g[dt * 32 + crow(r, hg)];
            const float pos = (float)(16 * blk + 31);
#pragma unroll
            for (int r = 0; r < 4; ++r) {
                float c0, s0, c1, s1; rope_sincos(pos, r, c0, s0); rope_sincos(pos, r + 4, c1, s1);
                const float cs = hg ? c1 : c0, sn = hg ? s1 : s0;
                const float a = o[0][r], b = o[0][r + 4]; o[0][r] = a * cs - b * sn; o[0][r + 4] = b * cs + a * sn;
            }
            bf16* KC = (bf16*)(F.ws + WS_KCMP);
#pragma unroll
            for (int dt = 0; dt < 2; ++dt)
#pragma unroll
                for (int gq = 0; gq < 4; ++gq) {
                    const int ks = dt * 2 + (gq >> 1), hgp = gq & 1;
                    u32x2 wv; wv.x = cvt_pk_bf16(o[dt][4 * gq], o[dt][4 * gq + 1]); wv.y = cvt_pk_bf16(o[dt][4 * gq + 2], o[dt][4 * gq + 3]);
                    *(u32x2*)(KC + ((size_t)(T * 4 + ks) * 64 + hgp * 32 + c) * 8 + 4 * hg) = wv;
                }
        } else {
            bf16* VC = (bf16*)(F.ws + WS_VCMP);
            const int s = c >> 4, hgp = (c >> 2) & 1, j = ((c >> 3) & 1) * 4 + (c & 3);
#pragma unroll
            for (int dt = 0; dt < 2; ++dt)
#pragma unroll
                for (int r = 0; r < 16; ++r)
                    VC[((size_t)((T * 2 + dt) * 2 + s) * 64 + hgp * 32 + crow(r, hg)) * 8 + j] = f2bf(o[dt][r]);
        }
    }
    __syncthreads();
}
#ifdef PROBE_P2PART
#define P2T(i) do { if (PROBE_P2PART == (i)) { const unsigned long long _t = __builtin_amdgcn_s_memrealtime(); if ((F.gw >> 3) == PROBE_P2BLK && F.tid == 0) p2acc += (long long)(_t); } } while (0)
#define P2T0(i) do { if (PROBE_P2PART == (i)) { const unsigned long long _t = __builtin_amdgcn_s_memrealtime(); if ((F.gw >> 3) == PROBE_P2BLK && F.tid == 0) p2acc -= (long long)(_t); } } while (0)
#else
#define P2T(i) do {} while (0)
#define P2T0(i) do {} while (0)
#endif
__device__ __forceinline__ void phase2(const Params& P, const Frame& F, int layer, long long& p2acc) {
    const int G = F.NGW >> 3, bxv = F.gw >> 3;
    const bool split = G >= 128;
    if (bxv < 64) { p2_compress(P, F, layer, bxv); if (split) return; }
    if (!split && G < 64) { for (int u = bxv + G; u < 64; u += G) p2_compress(P, F, layer, u); }
    const int vgw = split ? F.gw - 512 : F.gw, VN = split ? F.NGW - 512 : F.NGW, vbx = split ? bxv - 64 : bxv, VG = split ? G - 64 : G;
    for (int it = vgw; it < 6 * 256; it += VN) {
        const int h = it >> 8, ch = it & 255, t = ch * 64 + F.lane;
        const float z = bf2f(F.PA[(size_t)t * PAC + C_FF + h]) + P.b_f[layer * 6 + h];
        float v = (fminf(z, 0.f) - log1pf(__expf(-fabsf(z)))) * LOG2E;
#pragma unroll
        for (int o = 1; o < 64; o <<= 1) { const float y = shfrom(v, (F.lane - o) & 63); if (F.lane >= o) v += y; }
        ((float*)(F.ws + WS_CS))[h * SEQ + t] = v;
        if (F.lane == 63) ((float*)(F.ws + WS_CSTOT))[h * 256 + ch] = v;
    }
    for (int u = vbx; u < 192; u += VG) p2_mk_unit(P, F, layer, u);
    for (int it = vgw; it < SEQ * 24 / 64; it += VN) p2_normrow(P, F, layer, it * 64 + F.lane);
    for (int it = vgw; it < 14 * 131072 / 64; it += 4 * VN) p2_vfrag4(F, (size_t)it * 64 + F.lane, (size_t)VN * 64, (size_t)14 * 131072);
    (void)p2acc;
}

__device__ __forceinline__ int list_off(int j) { return 256 * (63 * j - (j * (j - 1)) / 2); }
constexpr int LIST_HEAD = 256 * 2016;
__device__ __forceinline__ void p3_unit(const Params& P, const Frame& F, int layer, int kind, int uidx) {
    if (kind == 0) for (int it = uidx * 8 + F.wave; it < uidx * 8 + 8; it += 8) {
        const int h = it >> 8, ch = it & 255;
        const float* tot = (const float*)(F.ws + WS_CSTOT) + h * 256;
        float s = 0.f;
        for (int cc = F.lane; cc < ch; cc += 64) s += tot[cc];
        s = wave_sum(s, F.lane);
        float* cs = (float*)(F.ws + WS_CS) + h * SEQ + ch * 64 + F.lane;
        *cs = *cs + s;
    }
    unsigned* cnt = (unsigned*)(F.ws + WS_CTL) + 1024 + 16384 * layer;
    unsigned short* LIST = (unsigned short*)(F.ws + WS_LIST);
    LAS float* kml = (LAS float*)F.lds;
    if (kind == 1) for (int u = uidx; u < uidx + 1; ++u) {
        const int h = u >> 5, t = (u & 31) * 512 + F.tid, cur = t >> 8, nb = (((u & 31) * 512 + 511) >> 8);
        const float* km = (const float*)(F.ws + WS_KMEAN) + (size_t)h * 64 * 64;
        LAS unsigned* lcnt = (LAS unsigned*)(F.lds + 32768); LAS unsigned* lbase = lcnt + 64;
        for (int i = F.tid; i < nb * 16; i += 512) ((LAS f32x4*)kml)[i] = ((const f32x4*)km)[i];
        if (F.tid < 64) lcnt[F.tid] = 0u;
        __syncthreads();
        int i1 = -1, i2 = -1, i3 = -1; unsigned p1 = 0, p2 = 0, p3 = 0;
        if (cur > 0) {
            const bf16* qrow = F.PA + (size_t)t * PAC + C_MQ + h * 64;
            float qv[64];
#pragma unroll
            for (int j = 0; j < 8; ++j) { const u32x4 w = ((const u32x4*)qrow)[j];
                qv[8 * j + 0] = bflo(w.x); qv[8 * j + 1] = bfhi(w.x); qv[8 * j + 2] = bflo(w.y); qv[8 * j + 3] = bfhi(w.y);
                qv[8 * j + 4] = bflo(w.z); qv[8 * j + 5] = bfhi(w.z); qv[8 * j + 6] = bflo(w.w); qv[8 * j + 7] = bfhi(w.w); }
            float v1 = -3e38f, v2 = -3e38f, v3 = -3e38f;
            for (int j = 0; j < cur; ++j) {
                float g0 = 0.f, g1 = 0.f;
#pragma unroll
                for (int d4 = 0; d4 < 16; ++d4) { const f32x4 k4 = ((const LAS f32x4*)kml)[j * 16 + d4];
                    g0 += qv[4 * d4] * k4[0]; g1 += qv[4 * d4 + 1] * k4[1]; g0 += qv[4 * d4 + 2] * k4[2]; g1 += qv[4 * d4 + 3] * k4[3]; }
                const float g = g0 + g1;
                if (g > v3) { if (g > v2) { v3 = v2; i3 = i2; if (g > v1) { v2 = v1; i2 = i1; v1 = g; i1 = j; } else { v2 = g; i2 = j; } } else { v3 = g; i3 = j; } }
            }
            if (i1 >= 0) p1 = __hip_atomic_fetch_add(lcnt + i1, 1u, __ATOMIC_RELAXED, __HIP_MEMORY_SCOPE_WORKGROUP);
            if (i2 >= 0) p2 = __hip_atomic_fetch_add(lcnt + i2, 1u, __ATOMIC_RELAXED, __HIP_MEMORY_SCOPE_WORKGROUP);
            if (i3 >= 0) p3 = __hip_atomic_fetch_add(lcnt + i3, 1u, __ATOMIC_RELAXED, __HIP_MEMORY_SCOPE_WORKGROUP);
        }
        __syncthreads();
        if (F.tid < 64) { const unsigned c = lcnt[F.tid]; lbase[F.tid] = c ? __hip_atomic_fetch_add(cnt + (h * 64 + F.tid) * 32, c, __ATOMIC_RELAXED, __HIP_MEMORY_SCOPE_AGENT) : 0u; }
        __syncthreads();
        if (i1 >= 0) LIST[(size_t)h * LIST_HEAD + list_off(i1) + lbase[i1] + p1] = (unsigned short)((t << 2) | 0);
        if (i2 >= 0) LIST[(size_t)h * LIST_HEAD + list_off(i2) + lbase[i2] + p2] = (unsigned short)((t << 2) | 1);
        if (i3 >= 0) LIST[(size_t)h * LIST_HEAD + list_off(i3) + lbase[i3] + p3] = (unsigned short)((t << 2) | 2);
        __syncthreads();
    }
}

constexpr int RING_OFF = 65536;
__device__ __forceinline__ f32x16 qk_lds(LAS unsigned char* buf, const bf16x8 (&qf)[4], int lane, float init = 0.f) {
    const LAS bf16x8* p = (const LAS bf16x8*)buf + lane;
    f32x16 s;
#pragma unroll
    for (int r = 0; r < 16; ++r) s[r] = init;
    const bf16x8 k0 = p[0], k1 = p[64], k2 = p[128], k3 = p[192];
    __builtin_amdgcn_s_setprio(1);
    s = MFMA32(k0, qf[0], s); s = MFMA32(k1, qf[1], s); s = MFMA32(k2, qf[2], s); s = MFMA32(k3, qf[3], s);
    __builtin_amdgcn_s_setprio(0);
    return s;
}
__device__ __forceinline__ void pv_lds(LAS unsigned char* buf, const float (&e)[16], f32x16 (&o)[2], int lane) {
    const LAS bf16x8* p = (const LAS bf16x8*)(buf + 4096) + lane;
    u32x4 w0, w1;
    w0.x = cvt_pk_bf16(e[0], e[1]); w0.y = cvt_pk_bf16(e[2], e[3]); w0.z = cvt_pk_bf16(e[4], e[5]); w0.w = cvt_pk_bf16(e[6], e[7]);
    w1.x = cvt_pk_bf16(e[8], e[9]); w1.y = cvt_pk_bf16(e[10], e[11]); w1.z = cvt_pk_bf16(e[12], e[13]); w1.w = cvt_pk_bf16(e[14], e[15]);
    const bf16x8 pb0 = __builtin_bit_cast(bf16x8, w0), pb1 = __builtin_bit_cast(bf16x8, w1);
    const bf16x8 v0 = p[0], v1 = p[64], v2 = p[128], v3 = p[192];
    __builtin_amdgcn_s_setprio(1);
    o[0] = MFMA32(v0, pb0, o[0]); o[1] = MFMA32(v2, pb0, o[1]); o[0] = MFMA32(v1, pb1, o[0]); o[1] = MFMA32(v3, pb1, o[1]);
    __builtin_amdgcn_s_setprio(0);
}
__device__ __forceinline__ float gain_bound(const float* gq, const float* gk, int lane) {
    const float a = wave_max(fabsf(gq[lane]), lane), b = wave_max(fabsf(gk[lane]), lane);
    return (8.f * a * b * 1.02f + 0.05f) * LOG2E;
}
__device__ __forceinline__ void write_gated(const Frame& F, const f32x16 (&o)[2], float scale, int t, int ocol, int zcol, int hg) {
    bf16* rowp = F.PA + (size_t)t * PAC;
#pragma unroll
    for (int dt = 0; dt < 2; ++dt)
#pragma unroll
        for (int g = 0; g < 4; ++g) {
            const int d0 = dt * 32 + 8 * g + 4 * hg;
            const u32x2 z = *(const u32x2*)(rowp + zcol + d0);
            u32x2 w;
            w.x = cvt_pk_bf16(o[dt][4 * g] * scale * siluf_(bflo(z.x)), o[dt][4 * g + 1] * scale * siluf_(bfhi(z.x)));
            w.y = cvt_pk_bf16(o[dt][4 * g + 2] * scale * siluf_(bflo(z.y)), o[dt][4 * g + 3] * scale * siluf_(bfhi(z.y)));
            *(u32x2*)(rowp + ocol + d0) = w;
        }
}
#define ZERO_O(o) do { _Pragma("unroll") for (int _r = 0; _r < 16; ++_r) { o[0][_r] = 0.f; o[1][_r] = 0.f; } } while (0)
__device__ __forceinline__ void glds16(const void* gsrc, unsigned lds_dst) { unsigned keep;
    asm volatile("s_mov_b32 %0, m0\n\ts_mov_b32 m0, %2\n\ts_nop 0\n\tglobal_load_lds_dwordx4 %1, off\n\ts_mov_b32 m0, %0" : "=&s"(keep) : "v"(gsrc), "s"(lds_dst) : "memory"); }
__device__ __forceinline__ unsigned lds_addr(LAS unsigned char* p) { return (unsigned)(size_t)p; }
#define SBAR() do { asm volatile("" ::: "memory"); __builtin_amdgcn_s_barrier(); asm volatile("" ::: "memory"); } while (0)
#define VMW(n) asm volatile("s_waitcnt vmcnt(" #n ")" ::: "memory")
#define DMA2(p) do { _Pragma("unroll") for (int _q = 0; _q < 2; ++_q) \
    glds16(_src + (ptrdiff_t)(2 * (p) + _q) * _st, (unsigned)__builtin_amdgcn_readfirstlane(_ringa + (unsigned)((((p) & 3) * 2 + _q) * 8192) + _wo)); } while (0)
#define STREAM_BEGIN(KFp, VFp, TFIRST, STEP, NTILES) { \
    const int _nt = (NTILES), _n = (_nt + 1) >> 1; \
    const char* _src = (const char*)((F.wave < 4) ? (KFp) : (VFp)) + (ptrdiff_t)(TFIRST) * 4096 + (F.wave & 3) * 1024 + F.lane * 16; \
    const ptrdiff_t _st = (ptrdiff_t)(STEP) * 4096; \
    LAS unsigned char* _ring = F.lds + RING_OFF; const unsigned _wo = (unsigned)F.wave * 1024u; const unsigned _ringa = lds_addr(_ring); \
    asm volatile("s_waitcnt vmcnt(0) lgkmcnt(0)" ::: "memory"); SBAR(); \
    if (_n > 0) DMA2(0); if (_n > 1) DMA2(1); if (_n > 2) DMA2(2); \
    for (int _i = 0; _i < _n; ++_i) { \
        if (_i + 2 < _n) VMW(4); else if (_i + 1 < _n) VMW(2); else VMW(0); \
        asm volatile("s_waitcnt lgkmcnt(0)" ::: "memory"); SBAR(); \
        if (_i + 3 < _n) DMA2(_i + 3); \
        _Pragma("unroll") for (int _s = 0; _s < 2; ++_s) { \
            const int T = (TFIRST) + (2 * _i + _s) * (STEP); LAS unsigned char* _buf = _ring + ((_i & 3) * 2 + _s) * 8192; \
            if (2 * _i + _s < _nt) {
#define STREAM_END } } } asm volatile("s_waitcnt vmcnt(0) lgkmcnt(0)" ::: "memory"); SBAR(); }
#define STREAM2_BEGIN(KFp, VFp, TFIRST, STEP, NTILES) { \
    const int _nt = (NTILES), _n = (_nt + 1) >> 1; \
    const char* _src = (const char*)((F.wave < 4) ? (KFp) : (VFp)) + (ptrdiff_t)(TFIRST) * 4096 + (F.wave & 3) * 1024 + F.lane * 16; \
    const ptrdiff_t _st = (ptrdiff_t)(STEP) * 4096; \
    LAS unsigned char* _ring = F.lds + RING_OFF; const unsigned _wo = (unsigned)F.wave * 1024u; const unsigned _ringa = lds_addr(_ring); \
    asm volatile("s_waitcnt vmcnt(0) lgkmcnt(0)" ::: "memory"); SBAR(); \
    if (_n > 0) DMA2(0); if (_n > 1) DMA2(1); if (_n > 2) DMA2(2); \
    for (int _i = 0; _i < _n; ++_i) { \
        if (_i + 2 < _n) VMW(4); else if (_i + 1 < _n) VMW(2); else VMW(0); \
        asm volatile("s_waitcnt lgkmcnt(0)" ::: "memory"); SBAR(); \
        if (_i + 3 < _n) DMA2(_i + 3); \
        const int T0 = (TFIRST) + (2 * _i) * (STEP), T1 = T0 + (STEP); const bool _v0 = true, _v1 = (2 * _i + 1 < _nt); \
        LAS unsigned char* _b0 = _ring + ((_i & 3) * 2) * 8192; LAS unsigned char* _b1 = _b0 + 8192;
#define STREAM2_END } asm volatile("s_waitcnt vmcnt(0) lgkmcnt(0)" ::: "memory"); SBAR(); }
template <class EF>
__device__ __forceinline__ void do_pair(bool ok0, bool ok1, LAS unsigned char* b0, LAS unsigned char* b1, int T0, int T1, const bf16x8 (&qf)[4], f32x16 (&o)[2], float& l, int lane, float nsh, EF ef) {
    if (ok0 && ok1) {
        const f32x16 s0 = qk_lds(b0, qf, lane, nsh), s1 = qk_lds(b1, qf, lane, nsh);
        float e0[16], e1[16];
#pragma unroll
        for (int r = 0; r < 16; ++r) { e0[r] = ef(T0, r, s0[r]); e1[r] = ef(T1, r, s1[r]); l += e0[r] + e1[r]; }
        pv_lds(b0, e0, o, lane); pv_lds(b1, e1, o, lane);
    } else if (ok0 || ok1) {
        LAS unsigned char* b = ok0 ? b0 : b1; const int T = ok0 ? T0 : T1;
        const f32x16 s = qk_lds(b, qf, lane, nsh);
        float e[16];
#pragma unroll
        for (int r = 0; r < 16; ++r) { e[r] = ef(T, r, s[r]); l += e[r]; }
        pv_lds(b, e, o, lane);
    }
}

__device__ __forceinline__ int first_keep(const float* cs, float cs0, float lim, int Tmax, int lane) {
    const int c1 = lane * 8;
    const bool k1 = c1 >= Tmax ? true : (cs0 - cs[32 * c1 + 31] >= lim);
    const unsigned long long b1 = __ballot(k1);
    const int f1 = b1 ? __builtin_ctzll(b1) : 64;
    if (f1 == 0) return 0;
    const int base = 8 * (f1 - 1) + 1, c2 = base + lane;
    const bool k2 = lane < 8 ? (c2 >= Tmax ? true : (cs0 - cs[32 * c2 + 31] >= lim)) : false;
    const unsigned long long b2 = __ballot(k2);
    const int r = base + (b2 ? __builtin_ctzll(b2) : 7);
    return r < Tmax ? r : Tmax;
}
__device__ __forceinline__ void wg_fox(const Params& P, const Frame& F, int layer, int h, int qb) {
    const int lane = F.lane, c = lane & 31, hg = lane >> 5, w = F.wave, t0 = qb * 256 + 32 * w, t = t0 + c;
    const float SH = gain_bound(P.fox_qk_g + layer * 128, P.fox_qk_g + layer * 128 + 64, lane);
    const float* cs = (const float*)(F.ws + WS_CS) + (size_t)h * SEQ;
    const bf16* qrow = F.PA + (size_t)t * PAC + C_FQ + h * 64;
    bf16x8 qf[4];
#pragma unroll
    for (int ks = 0; ks < 4; ++ks) qf[ks] = *(const bf16x8*)(qrow + ks * 16 + hg * 8);
    const float cq = cs[t];
    const float lim = -(2.f * SH + 40.f);
    const int Thw = qb * 8 + w, THI = qb * 8 + 7;
    int low = first_keep(cs, cs[t0], lim, Thw, lane), LO = first_keep(cs, cs[qb * 256], lim, qb * 8, lane);
    low = __builtin_amdgcn_readfirstlane(low); LO = __builtin_amdgcn_readfirstlane(LO);
    const bf16* KF = (const bf16*)(F.ws + WS_KF) + (size_t)(8 + h) * STREAM_ELEMS;
    const bf16* VF = (const bf16*)(F.ws + WS_VF) + (size_t)(8 + h) * STREAM_ELEMS;
    f32x16 o[2]; ZERO_O(o); float l = 0.f;
    const int LOp = LO > 0 ? LO - 1 : 0, kbase = 32 * LOp, ncs = (THI - LOp + 1) * 32;
    LAS float* csl = (LAS float*)F.lds;
    for (int i = F.tid; i < ncs; i += 512) csl[i] = cs[kbase + i];
    STREAM2_BEGIN(KF, VF, THI, -1, THI - LO + 1)
        do_pair(_v0 && T0 <= Thw && T0 >= low, _v1 && T1 <= Thw && T1 >= low, _b0, _b1, T0, T1, qf, o, l, lane, -SH,
                [=](int T, int r, float sv) { const int key = 32 * T + crow(r, hg); const float ck = csl[key - kbase];
                    return key <= t ? __builtin_amdgcn_exp2f(sv + (cq - ck)) : 0.f; });
    STREAM2_END
    l += shx(l, 32, lane);
    write_gated(F, o, l > 0.f ? 1.f / l : 0.f, t, C_OF + h * 64, C_FZ + h * 64, hg);
}

__device__ __forceinline__ void moba_load_block(const Frame& F, int h, int j) {
    const bf16* src = (const bf16*)(F.ws + (F.tid < 256 ? WS_KF : WS_VF)) + (size_t)h * STREAM_ELEMS + (size_t)(j * 8) * 2048 + (F.tid & 255) * 8;
    u32x4 r[8];
#pragma unroll
    for (int tt = 0; tt < 8; ++tt) r[tt] = *(const u32x4*)(src + tt * 2048);
#pragma unroll
    for (int tt = 0; tt < 8; ++tt) *(LAS u32x4*)(F.lds + RING_OFF + tt * 8192 + F.tid * 16) = r[tt];
    __syncthreads();
}
__device__ __forceinline__ bf16* moba_part(const Frame& F, int h, int t, int slot) {
    return slot == 0 ? F.PA + (size_t)t * PAC + C_FK + h * 64 : (slot == 1 ? F.PA + (size_t)t * PAC + C_FV + h * 64 : (bf16*)(F.ws + WS_P2) + ((size_t)h * SEQ + t) * 64);
}
__device__ __forceinline__ void wg_moba_own(const Params& P, const Frame& F, int layer, int h, int blk) {
    const int lane = F.lane, c = lane & 31, hg = lane >> 5, w = F.wave, t0 = blk * 256 + 32 * w, t = t0 + c;
    const float SH = gain_bound(P.moba_qk_g + layer * 128, P.moba_qk_g + layer * 128 + 64, lane);
    const bf16* qrow = F.PA + (size_t)t * PAC + C_MQ + h * 64;
    bf16x8 qf[4];
#pragma unroll
    for (int ks = 0; ks < 4; ++ks) qf[ks] = *(const bf16x8*)(qrow + ks * 16 + hg * 8);
    moba_load_block(F, h, blk);
    f32x16 o[2]; ZERO_O(o); float l = 0.f;
    for (int tp = 0; 2 * tp <= w; ++tp) {
        LAS unsigned char* b0 = F.lds + RING_OFF + (2 * tp) * 8192;
        do_pair(true, 2 * tp + 1 <= w, b0, b0 + 8192, blk * 8 + 2 * tp, blk * 8 + 2 * tp + 1, qf, o, l, lane, -SH,
                [=](int T, int r, float sv) { const int key = 32 * T + crow(r, hg); return key <= t ? __builtin_amdgcn_exp2f(sv) : 0.f; });
    }
    l += shx(l, 32, lane);
    bf16* rowp = F.PA + (size_t)t * PAC + C_OM + h * 64;
#pragma unroll
    for (int dt = 0; dt < 2; ++dt)
#pragma unroll
        for (int g = 0; g < 4; ++g) { u32x2 wv; wv.x = cvt_pk_bf16(o[dt][4 * g], o[dt][4 * g + 1]); wv.y = cvt_pk_bf16(o[dt][4 * g + 2], o[dt][4 * g + 3]);
            *(u32x2*)(rowp + dt * 32 + 8 * g + 4 * hg) = wv; }
    if (hg == 0) ((float*)(F.ws + WS_LOWN))[h * SEQ + t] = l;
    __syncthreads();
}
__device__ __forceinline__ void wg_moba_sel(const Params& P, const Frame& F, int layer, int h, int j) {
    const int lane = F.lane, c = lane & 31, hg = lane >> 5, w = F.wave;
    const int n = (int)((const unsigned*)(F.ws + WS_CTL))[1024 + 16384 * layer + (h * 64 + j) * 32];
    if (n == 0) return;
    const float SH = gain_bound(P.moba_qk_g + layer * 128, P.moba_qk_g + layer * 128 + 64, lane);
    moba_load_block(F, h, j);
    const unsigned short* list = (const unsigned short*)(F.ws + WS_LIST) + (size_t)h * LIST_HEAD + list_off(j);
    float* LPART = (float*)(F.ws + WS_LPART);
    bool valid = false; unsigned ent = 0u; bf16x8 qf[4];
    if (w * 32 < n) { const int i = w * 32 + c; valid = i < n; ent = list[valid ? i : w * 32];
        const bf16* qrow = F.PA + (size_t)(ent >> 2) * PAC + C_MQ + h * 64;
#pragma unroll
        for (int ks = 0; ks < 4; ++ks) qf[ks] = *(const bf16x8*)(qrow + ks * 16 + hg * 8); }
    for (int cb = w * 32; cb < n; cb += 256) {
        const int cbn = cb + 256; bool validn = false; unsigned entn = 0u; bf16x8 qfn[4];
        if (cbn < n) { const int in = cbn + c; validn = in < n; entn = list[validn ? in : cbn];
            const bf16* qrn = F.PA + (size_t)(entn >> 2) * PAC + C_MQ + h * 64;
#pragma unroll
            for (int ks = 0; ks < 4; ++ks) qfn[ks] = *(const bf16x8*)(qrn + ks * 16 + hg * 8); }
        const int t = (int)(ent >> 2), slot = (int)(ent & 3u);
        f32x16 o[2]; ZERO_O(o); float l = 0.f;
        for (int tp = 0; tp < 4; ++tp) {
            LAS unsigned char* b0 = F.lds + RING_OFF + (2 * tp) * 8192;
            do_pair(true, true, b0, b0 + 8192, 0, 0, qf, o, l, lane, -SH, [=](int, int, float sv) { return __builtin_amdgcn_exp2f(sv); });
        }
        l += shx(l, 32, lane);
        if (valid) {
            const size_t rec = ((size_t)h * SEQ + t) * 3 + slot;
            bf16* pp = moba_part(F, h, t, slot);
#pragma unroll
            for (int dt = 0; dt < 2; ++dt)
#pragma unroll
                for (int g = 0; g < 4; ++g) { u32x2 wv; wv.x = cvt_pk_bf16(o[dt][4 * g], o[dt][4 * g + 1]); wv.y = cvt_pk_bf16(o[dt][4 * g + 2], o[dt][4 * g + 3]);
                    *(u32x2*)(pp + dt * 32 + 8 * g + 4 * hg) = wv; }
            if (hg == 0) LPART[rec] = l;
        }
        valid = validn; ent = entn;
#pragma unroll
        for (int ks = 0; ks < 4; ++ks) qf[ks] = qfn[ks];
    }
    __syncthreads();
}

__device__ __forceinline__ void wg_nsa(const Params& P, const Frame& F, int layer, int qb) {
    const int lane = F.lane, c = lane & 31, hg = lane >> 5, w = F.wave, qi = c >> 2, h = c & 3, t0 = qb * 64 + 8 * w, t = t0 + qi, cur = qb;
    const float* kg = P.nsa_k_g + layer * 192; const float* qg = P.nsa_q_g + layer * 64;
    const float SHc = gain_bound(qg, kg, lane), SHs = gain_bound(qg, kg + 64, lane), SHw = gain_bound(qg, kg + 128, lane);
    const bf16* prow = F.PA + (size_t)t * PAC;
    bf16x8 qf[4];
#pragma unroll
    for (int ks = 0; ks < 4; ++ks) qf[ks] = *(const bf16x8*)(prow + C_NQ + h * 64 + ks * 16 + hg * 8);
    const float g0 = sigmoidf_(bf2f(prow[C_NG + h * 3 + 0])), g1 = sigmoidf_(bf2f(prow[C_NG + h * 3 + 1])), g2 = sigmoidf_(bf2f(prow[C_NG + h * 3 + 2]));
    LAS float* imp = (LAS float*)(F.lds + w * 8192);
    f32x16 accF[2]; ZERO_O(accF);
    f32x16 o[2]; float l;
    const int ntw = (t0 + 7 >= 31) ? (((t0 + 7 - 31) >> 4) >> 5) + 1 : 0;
    const int NT = (qb * 64 + 63 >= 31) ? (((qb * 64 + 63 - 31) >> 4) >> 5) + 1 : 0;
    const bf16* KC = (const bf16*)(F.ws + WS_KCMP); const bf16* VC = (const bf16*)(F.ws + WS_VCMP);
    ZERO_O(o); l = 0.f;
    STREAM2_BEGIN(KC, VC, 0, 1, NT)
        do_pair(_v0 && T0 < ntw, _v1 && T1 < ntw, _b0, _b1, T0, T1, qf, o, l, lane, -SHc,
                [=](int T, int r, float sv) { const int n = 32 * T + crow(r, hg); return (16 * n + 31 <= t) ? __builtin_amdgcn_exp2f(sv) : 0.f; });
    STREAM2_END
    l += shx(l, 32, lane);
    const float invc = l > 0.f ? 1.f / l : 0.f;
    {
        const float sc = g0 * invc;
#pragma unroll
        for (int r = 0; r < 16; ++r) { accF[0][r] += sc * o[0][r]; accF[1][r] += sc * o[1][r]; }
    }
    {
        float prevEx = 0.f;
        STREAM_BEGIN(KC, VC, 0, 1, NT)
            if (T < ntw) {
                const f32x16 s = qk_lds(_buf, qf, lane);
#pragma unroll
                for (int g = 0; g < 4; ++g) {
                    float s4 = 0.f, ed = 0.f;
#pragma unroll
                    for (int k = 0; k < 4; ++k) { const int r = 4 * g + k; const int n = 32 * T + crow(r, hg);
                        const float p = (16 * n + 31 <= t) ? __builtin_amdgcn_exp2f(s[r] - SHc) * invc : 0.f; s4 += p; if (k == 3) ed = p; }
                    s4 += dpp_x1(s4); s4 += dpp_x2(s4); ed += dpp_x1(ed); ed += dpp_x2(ed);
                    const float Ex = shx(ed, 32, lane);
                    const float Sp = s4 + (hg ? Ex : prevEx); prevEx = Ex;
                    if (h == 0) imp[qi * 256 + 8 * T + 2 * g + hg] = Sp;
                }
            }
        STREAM_END
    }
    unsigned long long my0 = 0ull, my1 = 0ull, my2 = 0ull, my3 = 0ull, un0 = 0ull, un1 = 0ull, un2 = 0ull, un3 = 0ull;
    {
        const int qs = lane >> 3, sub = lane & 7;
        float val[32];
#pragma unroll
        for (int k = 0; k < 32; ++k) { const int m = sub + 8 * k;
            const float iv = imp[qs * 256 + m];
            val[k] = (m > cur) ? -3e38f : ((m == 0 || m == cur || m == cur - 1) ? 3e38f : iv); }
        const int nsel = cur + 1 < 16 ? cur + 1 : 16;
        for (int rd = 0; rd < nsel; ++rd) {
            float bv = val[0]; int bk = 0;
#pragma unroll
            for (int k = 1; k < 32; ++k) if (val[k] > bv) { bv = val[k]; bk = k; }
            int bm = sub + 8 * bk;
#pragma unroll
            for (int of = 1; of < 8; of <<= 1) { const float ov = shx(bv, of, lane); const int om = shxi(bm, of, lane);
                if (ov > bv || (ov == bv && om < bm)) { bv = ov; bm = om; } }
#pragma unroll
            for (int k = 0; k < 32; ++k) if (sub + 8 * k == bm) val[k] = -3e38f;
            const int wa = shfromi(bm, (c >> 2) * 8);
            { const unsigned long long bit = 1ull << (wa & 63); const int kk = wa >> 6;
              my0 |= kk == 0 ? bit : 0ull; my1 |= kk == 1 ? bit : 0ull; my2 |= kk == 2 ? bit : 0ull; my3 |= kk == 3 ? bit : 0ull; }
#pragma unroll
            for (int q = 0; q < 8; ++q) { const int wq = __builtin_amdgcn_readlane(bm, q * 8); const unsigned long long bit = 1ull << (wq & 63); const int kk = wq >> 6;
                un0 |= kk == 0 ? bit : 0ull; un1 |= kk == 1 ? bit : 0ull; un2 |= kk == 2 ? bit : 0ull; un3 |= kk == 3 ? bit : 0ull; }
        }
    }
    const bf16* KS = (const bf16*)(F.ws + WS_KF) + (size_t)6 * STREAM_ELEMS; const bf16* VS = (const bf16*)(F.ws + WS_VF) + (size_t)6 * STREAM_ELEMS;
    ZERO_O(o); l = 0.f;
    {
        const int NG = (cur + 8) >> 3;
        const char* srcb = (const char*)((w < 4) ? KS : VS) + (w & 3) * 1024 + lane * 16;
        LAS unsigned char* ring0 = F.lds; const unsigned wo = (unsigned)w * 1024u; const unsigned ring0a = lds_addr(ring0);
#define DMAG(gi) do { _Pragma("unroll") for (int _tt = 0; _tt < 16; ++_tt) \
        glds16(srcb + (ptrdiff_t)((gi) * 16 + _tt) * 4096, (unsigned)__builtin_amdgcn_readfirstlane(ring0a + (unsigned)(_tt * 8192) + wo)); } while (0)
        asm volatile("s_waitcnt vmcnt(0) lgkmcnt(0)" ::: "memory"); SBAR();
        for (int gi = 0; gi < NG; ++gi) {
            DMAG(gi);
            VMW(0);
            SBAR();
#pragma unroll
            for (int bb = 0; bb < 8; ++bb) {
                const int m = gi * 8 + bb, kk = m >> 6, b = m & 63;
                const unsigned long long uw = kk == 0 ? un0 : (kk == 1 ? un1 : (kk == 2 ? un2 : un3));
                if (m < 256 && ((uw >> b) & 1ull)) {
                    const unsigned long long mw = kk == 0 ? my0 : (kk == 1 ? my1 : (kk == 2 ? my2 : my3));
                    const bool flag = (mw >> b) & 1ull;
                    {
                        LAS unsigned char* b0 = ring0 + (bb * 2) * 8192; LAS unsigned char* b1 = b0 + 8192;
                        const f32x16 s0 = qk_lds(b0, qf, lane, -SHs), s1 = qk_lds(b1, qf, lane, -SHs);
                        float e0[16], e1[16];
                        if (m == cur) {
#pragma unroll
                            for (int r = 0; r < 16; ++r) { const int key = 64 * m + crow(r, hg);
                                e0[r] = (flag && key <= t) ? __builtin_amdgcn_exp2f(s0[r]) : 0.f; e1[r] = (flag && key + 32 <= t) ? __builtin_amdgcn_exp2f(s1[r]) : 0.f; l += e0[r] + e1[r]; }
                        } else {
                            const float fl = flag ? 1.f : 0.f;
#pragma unroll
                            for (int r = 0; r < 16; ++r) { e0[r] = fl * __builtin_amdgcn_exp2f(s0[r]); e1[r] = fl * __builtin_amdgcn_exp2f(s1[r]); l += e0[r] + e1[r]; }
                        }
                        pv_lds(b0, e0, o, lane); pv_lds(b1, e1, o, lane);
                    }
                }
            }
            asm volatile("s_waitcnt lgkmcnt(0)" ::: "memory"); SBAR();
        }
#undef DMAG
    }
    l += shx(l, 32, lane);
    {
        const float sc = l > 0.f ? g1 / l : 0.f;
#pragma unroll
        for (int r = 0; r < 16; ++r) { accF[0][r] += sc * o[0][r]; accF[1][r] += sc * o[1][r]; }
    }
    const bf16* KW = (const bf16*)(F.ws + WS_KF) + (size_t)7 * STREAM_ELEMS; const bf16* VW = (const bf16*)(F.ws + WS_VF) + (size_t)7 * STREAM_ELEMS;
    ZERO_O(o); l = 0.f;
    const int Tlw = (t0 - 511 > 0 ? t0 - 511 : 0) >> 5, Thw = (t0 + 7) >> 5;
    const int TLO = (qb * 64 - 511 > 0 ? qb * 64 - 511 : 0) >> 5, THI = (qb * 64 + 63) >> 5;
    STREAM2_BEGIN(KW, VW, TLO, 1, THI - TLO + 1)
        do_pair(_v0 && T0 >= Tlw && T0 <= Thw, _v1 && T1 >= Tlw && T1 <= Thw, _b0, _b1, T0, T1, qf, o, l, lane, -SHw,
                [=](int T, int r, float sv) { const int key = 32 * T + crow(r, hg); return (key <= t && key >= t - 511) ? __builtin_amdgcn_exp2f(sv) : 0.f; });
    STREAM2_END
    l += shx(l, 32, lane);
    {
        const float sc = l > 0.f ? g2 / l : 0.f;
#pragma unroll
        for (int r = 0; r < 16; ++r) { accF[0][r] += sc * o[0][r]; accF[1][r] += sc * o[1][r]; }
    }
    write_gated(F, accF, 1.f, t, C_ON + h * 64, C_NZ + h * 64, hg);
}

__device__ __forceinline__ void phase4a(const Params& P, const Frame& F0, int layer, int rep) {
    unsigned* ctr = (unsigned*)(F0.ws + WS_CTL) + 16 * layer + 8 * rep;
    constexpr int N_P3 = 192, N_NSA = 256, N_FOX = 384, N_SEL = 384, N_OWN = 384, N_ALL = N_P3 + N_NSA + N_FOX + N_SEL + N_OWN;
    unsigned* p3done = (unsigned*)(F0.ws + WS_CTL) + 16 * layer + 4;
    volatile LAS unsigned* ubox = (volatile LAS unsigned*)(F0.lds + 131072);
    for (;;) {
        Frame F = F0;
        { unsigned char* wp = F0.ws; asm volatile("" : "+s"(wp)); int tv = F0.tid; asm volatile("" : "+v"(tv)); F.ws = wp; F.PA = (bf16*)(wp + WS_PA); F.tid = tv; F.lane = tv & 63; }
        if (F.tid == 0) *ubox = __hip_atomic_fetch_add(ctr, 1u, __ATOMIC_RELAXED, __HIP_MEMORY_SCOPE_AGENT);
        __syncthreads();
        const unsigned u = __builtin_amdgcn_readfirstlane(*ubox);
        __syncthreads();
        if (u >= (unsigned)N_ALL) break;
#ifndef PROBE_ONLY
#define PROBE_ONLY -1
#endif
        if (u < (unsigned)N_P3) {
            p3_unit(P, F, layer, 0, (int)u); p3_unit(P, F, layer, 1, (int)u);
            asm volatile("s_waitcnt vmcnt(0)" ::: "memory");
            __syncthreads();
            if (F.tid == 0) { __builtin_amdgcn_fence(__ATOMIC_RELEASE, "agent"); asm volatile("s_waitcnt vmcnt(0)" ::: "memory");
                __hip_atomic_fetch_add(p3done, 1u, __ATOMIC_RELAXED, __HIP_MEMORY_SCOPE_AGENT); }
            continue;
        }
        const unsigned u2 = u - N_P3;
        if (u2 >= (unsigned)N_NSA && u2 < (unsigned)(N_NSA + N_FOX + N_SEL)) {
            if (F.tid == 0) { unsigned sp = 0; while (__hip_atomic_load(p3done, __ATOMIC_RELAXED, __HIP_MEMORY_SCOPE_AGENT) < (unsigned)N_P3 && ++sp < (1u << 24)) __builtin_amdgcn_s_sleep(2);
                __builtin_amdgcn_fence(__ATOMIC_ACQUIRE, "agent"); asm volatile("s_waitcnt vmcnt(0)" ::: "memory"); }
            __syncthreads();
        }
        if (u2 < (unsigned)N_NSA) { wg_nsa(P, F, layer, 255 - (int)u2); }
        else if (u2 < (unsigned)(N_NSA + N_FOX)) { const unsigned v = u2 - N_NSA; wg_fox(P, F, layer, (int)(v % 6), 63 - (int)(v / 6)); }
        else if (u2 < (unsigned)(N_NSA + N_FOX + N_SEL)) { const unsigned v = u2 - (N_NSA + N_FOX); wg_moba_sel(P, F, layer, (int)(v % 6), (int)(v / 6)); }
        else { const unsigned v = u2 - (N_NSA + N_FOX + N_SEL); wg_moba_own(P, F, layer, (int)(v % 6), 63 - (int)(v / 6)); }
    }
}

__device__ __forceinline__ void phase4b(const Params& P, const Frame& F, int layer, const float* xin) {
    const float* LPART = (const float*)(F.ws + WS_LPART); const float* LOWN = (const float*)(F.ws + WS_LOWN);
    for (int it = F.gw; it < SEQ * 48 / 64; it += F.NGW) {
        const int idx = it * 64 + F.lane, t = idx / 48, r = idx - t * 48, h = r >> 3, d8 = (r & 7) * 8, cur = t >> 8;
        bf16* op = F.PA + (size_t)t * PAC + C_OM + h * 64 + d8;
        const u32x4 ow = *(const u32x4*)op;
        float v[8] = {bflo(ow.x), bfhi(ow.x), bflo(ow.y), bfhi(ow.y), bflo(ow.z), bfhi(ow.z), bflo(ow.w), bfhi(ow.w)};
        float l = LOWN[h * SEQ + t];
        const size_t rec = ((size_t)h * SEQ + t) * 3;
#pragma unroll
        for (int s = 0; s < 3; ++s) if (s < cur) {
            const u32x4 pw = *(const u32x4*)(moba_part(F, h, t, s) + d8);
            v[0] += bflo(pw.x); v[1] += bfhi(pw.x); v[2] += bflo(pw.y); v[3] += bfhi(pw.y); v[4] += bflo(pw.z); v[5] += bfhi(pw.z); v[6] += bflo(pw.w); v[7] += bfhi(pw.w);
            l += LPART[rec + s];
        }
        const float inv = l > 0.f ? 1.f / l : 0.f;
        const u32x4 z = *(const u32x4*)(F.PA + (size_t)t * PAC + C_MZ + h * 64 + d8);
        u32x4 wv;
        wv.x = cvt_pk_bf16(v[0] * inv * siluf_(bflo(z.x)), v[1] * inv * siluf_(bfhi(z.x))); wv.y = cvt_pk_bf16(v[2] * inv * siluf_(bflo(z.y)), v[3] * inv * siluf_(bfhi(z.y)));
        wv.z = cvt_pk_bf16(v[4] * inv * siluf_(bflo(z.z)), v[5] * inv * siluf_(bfhi(z.z))); wv.w = cvt_pk_bf16(v[6] * inv * siluf_(bflo(z.w)), v[7] * inv * siluf_(bfhi(z.w)));
        *(u32x4*)op = wv;
    }
    (void)xin;
}


#define XB_TMO      128
#define XB_XCNT(j)  (256  + 64 * (j))
#define XB_XSUB(j)  (1280 + 64 * (j))
#define XB_XGEN(j)  (2304 + 64 * (j))
#define XB_TOP      3328
#define XB_TOPGEN   3392
#define XCD_BAR_WORDS 3456
#define XB_SPIN_CAP (1u << 22)
__device__ __forceinline__ unsigned xb_ld(unsigned* p)              { return __hip_atomic_load(p, __ATOMIC_RELAXED, __HIP_MEMORY_SCOPE_AGENT); }
__device__ __forceinline__ unsigned xb_add(unsigned* p, unsigned v) { return __hip_atomic_fetch_add(p, v, __ATOMIC_RELAXED, __HIP_MEMORY_SCOPE_AGENT); }
__device__ __forceinline__ unsigned xb_xcc_id() { return (unsigned)__builtin_amdgcn_s_getreg((3 << 11) | 20) & 0xFu; }
#define XB_SPIN(cond, bar) do { unsigned _sp = 0; while (cond) { __builtin_amdgcn_s_sleep(1); \
    if ((++_sp & 255u) == 0u) { if (xb_ld(&(bar)[XB_TMO])) break; if (_sp > XB_SPIN_CAP) { atomicAdd(&(bar)[XB_TMO], 1u); break; } } } } while (0)
struct XcdBarrier { unsigned* bar; unsigned x; volatile LAS unsigned* st; };
__device__ __forceinline__ XcdBarrier xcd_barrier_post(unsigned* bar, volatile LAS unsigned* st) {
    XcdBarrier b; b.bar = bar; b.x = xb_xcc_id(); b.st = st;
    if (threadIdx.x == 0) (void)xb_add(&bar[XB_XCNT(b.x)], 1u);
    return b;
}
__device__ __forceinline__ void xcd_barrier_complete(unsigned* bar, unsigned x, unsigned& nloc, unsigned& nx) {
    const unsigned G = gridDim.x * gridDim.y * gridDim.z;
    unsigned sum, cnt, mine, sp = 0u;
    for (;;) {
        sum = 0u; cnt = 0u; mine = 0u;
#pragma unroll
        for (unsigned j = 0; j < 16; ++j) { const unsigned c = xb_ld(&bar[XB_XCNT(j)]); sum += c; cnt += (c > 0u) ? 1u : 0u; mine = (j == x) ? c : mine; }
        if (sum == G) break;
        __builtin_amdgcn_s_sleep(1);
        if ((++sp & 255u) == 0u) { if (xb_ld(&bar[XB_TMO])) break; if (sp > XB_SPIN_CAP) { atomicAdd(&bar[XB_TMO], 1u); break; } }
    }
    nloc = mine > 0u ? mine : 1u; nx = cnt > 0u ? cnt : 1u;
}
__device__ __forceinline__ void xcd_barrier(const XcdBarrier& b) {
    asm volatile("s_waitcnt vmcnt(0)" ::: "memory");
    __syncthreads();
    if (threadIdx.x == 0) {
        unsigned* bar = b.bar;
        __builtin_amdgcn_s_waitcnt(0);
        unsigned nloc = b.st[0], nx = b.st[1];
        if (nloc == 0u) { xcd_barrier_complete(bar, b.x, nloc, nx); b.st[0] = nloc; b.st[1] = nx; }
        const unsigned old = xb_add(&bar[XB_XSUB(b.x)], 1u);
        const unsigned gen = old / nloc;
        if (old + 1u == (gen + 1u) * nloc) {
            __builtin_amdgcn_fence(__ATOMIC_RELEASE, "agent");
            asm volatile("s_waitcnt vmcnt(0)" ::: "memory");
            const unsigned og = xb_add(&bar[XB_TOP], 1u);
            const unsigned tg = og / nx;
            if (og + 1u == (tg + 1u) * nx) xb_add(&bar[XB_TOPGEN], 1u);
            else XB_SPIN(xb_ld(&bar[XB_TOPGEN]) == tg, bar);
            __builtin_amdgcn_fence(__ATOMIC_ACQUIRE, "agent");
            xb_add(&bar[XB_XGEN(b.x)], 1u);
            asm volatile("s_waitcnt vmcnt(0)" ::: "memory");
        } else {
            XB_SPIN(xb_ld(&bar[XB_XGEN(b.x)]) == gen, bar);
            __builtin_amdgcn_fence(__ATOMIC_ACQUIRE, "agent");
            asm volatile("s_waitcnt vmcnt(0)" ::: "memory");
        }
    }
    __syncthreads();
}

__global__ void __launch_bounds__(512, 2) fwd_kernel(Params P) {
    extern __shared__ __attribute__((aligned(16))) unsigned char lds_raw[];
    cg::grid_group grid = cg::this_grid();
    const int G = gridDim.x, bx = blockIdx.x;
    volatile LAS unsigned* bst = (volatile LAS unsigned*)((LAS unsigned char*)lds_raw + 131072 + 64);
    if (threadIdx.x == 0) { bst[0] = 0u; bst[1] = 0u; }
    __syncthreads();
    XcdBarrier gbar; gbar.bar = (unsigned*)(P.ws + WS_BAR); gbar.x = 0; gbar.st = bst;
    if (P.ph_hi - P.ph_lo > 1) gbar = xcd_barrier_post((unsigned*)(P.ws + WS_BAR), bst);
#ifdef PROBE_TS
    unsigned long long ts_acc = 0ull;
#endif
    long long p2acc = 0;
#ifdef PROBE_SYNC
    { const unsigned long long t0 = __builtin_amdgcn_s_memrealtime();
      for (int i = 0; i < 20; ++i) grid.sync();
      p2acc += (long long)(__builtin_amdgcn_s_memrealtime() - t0); }
#endif
    for (int ph = P.ph_lo; ph < P.ph_hi; ++ph) {
#ifdef PROBE_TS
        const unsigned long long ts0 = __builtin_amdgcn_s_memrealtime();
#endif
        unsigned char* wsb = P.ws; asm volatile("" : "+s"(wsb));
        int tidv = threadIdx.x; asm volatile("" : "+v"(tidv));
        Frame F;
        F.lds = (LAS unsigned char*)lds_raw;
        F.tid = tidv; F.lane = F.tid & 63; F.wave = __builtin_amdgcn_readfirstlane(F.tid >> 6);
        F.gw = bx * 8 + F.wave; F.NGW = G * 8;
        F.ws = wsb; F.PA = (bf16*)(wsb + WS_PA);
        const int layer = ph / NPH, k = ph - layer * NPH;
        const float* xin = layer == 0 ? P.x : P.out;
        if (k == 0) phase0(P, F, layer, xin);
        else if (k == 1) {
            pg8::Gemm g{(const bf16*)(wsb + WS_H), (const bf16*)(wsb + WS_WA), SEQ, PAC, DM, DM}; pg8::StaticOrder S; S.init(SEQ, PAC, G, bx); pg8::EpiBf16 E{F.PA, PAC};
            pg8::gemm_phase<pg8::EpiBf16, pg8::StaticOrder>(F.lds, g, S, E, F.tid);
        }
        else if (k == 5) {
            pg8::StaticOrder SM; SM.init(SEQ, DM, G, bx); pg8::Unit mu;
            for (int j = 0; SM.next(j, mu); ++j) {
                { unsigned char* wl = wsb; asm volatile("" : "+s"(wl)); int tl = tidv; asm volatile("" : "+v"(tl));
                  pg8::Gemm g{(const bf16*)(wl + WS_H), (const bf16*)(wl + WS_WG), SEQ, NGL, DM, DM}; pg8::FixedUnits S{mu, 3, 4}; pg8::EpiBf16 E{(bf16*)(wl + WS_PA) + C_GL, PAC};
                  pg8::gemm_phase<pg8::EpiBf16, pg8::FixedUnits>(F.lds, g, S, E, tl); }
                for (int b = 0; b < 3; ++b) {
                    unsigned char* wl = wsb; asm volatile("" : "+s"(wl)); int tl = tidv; asm volatile("" : "+v"(tl));
                    bf16* PAl = (bf16*)(wl + WS_PA);
                    const int Kb = b == 1 ? 256 : 384;
                    const bf16* A = PAl + (b == 0 ? C_OM : (b == 1 ? C_ON : C_OF));
                    const bf16* Bt = (const bf16*)(wl + (b == 0 ? WS_WUPM : (b == 1 ? WS_WUPN : WS_WUPF)));
                    pg8::Gemm g{A, Bt, SEQ, DM, Kb, PAC}; pg8::FixedUnits S{mu, 1, 0};
                    pg8::EpiMerge E{(bf16*)(wl + WS_MG), PAl + C_GL + b * 1024, P.b_gate + layer * 3072 + b * 1024, b == 0 ? 1 : 0};
                    pg8::gemm_phase<pg8::EpiMerge, pg8::FixedUnits>(F.lds, g, S, E, tl);
                }
            }
        }
        else if (k == 2) phase2(P, F, layer, p2acc);
        else if (k == 3) {
#ifdef PROBE_P4X2
            for (int rep = 0; rep < 2; ++rep) { if (rep) grid.sync(); phase4a(P, F, layer, rep); }
#else
            phase4a(P, F, layer, 0);
#endif
        }
        else if (k == 4) phase4b(P, F, layer, xin);
        else {
            pg8::Gemm g{(const bf16*)(wsb + WS_MG), (const bf16*)(wsb + WS_WO), SEQ, DM, DM, DM}; pg8::StaticOrder S; S.init(SEQ, DM, G, bx);
            pg8::EpiOut E{xin, P.out};
            pg8::gemm_phase<pg8::EpiOut, pg8::StaticOrder>(F.lds, g, S, E, F.tid);
        }
        if (ph + 1 < P.ph_hi) { if (P.ph_hi < 0) grid.sync(); else xcd_barrier(gbar); }
#ifdef PROBE_TS
        if ((ph % NPH) == PROBE_TS) ts_acc += __builtin_amdgcn_s_memrealtime() - ts0;
        if (ph + 1 == P.ph_hi && bx == 0 && tidv == 0) { __threadfence(); P.out[0] += (float)ts_acc * 1e-3f; }
#endif
#ifdef PROBE_SYNC
        if (ph + 1 == P.ph_hi && bx == 0 && tidv == 0) { __threadfence(); P.out[0] += (float)p2acc * 1e-3f; }
#endif
#ifdef PROBE_P2PART
        if (ph + 1 == P.ph_hi && bx == PROBE_P2BLK && tidv == 0) { __threadfence(); P.out[0] += (float)p2acc * 1e-3f; }
#endif
    }
}

extern "C" void kernel_launch(void* const* d_in, const int* in_sizes, int n_in, void* d_out, int out_size, void* d_ws, size_t ws_size, hipStream_t stream) {
    static int grid = 0;
    if (grid == 0) {
        if (n_in != 16 || out_size != SEQ * DM || ws_size < WS_END) { fprintf(stderr, "kernel_launch: unexpected problem shape (n_in %d out %d ws %zu)\n", n_in, out_size, ws_size); grid = -1; return; }
        int dev = 0, cus = 0, per_cu = 0;
        hipGetDevice(&dev);
        hipDeviceGetAttribute(&cus, hipDeviceAttributeMultiprocessorCount, dev);
        hipFuncSetAttribute((const void*)fwd_kernel, hipFuncAttributeMaxDynamicSharedMemorySize, LDS_BYTES);
        hipOccupancyMaxActiveBlocksPerMultiprocessor(&per_cu, (const void*)fwd_kernel, 512, LDS_BYTES);
        if (per_cu < 1) { fprintf(stderr, "kernel_launch: occupancy query says %d blocks per CU\n", per_cu); per_cu = 1; }
        (void)hipGetLastError();
        grid = cus * per_cu;
    }
    if (grid < 0) return;
    Params p{};
    p.x = (const float*)d_in[0]; p.norm_g = (const float*)d_in[1]; p.w_in = (const float*)d_in[2]; p.b_f = (const float*)d_in[3]; p.b_gate = (const float*)d_in[4];
    p.moba_qk_g = (const float*)d_in[5]; p.nsa_q_g = (const float*)d_in[6]; p.nsa_k_g = (const float*)d_in[7]; p.fox_qk_g = (const float*)d_in[8];
    p.cmp_pe = (const float*)d_in[9]; p.cmp_w1 = (const float*)d_in[10]; p.cmp_w2 = (const float*)d_in[11];
    p.w_up_moba = (const float*)d_in[12]; p.w_up_nsa = (const float*)d_in[13]; p.w_up_fox = (const float*)d_in[14]; p.w_out = (const float*)d_in[15];
    p.out = (float*)d_out; p.ws = (unsigned char*)d_ws;
#if N_LAUNCH_MODE == 1
    for (int ph = 0; ph < 2 * NPH; ++ph) { p.ph_lo = ph; p.ph_hi = ph + 1; hipLaunchKernelGGL(fwd_kernel, dim3(grid), dim3(512), LDS_BYTES, stream, p); }
#else
    p.ph_lo = 0; p.ph_hi = 2 * NPH;
    if (hipMemsetAsync((char*)d_ws + WS_BAR, 0, 16384, stream) != hipSuccess) { fprintf(stderr, "kernel_launch: memset of the barrier words failed\n"); return; }
    void* args[] = {&p};
    hipError_t e = hipLaunchCooperativeKernel((const void*)fwd_kernel, dim3(grid), dim3(512), args, LDS_BYTES, stream);
    if (e != hipSuccess) fprintf(stderr, "kernel_launch: cooperative launch failed: %s (grid %d)\n", hipGetErrorString(e), grid);
#endif
}
```
